# Optimizing an MI355X kernel written in HIP

```python
import math
import jax, jax.numpy as jnp
from jax import lax
import numpy as np

D_MODEL = 1024
BATCH = 8
SEQ = 2048
DEPTH = 4

N_MLA_HEADS = 8
QK_NOPE_DIM = 64
QK_ROPE_DIM = 32
QK_HEAD_DIM = QK_NOPE_DIM + QK_ROPE_DIM
V_HEAD_DIM = 64
Q_LORA_RANK = 256
KV_LORA_RANK = 256
ROPE_THETA = 10000.0
Q_BLOCK = 128
LRU_WIDTH = D_MODEL
N_LRU_BLOCKS = 8
LRU_BLOCK = LRU_WIDTH // N_LRU_BLOCKS
CONV_WIDTH = 4
CONV_LEFT = 2
RG_LRU_C = 8.0
A_MIN_RAD = 0.9
A_MAX_RAD = 0.999
D_FF = 2816
N_EXPERTS = 8
TOP_K = 2
N_DENSE = (DEPTH + 1) // 2
N_MOE = DEPTH // 2
EPS = 1e-6

IN_SIZES = (Q_LORA_RANK, KV_LORA_RANK, QK_ROPE_DIM, LRU_WIDTH, LRU_WIDTH, 2 * D_MODEL)
IN_COLS = sum(IN_SIZES)
IN_SPLITS = [int(v) for v in np.cumsum(IN_SIZES)[:-1]]

kernel_name = "hybrid_rglru_mla_moe_adaln_encoder"


def rms_norm(x, g):
    x32 = x.astype(jnp.float32)
    y = x32 * lax.rsqrt(jnp.mean(x32 * x32, axis=-1, keepdims=True) + EPS)
    return (y * g.astype(jnp.float32)).astype(x.dtype)


def rope_tables(positions, dtype):
    inv_freq = 1.0 / (ROPE_THETA ** (jnp.arange(0, QK_ROPE_DIM, 2, dtype=jnp.float32) / QK_ROPE_DIM))
    ang = positions.astype(jnp.float32)[..., None] * inv_freq
    return jnp.cos(ang).astype(dtype), jnp.sin(ang).astype(dtype)


def rope(x, cos, sin):
    x1, x2 = jnp.split(x, 2, axis=-1)
    return jnp.concatenate([x1 * cos - x2 * sin, x1 * sin + x2 * cos], axis=-1)


def block_attention(q, k, v):
    B, S, H, Dh = q.shape
    scale = Dh ** -0.5
    kh = k.transpose(0, 2, 1, 3)
    vh = v.transpose(0, 2, 1, 3)
    qb = q.reshape(B, S // Q_BLOCK, Q_BLOCK, H, Dh).transpose(1, 0, 3, 2, 4)

    def one_block(q_blk):
        s = jnp.einsum('bhqd,bhkd->bhqk', q_blk, kh).astype(jnp.float32) * scale
        p = jax.nn.softmax(s, axis=-1)
        return jnp.einsum('bhqk,bhkd->bhqd', p.astype(vh.dtype), vh)

    o = lax.map(one_block, qb)
    return o.transpose(1, 0, 3, 2, 4).reshape(B, S, H, -1)


def mla_branch(cq, ckv, kr, cos, sin, q_norm_g, kv_norm_g, w_uq, w_ukv, q_head_g, k_head_g, w_o):
    B, S, _ = cq.shape
    q = (rms_norm(cq, q_norm_g) @ w_uq).reshape(B, S, N_MLA_HEADS, QK_HEAD_DIM)
    kv = (rms_norm(ckv, kv_norm_g) @ w_ukv).reshape(B, S, N_MLA_HEADS, QK_NOPE_DIM + V_HEAD_DIM)
    q_nope, q_pe = q[..., :QK_NOPE_DIM], q[..., QK_NOPE_DIM:]
    k_nope, v = kv[..., :QK_NOPE_DIM], kv[..., QK_NOPE_DIM:]
    q_pe = rope(q_pe, cos[:, :, None, :], sin[:, :, None, :])
    k_pe = rope(kr, cos, sin)
    q = jnp.concatenate([q_nope, q_pe], axis=-1)
    k = jnp.concatenate(
        [k_nope, jnp.broadcast_to(k_pe[:, :, None, :], (B, S, N_MLA_HEADS, QK_ROPE_DIM))], axis=-1)
    q = rms_norm(q, q_head_g)
    k = rms_norm(k, k_head_g)
    o = block_attention(q, k, v)
    return o.reshape(B, S, N_MLA_HEADS * V_HEAD_DIM) @ w_o


def lru_combine(left, right):
    a_l, b_l = left
    a_r, b_r = right
    return a_l * a_r, a_r * b_l + b_r


def rg_lru(u, w_gates, b_gates, a_param, reverse):
    B, S, W = u.shape
    g = jnp.einsum('bsnd,gnde->gbsne', u.reshape(B, S, N_LRU_BLOCKS, LRU_BLOCK), w_gates)
    g = (g.reshape(2, B, S, W) + b_gates[:, None, None, :]).astype(jnp.float32)
    r = jax.nn.sigmoid(g[0])
    i = jax.nn.sigmoid(g[1])
    log_a = -RG_LRU_C * r * jax.nn.softplus(a_param.astype(jnp.float32))
    a = jnp.exp(log_a)
    mult = jnp.sqrt(-jnp.expm1(2.0 * log_a))
    first = jnp.arange(S) == (S - 1 if reverse else 0)
    mult = jnp.where(first[None, :, None], 1.0, mult)
    b = mult * i * u.astype(jnp.float32)
    _, h = lax.associative_scan(lru_combine, (a, b), axis=1, reverse=reverse)
    return h.astype(u.dtype)


def lru_branch(u, y_gate, conv_w, conv_b, w_gates, b_gates, a_param, w_o):
    S = u.shape[1]
    up = jnp.pad(u, ((0, 0), (CONV_LEFT, CONV_WIDTH - 1 - CONV_LEFT), (0, 0)))
    uc = conv_b
    for tap in range(CONV_WIDTH):
        uc = uc + up[:, tap:tap + S] * conv_w[tap]
    h = rg_lru(uc, w_gates[0], b_gates[0], a_param[0], False) + \
        rg_lru(uc, w_gates[1], b_gates[1], a_param[1], True)
    return (h * jax.nn.gelu(y_gate)) @ w_o


def swiglu(h, w_gate, w_up, w_down):
    return (jax.nn.silu(h @ w_gate) * (h @ w_up)) @ w_down


def moe_ffn(h, w_router, w_gate, w_up, w_down):
    B, S, D = h.shape
    t = h.reshape(B * S, D)
    logits = (t @ w_router).astype(jnp.float32)
    top_v, top_i = lax.top_k(logits, TOP_K)
    top_w = jax.nn.softmax(top_v, axis=-1)
    combine = jnp.sum(jax.nn.one_hot(top_i, N_EXPERTS, dtype=jnp.float32) * top_w[..., None], axis=1)
    combine = combine.astype(t.dtype)
    out = jnp.zeros_like(t)
    for e in range(N_EXPERTS):
        out = out + combine[:, e:e + 1] * swiglu(t, w_gate[e], w_up[e], w_down[e])
    return out.reshape(B, S, D)


def setup_inputs(seed: int = 0) -> dict:
    key = jax.random.key(seed)
    ks = jax.random.split(key, 32)

    def nrm(k, shape, scale):
        return jax.random.normal(k, shape, jnp.float32) * scale

    def gain(k, shape):
        return 1.0 + 0.02 * jax.random.normal(k, shape, jnp.float32)

    L = DEPTH
    unif = jax.random.uniform(ks[20], (L, 2, LRU_WIDTH), jnp.float32, A_MIN_RAD ** 2, A_MAX_RAD ** 2)
    lru_a_param = jnp.log(jnp.expm1(-0.5 * jnp.log(unif)))
    return {
        "x": nrm(ks[0], (BATCH, SEQ, D_MODEL), 1.0),
        "c": nrm(ks[1], (BATCH, D_MODEL), 1.0),
        "positions": jnp.broadcast_to(jnp.arange(SEQ, dtype=jnp.int32), (BATCH, SEQ)),
        "ada_w": nrm(ks[2], (L, D_MODEL, 6 * D_MODEL), 0.5 * D_MODEL ** -0.5),
        "ada_b": nrm(ks[3], (L, 6 * D_MODEL), 0.02),
        "norm1_g": gain(ks[4], (L, D_MODEL)),
        "norm2_g": gain(ks[5], (L, D_MODEL)),
        "w_in": nrm(ks[6], (L, D_MODEL, IN_COLS), D_MODEL ** -0.5),
        "q_norm_g": gain(ks[7], (L, Q_LORA_RANK)),
        "kv_norm_g": gain(ks[8], (L, KV_LORA_RANK)),
        "w_uq": nrm(ks[9], (L, Q_LORA_RANK, N_MLA_HEADS * QK_HEAD_DIM), Q_LORA_RANK ** -0.5),
        "w_ukv": nrm(ks[10], (L, KV_LORA_RANK, N_MLA_HEADS * (QK_NOPE_DIM + V_HEAD_DIM)), KV_LORA_RANK ** -0.5),
        "q_head_g": gain(ks[11], (L, QK_HEAD_DIM)),
        "k_head_g": gain(ks[12], (L, QK_HEAD_DIM)),
        "w_o_mla": nrm(ks[13], (L, N_MLA_HEADS * V_HEAD_DIM, D_MODEL), (N_MLA_HEADS * V_HEAD_DIM) ** -0.5),
        "conv_w": nrm(ks[14], (L, CONV_WIDTH, LRU_WIDTH), CONV_WIDTH ** -0.5),
        "conv_b": nrm(ks[15], (L, LRU_WIDTH), 0.01),
        "lru_gate_w": nrm(ks[16], (L, 2, 2, N_LRU_BLOCKS, LRU_BLOCK, LRU_BLOCK), LRU_BLOCK ** -0.5),
        "lru_gate_b": nrm(ks[17], (L, 2, 2, LRU_WIDTH), 0.01),
        "lru_a_param": lru_a_param,
        "w_o_lru": nrm(ks[18], (L, LRU_WIDTH, D_MODEL), LRU_WIDTH ** -0.5),
        "w_out": nrm(ks[19], (L, D_MODEL, D_MODEL), D_MODEL ** -0.5),
        "ffn_w_gate": nrm(ks[21], (N_DENSE, D_MODEL, D_FF), D_MODEL ** -0.5),
        "ffn_w_up": nrm(ks[22], (N_DENSE, D_MODEL, D_FF), D_MODEL ** -0.5),
        "ffn_w_down": nrm(ks[23], (N_DENSE, D_FF, D_MODEL), D_FF ** -0.5),
        "moe_router": nrm(ks[24], (N_MOE, D_MODEL, N_EXPERTS), D_MODEL ** -0.5),
        "moe_w_gate": nrm(ks[25], (N_MOE, N_EXPERTS, D_MODEL, D_FF), D_MODEL ** -0.5),
        "moe_w_up": nrm(ks[26], (N_MOE, N_EXPERTS, D_MODEL, D_FF), D_MODEL ** -0.5),
        "moe_w_down": nrm(ks[27], (N_MOE, N_EXPERTS, D_FF, D_MODEL), D_FF ** -0.5),
    }


def reference(x, c, positions, ada_w, ada_b, norm1_g, norm2_g, w_in, q_norm_g, kv_norm_g,
              w_uq, w_ukv, q_head_g, k_head_g, w_o_mla, conv_w, conv_b, lru_gate_w, lru_gate_b,
              lru_a_param, w_o_lru, w_out, ffn_w_gate, ffn_w_up, ffn_w_down,
              moe_router, moe_w_gate, moe_w_up, moe_w_down):
    cos, sin = rope_tables(positions, x.dtype)
    c_act = jax.nn.silu(c)
    for l in range(DEPTH):
        mod = c_act @ ada_w[l] + ada_b[l]
        shift1, scale1, gate1, shift2, scale2, gate2 = [m[:, None, :] for m in jnp.split(mod, 6, axis=-1)]

        h = rms_norm(x, norm1_g[l]) * (1 + scale1) + shift1
        cq, ckv, kr, u, y_gate, g_branch = jnp.split(h @ w_in[l], IN_SPLITS, axis=-1)
        y_mla = mla_branch(cq, ckv, kr, cos, sin, q_norm_g[l], kv_norm_g[l], w_uq[l], w_ukv[l],
                           q_head_g[l], k_head_g[l], w_o_mla[l])
        y_lru = lru_branch(u, y_gate, conv_w[l], conv_b[l], lru_gate_w[l], lru_gate_b[l],
                           lru_a_param[l], w_o_lru[l])
        g_lru, g_mla = jnp.split(jax.nn.sigmoid(g_branch), 2, axis=-1)
        x = x + gate1 * ((g_lru * y_lru + g_mla * y_mla) @ w_out[l])

        h = rms_norm(x, norm2_g[l]) * (1 + scale2) + shift2
        if l % 2 == 0:
            f = swiglu(h, ffn_w_gate[l // 2], ffn_w_up[l // 2], ffn_w_down[l // 2])
        else:
            f = moe_ffn(h, moe_router[l // 2], moe_w_gate[l // 2], moe_w_up[l // 2], moe_w_down[l // 2])
        x = x + gate2 * f
    return x
```

```cpp
#include <hip/hip_runtime.h>
#include <cstdio>
#include <cstdint>

constexpr int B_ = 8, S_ = 2048, T_ = B_ * S_, D_ = 1024, L_ = 4, H_ = 8;
constexpr int QKD = 96, VD = 64, FF = 2816, NE = 8, INC = 4640;
constexpr int SP = S_ + 4;
constexpr float EPS = 1e-6f;
constexpr float QSCALE = 0.10206207261596577f * 1.4426950408889634f;

typedef unsigned short bf16_t;
typedef float f32x4 __attribute__((ext_vector_type(4)));
typedef unsigned u32x4 __attribute__((ext_vector_type(4)));
typedef unsigned u32x2 __attribute__((ext_vector_type(2)));

constexpr size_t MiB = 1u << 20;
constexpr size_t WS_CTL = 0, CTL_BYTES = 1 * MiB;
constexpr size_t WS_MOD = 1 * MiB;
constexpr size_t WS_COS = 2 * MiB, WS_SIN = 3 * MiB;
constexpr size_t WS_GB = 4 * MiB;
constexpr size_t WS_LIST = 5 * MiB;
constexpr size_t WS_TW = 6 * MiB;
constexpr size_t WS_AGG = 8 * MiB;
constexpr size_t WS_WEI = 16 * MiB;
constexpr size_t WS_AR = 392 * MiB;
constexpr size_t A_XN = WS_AR + 0 * MiB;
constexpr size_t A_CQKV = WS_AR + 32 * MiB;
constexpr size_t A_KR = WS_AR + 48 * MiB;
constexpr size_t A_KPE = WS_AR + 50 * MiB;
constexpr size_t A_UP = WS_AR + 52 * MiB;
constexpr size_t A_YG = WS_AR + 86 * MiB;
constexpr size_t A_G = WS_AR + 118 * MiB;
constexpr size_t A_CQN = WS_AR + 182 * MiB;
constexpr size_t A_QR = WS_AR + 198 * MiB;
constexpr size_t A_KVR = WS_AR + 230 * MiB;
constexpr size_t A_LAB = WS_AR + 262 * MiB;
constexpr size_t A_Q = WS_AR + 0 * MiB;
constexpr size_t A_K = WS_AR + 24 * MiB;
constexpr size_t A_V = WS_AR + 52 * MiB;
constexpr size_t A_O = WS_AR + 198 * MiB;
constexpr size_t A_HL = WS_AR + 230 * MiB;
constexpr size_t A_Z1 = WS_AR + 262 * MiB;
constexpr size_t A_Z = WS_AR + 326 * MiB;
constexpr size_t A_HID = WS_AR + 32 * MiB;
constexpr size_t A_Y0 = WS_AR + 262 * MiB;
constexpr size_t A_Y1 = WS_AR + 326 * MiB;
constexpr size_t WS_END = WS_AR + 390 * MiB;
constexpr int CW_CNT = 65536;
constexpr int CW_BAR = 4096;

struct Params { const float* in[29]; float* out; unsigned char* ws; };

#define PB(off, type) ((type*)(p.ws + (off)))

__device__ __forceinline__ float bf2f(bf16_t v) { return __uint_as_float(((unsigned)v) << 16); }
__device__ __forceinline__ bf16_t f2bf(float f) { unsigned u = __float_as_uint(f); u += 0x7fffu + ((u >> 16) & 1u); return (bf16_t)(u >> 16); }
__device__ __forceinline__ unsigned pk2(float lo, float hi) { return (unsigned)f2bf(lo) | ((unsigned)f2bf(hi) << 16); }
__device__ __forceinline__ float sigmoidf_(float x) { return 1.0f / (1.0f + __expf(-x)); }
__device__ __forceinline__ float siluf_(float x) { return x * sigmoidf_(x); }
__device__ __forceinline__ float gelu_tanh(float x) { const float u = 0.7978845608028654f * (x + 0.044715f * x * x * x); return x * sigmoidf_(2.0f * u); }
__device__ __forceinline__ float softplusf_(float x) { return fmaxf(x, 0.f) + log1pf(__expf(-fabsf(x))); }
__device__ __forceinline__ float wave_sum(float v) {
#pragma unroll
    for (int o = 1; o < 64; o <<= 1) v += __shfl_xor(v, o);
    return v;
}

__device__ __forceinline__ void ph_mod(const Params& p, float* lds, int blk, int nblk) {
    const int tid = threadIdx.x, lane = tid & 63, w = tid >> 6;
    const float* c = p.in[1]; const float* aw = p.in[3]; const float* ab = p.in[4];
    float* mod = PB(WS_MOD, float);
    for (int i = tid; i < B_ * D_; i += 512) lds[i] = siluf_(c[i]);
    __syncthreads();
    float* red = lds + B_ * D_;
    for (int item = blk; item < L_ * 96; item += nblk) {
        const int l = item / 96, n0 = (item % 96) * 64;
        float acc[8];
#pragma unroll
        for (int b = 0; b < 8; ++b) acc[b] = 0.f;
        const float* wp = aw + ((size_t)l * D_ + w * 128) * 6144 + n0 + lane;
        for (int k = 0; k < 128; ++k) {
            const float wv = wp[(size_t)k * 6144];
#pragma unroll
            for (int b = 0; b < 8; ++b) acc[b] += lds[b * D_ + w * 128 + k] * wv;
        }
#pragma unroll
        for (int b = 0; b < 8; ++b) red[(w * 8 + b) * 64 + lane] = acc[b];
        __syncthreads();
        {
            const int b = tid >> 6, n = tid & 63; float s = 0.f;
#pragma unroll
            for (int ww = 0; ww < 8; ++ww) s += red[(ww * 8 + b) * 64 + n];
            mod[((size_t)l * 8 + b) * 6144 + n0 + n] = s + ab[l * 6144 + n0 + n];
        }
        __syncthreads();
    }
}
__device__ __forceinline__ void ph_tables(const Params& p, int gt, int ngt) {
    const int* pos = (const int*)p.in[2];
    float* cs = PB(WS_COS, float); float* sn = PB(WS_SIN, float);
    for (int i = gt; i < T_ * 16; i += ngt) {
        const int t = i >> 4, j = i & 15;
        const float inv = 1.0f / powf(10000.0f, (float)(2 * j) / 32.0f);
        const float ang = (float)pos[t] * inv;
        cs[i] = (float)cos((double)ang); sn[i] = (float)sin((double)ang);
    }
}
__device__ __forceinline__ void ph_zero_pads(const Params& p, int gt, int ngt) {
    bf16_t* up = PB(A_UP, bf16_t);
    for (int i = gt; i < B_ * 4 * D_; i += ngt) {
        const int b = i / (4 * D_), r = (i / D_) & 3, c = i & (D_ - 1);
        const int row = (r < 2) ? r : (S_ + r);
        up[((size_t)b * SP + row) * D_ + c] = 0;
    }
}
__device__ __forceinline__ void ph_norm(const Params& p, int l, int sub, int gw, int ngw, int lane) {
    const float* xsrc = (l == 0 && sub == 1) ? p.in[0] : p.out;
    const bool combine = (sub == 1 && l > 0 && ((l - 1) & 1));
    const bool route = (sub == 2 && (l & 1));
    const float* g = p.in[sub == 1 ? 5 : 6] + l * D_;
    const float* mod = PB(WS_MOD, float);
    bf16_t* XN = PB(A_XN, bf16_t);
    const float* Y0 = PB(A_Y0, float); const float* Y1 = PB(A_Y1, float);
    const float* wr = p.in[25] + (size_t)(l >> 1) * D_ * NE;
    unsigned* cnt = PB(WS_CTL, unsigned) + CW_CNT + (l >> 1) * 1024;
    int* list = PB(WS_LIST, int); float* tw = PB(WS_TW, float);
    for (int row = gw; row < T_; row += ngw) {
        const int b = row / S_;
        const float* mrow = mod + ((size_t)l * 8 + b) * 6144 + (sub == 1 ? 0 : 3072);
        f32x4 v[4];
#pragma unroll
        for (int j = 0; j < 4; ++j) v[j] = *(const f32x4*)(xsrc + (size_t)row * D_ + 4 * lane + 256 * j);
        if (combine) {
            const float* g2 = mod + ((size_t)(l - 1) * 8 + b) * 6144 + 5120;
#pragma unroll
            for (int j = 0; j < 4; ++j) {
                const size_t o = (size_t)row * D_ + 4 * lane + 256 * j;
                const f32x4 a = *(const f32x4*)(Y0 + o), c2 = *(const f32x4*)(Y1 + o), gg = *(const f32x4*)(g2 + 4 * lane + 256 * j);
                v[j] = v[j] + gg * (a + c2);
                *(f32x4*)(p.out + o) = v[j];
            }
        }
        float ss = 0.f;
#pragma unroll
        for (int j = 0; j < 4; ++j) ss += (v[j].x * v[j].x + v[j].y * v[j].y) + (v[j].z * v[j].z + v[j].w * v[j].w);
        ss = wave_sum(ss);
        const float rstd = rsqrtf(ss * (1.0f / D_) + EPS);
        f32x4 hh[4];
#pragma unroll
        for (int j = 0; j < 4; ++j) {
            const int c0 = 4 * lane + 256 * j;
            const f32x4 gg = *(const f32x4*)(g + c0), sh = *(const f32x4*)(mrow + c0), sc = *(const f32x4*)(mrow + 1024 + c0);
            hh[j] = v[j] * rstd * gg * (sc + 1.0f) + sh;
            u32x2 o; o.x = pk2(hh[j].x, hh[j].y); o.y = pk2(hh[j].z, hh[j].w);
            *(u32x2*)(XN + (size_t)row * D_ + c0) = o;
        }
        if (route) {
            float lg[8];
#pragma unroll
            for (int e = 0; e < 8; ++e) lg[e] = 0.f;
#pragma unroll
            for (int j = 0; j < 4; ++j)
#pragma unroll
                for (int i = 0; i < 4; ++i) {
                    const int k = 4 * lane + 256 * j + i; const float hv = hh[j][i];
                    const f32x4 w0 = *(const f32x4*)(wr + (size_t)k * 8), w1 = *(const f32x4*)(wr + (size_t)k * 8 + 4);
                    lg[0] += hv * w0.x; lg[1] += hv * w0.y; lg[2] += hv * w0.z; lg[3] += hv * w0.w;
                    lg[4] += hv * w1.x; lg[5] += hv * w1.y; lg[6] += hv * w1.z; lg[7] += hv * w1.w;
                }
#pragma unroll
            for (int e = 0; e < 8; ++e) lg[e] = wave_sum(lg[e]);
            int i1 = 0; float v1 = lg[0];
#pragma unroll
            for (int e = 1; e < 8; ++e) if (lg[e] > v1) { v1 = lg[e]; i1 = e; }
            int i2 = -1; float v2 = -3.0e38f;
#pragma unroll
            for (int e = 0; e < 8; ++e) if (e != i1 && lg[e] > v2) { v2 = lg[e]; i2 = e; }
            const float ex = __expf(v2 - v1), w1 = 1.0f / (1.0f + ex), w2 = ex * w1;
            if (lane == 0) {
                const unsigned p1 = atomicAdd(cnt + 64 * i1, 1u); list[(size_t)i1 * T_ + p1] = row * 2;
                const unsigned p2 = atomicAdd(cnt + 64 * i2, 1u); list[(size_t)i2 * T_ + p2] = row * 2 + 1;
                tw[row * 2] = w1; tw[row * 2 + 1] = w2;
            }
        }
    }
}
__device__ __forceinline__ void ph_final(const Params& p, int gt, int ngt) {
    const float* mod = PB(WS_MOD, float); const float* Y0 = PB(A_Y0, float); const float* Y1 = PB(A_Y1, float);
    for (int i = gt; i < T_ * D_ / 4; i += ngt) {
        const int row = i >> 8, c0 = (i & 255) * 4, b = row / S_;
        const f32x4 gg = *(const f32x4*)(mod + ((size_t)(L_ - 1) * 8 + b) * 6144 + 5120 + c0);
        const size_t o = (size_t)row * D_ + c0;
        *(f32x4*)(p.out + o) = *(const f32x4*)(p.out + o) + gg * (*(const f32x4*)(Y0 + o) + *(const f32x4*)(Y1 + o));
    }
}
__device__ __forceinline__ void ph_prep1(const Params& p, int l, int gw, int ngw, int lane) {
    const bf16_t* CQKV = PB(A_CQKV, bf16_t); bf16_t* CQN = PB(A_CQN, bf16_t);
    const float* KR = PB(A_KR, float); float* KPE = PB(A_KPE, float);
    const float* cs = PB(WS_COS, float); const float* sn = PB(WS_SIN, float);
    const float* g = (lane < 32 ? p.in[8] + l * 256 + lane * 8 : p.in[9] + l * 256 + (lane - 32) * 8);
    float gv[8];
#pragma unroll
    for (int i = 0; i < 8; ++i) gv[i] = g[i];
    for (int row = gw; row < T_; row += ngw) {
        const u32x4 raw = *(const u32x4*)(CQKV + (size_t)row * 512 + lane * 8);
        float v[8];
#pragma unroll
        for (int i = 0; i < 4; ++i) { v[2 * i] = __uint_as_float(raw[i] << 16); v[2 * i + 1] = __uint_as_float(raw[i] & 0xffff0000u); }
        float ss = 0.f;
#pragma unroll
        for (int i = 0; i < 8; ++i) ss += v[i] * v[i];
#pragma unroll
        for (int o = 1; o < 32; o <<= 1) ss += __shfl_xor(ss, o);
        const float rstd = rsqrtf(ss * (1.0f / 256.0f) + EPS);
        u32x4 o4;
#pragma unroll
        for (int i = 0; i < 4; ++i) o4[i] = pk2(v[2 * i] * rstd * gv[2 * i], v[2 * i + 1] * rstd * gv[2 * i + 1]);
        *(u32x4*)(CQN + (size_t)row * 512 + lane * 8) = o4;
        if (lane < 16) {
            const float x1 = KR[(size_t)row * 32 + lane], x2 = KR[(size_t)row * 32 + 16 + lane];
            const float c = cs[(size_t)row * 16 + lane], s = sn[(size_t)row * 16 + lane];
            KPE[(size_t)row * 32 + lane] = x1 * c - x2 * s; KPE[(size_t)row * 32 + 16 + lane] = x1 * s + x2 * c;
        }
    }
}
__device__ __forceinline__ void ph_prep2(const Params& p, int l, int gw, int ngw, int lane) {
    const bf16_t* QR = PB(A_QR, bf16_t); const bf16_t* KVR = PB(A_KVR, bf16_t); const float* KPE = PB(A_KPE, float);
    const float* cs = PB(WS_COS, float); const float* sn = PB(WS_SIN, float);
    bf16_t* Q = PB(A_Q, bf16_t); bf16_t* K = PB(A_K, bf16_t); bf16_t* V = PB(A_V, bf16_t);
    const int h = lane >> 3, sub = lane & 7;
    float qg[16], kg[16];
#pragma unroll
    for (int i = 0; i < 16; ++i) { qg[i] = sub < 6 ? p.in[12][l * QKD + sub * 16 + i] : 0.f; kg[i] = sub < 6 ? p.in[13][l * QKD + sub * 16 + i] : 0.f; }
    for (int row = gw; row < T_; row += ngw) {
        const int b = row / S_, s = row % S_;
        float c16[16], s16[16];
#pragma unroll
        for (int i = 0; i < 4; ++i) { const f32x4 a = *(const f32x4*)(cs + (size_t)row * 16 + 4 * i), d = *(const f32x4*)(sn + (size_t)row * 16 + 4 * i);
            c16[4 * i] = a.x; c16[4 * i + 1] = a.y; c16[4 * i + 2] = a.z; c16[4 * i + 3] = a.w; s16[4 * i] = d.x; s16[4 * i + 1] = d.y; s16[4 * i + 2] = d.z; s16[4 * i + 3] = d.w; }
        float v[16];
        {
            u32x4 r0 = {0, 0, 0, 0}, r1 = {0, 0, 0, 0};
            if (sub < 6) { r0 = *(const u32x4*)(QR + (size_t)row * 1024 + h * 128 + sub * 16); r1 = *(const u32x4*)(QR + (size_t)row * 1024 + h * 128 + sub * 16 + 8); }
#pragma unroll
            for (int i = 0; i < 4; ++i) { v[2 * i] = __uint_as_float(r0[i] << 16); v[2 * i + 1] = __uint_as_float(r0[i] & 0xffff0000u); v[8 + 2 * i] = __uint_as_float(r1[i] << 16); v[9 + 2 * i] = __uint_as_float(r1[i] & 0xffff0000u); }
        }
        {
            float o[16];
#pragma unroll
            for (int i = 0; i < 16; ++i) { const float pr = __shfl_xor(v[i], 1);
                o[i] = (sub == 4) ? (v[i] * c16[i] - pr * s16[i]) : ((sub == 5) ? (pr * s16[i] + v[i] * c16[i]) : v[i]); }
            float ss = 0.f;
#pragma unroll
            for (int i = 0; i < 16; ++i) ss += o[i] * o[i];
            ss += __shfl_xor(ss, 1); ss += __shfl_xor(ss, 2); ss += __shfl_xor(ss, 4);
            const float rstd = rsqrtf(ss * (1.0f / QKD) + EPS) * QSCALE;
            if (sub < 6) {
                u32x4 w0, w1;
#pragma unroll
                for (int i = 0; i < 4; ++i) { w0[i] = pk2(o[2 * i] * rstd * qg[2 * i], o[2 * i + 1] * rstd * qg[2 * i + 1]); w1[i] = pk2(o[8 + 2 * i] * rstd * qg[8 + 2 * i], o[9 + 2 * i] * rstd * qg[9 + 2 * i]); }
                bf16_t* dst = Q + (((size_t)b * H_ + h) * S_ + s) * QKD + sub * 16;
                *(u32x4*)dst = w0; *(u32x4*)(dst + 8) = w1;
            }
        }
        {
            if (sub < 4) {
                const u32x4 r0 = *(const u32x4*)(KVR + (size_t)row * 1024 + h * 128 + sub * 16), r1 = *(const u32x4*)(KVR + (size_t)row * 1024 + h * 128 + sub * 16 + 8);
#pragma unroll
                for (int i = 0; i < 4; ++i) { v[2 * i] = __uint_as_float(r0[i] << 16); v[2 * i + 1] = __uint_as_float(r0[i] & 0xffff0000u); v[8 + 2 * i] = __uint_as_float(r1[i] << 16); v[9 + 2 * i] = __uint_as_float(r1[i] & 0xffff0000u); }
            } else if (sub < 6) {
#pragma unroll
                for (int i = 0; i < 4; ++i) { const f32x4 a = *(const f32x4*)(KPE + (size_t)row * 32 + (sub - 4) * 16 + 4 * i); v[4 * i] = a.x; v[4 * i + 1] = a.y; v[4 * i + 2] = a.z; v[4 * i + 3] = a.w; }
            } else {
#pragma unroll
                for (int i = 0; i < 16; ++i) v[i] = 0.f;
            }
            float ss = 0.f;
#pragma unroll
            for (int i = 0; i < 16; ++i) ss += v[i] * v[i];
            ss += __shfl_xor(ss, 1); ss += __shfl_xor(ss, 2); ss += __shfl_xor(ss, 4);
            const float rstd = rsqrtf(ss * (1.0f / QKD) + EPS);
            if (sub < 6) {
                u32x4 w0, w1;
#pragma unroll
                for (int i = 0; i < 4; ++i) { w0[i] = pk2(v[2 * i] * rstd * kg[2 * i], v[2 * i + 1] * rstd * kg[2 * i + 1]); w1[i] = pk2(v[8 + 2 * i] * rstd * kg[8 + 2 * i], v[9 + 2 * i] * rstd * kg[9 + 2 * i]); }
                bf16_t* dst = K + (((size_t)b * H_ + h) * S_ + s) * QKD + sub * 16;
                *(u32x4*)dst = w0; *(u32x4*)(dst + 8) = w1;
            }
        }
        *(u32x4*)(V + (((size_t)b * H_ + h) * S_ + s) * VD + sub * 8) = *(const u32x4*)(KVR + (size_t)row * 1024 + h * 128 + 64 + sub * 8);
    }
}
constexpr int SCH = 32, NCH = S_ / SCH;
__device__ __forceinline__ void ph_scan_agg(const Params& p, int gt, int ngt) {
    const bf16_t* LAB = PB(A_LAB, bf16_t); f32x4* AGG = PB(WS_AGG, f32x4);
    for (int it = gt; it < B_ * NCH * D_; it += ngt) {
        const int ch = it & (D_ - 1), c = (it >> 10) & (NCH - 1), b = it >> 16;
        const size_t r0 = (size_t)b * S_ + (size_t)c * SCH;
        float Af = 0.f, Hf = 0.f, Ab = 0.f, Hb = 0.f, Pb = 1.f;
        for (int t = 0; t < SCH; ++t) {
            const u32x2 w = *(const u32x2*)(LAB + ((r0 + t) * D_ + ch) * 4);
            const float laf = __uint_as_float(w.x << 16), bfv = __uint_as_float(w.x & 0xffff0000u), lab = __uint_as_float(w.y << 16), bbv = __uint_as_float(w.y & 0xffff0000u);
            Hf = __expf(laf) * Hf + bfv; Af += laf;
            Hb += Pb * bbv; Pb *= __expf(lab); Ab += lab;
        }
        AGG[it] = (f32x4){__expf(Af), Hf, __expf(Ab), Hb};
    }
}
__device__ __forceinline__ void ph_scan_fin(const Params& p, int gt, int ngt) {
    const bf16_t* LAB = PB(A_LAB, bf16_t); const f32x4* AGG = PB(WS_AGG, f32x4);
    const bf16_t* YG = PB(A_YG, bf16_t); bf16_t* HL = PB(A_HL, bf16_t);
    for (int it = gt; it < B_ * NCH * D_; it += ngt) {
        const int ch = it & (D_ - 1), c = (it >> 10) & (NCH - 1), b = it >> 16;
        const size_t r0 = (size_t)b * S_ + (size_t)c * SCH;
        float hf = 0.f, hb = 0.f;
        for (int cc = 0; cc < c; ++cc) { const f32x4 a = AGG[((size_t)b * NCH + cc) * D_ + ch]; hf = a.x * hf + a.y; }
        for (int cc = NCH - 1; cc > c; --cc) { const f32x4 a = AGG[((size_t)b * NCH + cc) * D_ + ch]; hb = a.z * hb + a.w; }
        float hfv[SCH];
#pragma unroll
        for (int t = 0; t < SCH; ++t) {
            const unsigned w = *(const unsigned*)(LAB + ((r0 + t) * D_ + ch) * 4);
            hf = __expf(__uint_as_float(w << 16)) * hf + __uint_as_float(w & 0xffff0000u); hfv[t] = hf;
        }
#pragma unroll
        for (int t = SCH - 1; t >= 0; --t) {
            const unsigned w = *(const unsigned*)(LAB + ((r0 + t) * D_ + ch) * 4 + 2);
            hb = __expf(__uint_as_float(w << 16)) * hb + __uint_as_float(w & 0xffff0000u);
            HL[(r0 + t) * D_ + ch] = f2bf((hfv[t] + hb) * bf2f(YG[(r0 + t) * D_ + ch]));
        }
    }
}

enum { TH_MOD, TH_TABLES, TH_NORM1, TH_NORM2, TH_FINAL, TH_PREP1, TH_PREP2, TH_SCANA, TH_SCANF };
template <int PH> __global__ __launch_bounds__(512) void k_thin(Params p, int l) {
    extern __shared__ __attribute__((aligned(16))) unsigned char dyn_lds[];
    const int tid = threadIdx.x, lane = tid & 63, w = tid >> 6;
    const int gw = blockIdx.x * 8 + w, ngw = gridDim.x * 8, gt = blockIdx.x * 512 + tid, ngt = gridDim.x * 512;
    if constexpr (PH == TH_MOD) ph_mod(p, (float*)dyn_lds, blockIdx.x, gridDim.x);
    if constexpr (PH == TH_TABLES) ph_tables(p, gt, ngt);
    if constexpr (PH == TH_NORM1) { ph_zero_pads(p, gt, ngt); ph_norm(p, l, 1, gw, ngw, lane); }
    if constexpr (PH == TH_NORM2) ph_norm(p, l, 2, gw, ngw, lane);
    if constexpr (PH == TH_FINAL) ph_final(p, gt, ngt);
    if constexpr (PH == TH_PREP1) ph_prep1(p, l, gw, ngw, lane);
    if constexpr (PH == TH_PREP2) ph_prep2(p, l, gw, ngw, lane);
    if constexpr (PH == TH_SCANA) ph_scan_agg(p, gt, ngt);
    if constexpr (PH == TH_SCANF) ph_scan_fin(p, gt, ngt);
}

template <class F, bool DUAL> __global__ __launch_bounds__(256) void naive_gemm(F f) {
    __shared__ float As[16][65], Bs[16][65], B2s[DUAL ? 16 : 1][65];
    const int z = blockIdx.z, M = f.M(z), N = f.N, K = f.K;
    const int m0 = blockIdx.y * 64, n0 = blockIdx.x * 64;
    if (m0 >= M) return;
    const int tid = threadIdx.x, ty = tid >> 4, tx = tid & 15;
    float acc[4][4], acc2[4][4];
#pragma unroll
    for (int i = 0; i < 4; ++i)
#pragma unroll
        for (int j = 0; j < 4; ++j) { acc[i][j] = 0.f; acc2[i][j] = 0.f; }
    for (int k0 = 0; k0 < K; k0 += 16) {
#pragma unroll
        for (int i = 0; i < 4; ++i) {
            const int idx = tid + i * 256;
            { const int k = idx & 15, m = idx >> 4; As[k][m] = (m0 + m < M) ? f.a(z, m0 + m, k0 + k) : 0.f; }
            { const int n = idx & 63, k = idx >> 6; Bs[k][n] = (n0 + n < N) ? f.b(z, k0 + k, n0 + n) : 0.f;
              if constexpr (DUAL) B2s[k][n] = (n0 + n < N) ? f.b2(z, k0 + k, n0 + n) : 0.f; }
        }
        __syncthreads();
#pragma unroll
        for (int k = 0; k < 16; ++k) {
            float a[4], b[4], b2[4];
#pragma unroll
            for (int i = 0; i < 4; ++i) { a[i] = As[k][ty * 4 + i]; b[i] = Bs[k][tx * 4 + i]; if constexpr (DUAL) b2[i] = B2s[k][tx * 4 + i]; }
#pragma unroll
            for (int i = 0; i < 4; ++i)
#pragma unroll
                for (int j = 0; j < 4; ++j) { acc[i][j] += a[i] * b[j]; if constexpr (DUAL) acc2[i][j] += a[i] * b2[j]; }
        }
        __syncthreads();
    }
#pragma unroll
    for (int i = 0; i < 4; ++i)
#pragma unroll
        for (int j = 0; j < 4; ++j) { const int m = m0 + ty * 4 + i, n = n0 + tx * 4 + j; if (m < M && n < N) f.c(z, m, n, acc[i][j], acc2[i][j]); }
}
struct FWin { Params p; int l; int N, K; int pad;
    __device__ int M(int) const { return T_; }
    __device__ float a(int, int m, int k) const { return bf2f(PB(A_XN, bf16_t)[(size_t)m * D_ + k]); }
    __device__ float b(int, int k, int n) const { return p.in[7][((size_t)l * D_ + k) * INC + n]; }
    __device__ void c(int, int m, int n, float acc, float) const {
        if (n < 512) PB(A_CQKV, bf16_t)[(size_t)m * 512 + n] = f2bf(acc);
        else if (n < 544) PB(A_KR, float)[(size_t)m * 32 + n - 512] = acc;
        else if (n < 1568) { const int b = m / S_, s = m % S_; PB(A_UP, bf16_t)[((size_t)b * SP + 2 + s) * D_ + n - 544] = f2bf(acc); }
        else if (n < 2592) PB(A_YG, bf16_t)[(size_t)m * D_ + n - 1568] = f2bf(gelu_tanh(acc));
        else PB(A_G, bf16_t)[(size_t)m * 2048 + n - 2592] = f2bf(sigmoidf_(acc));
    } };
struct FQ { Params p; int l; int N, K; int pad;
    __device__ int M(int) const { return T_; }
    __device__ float a(int, int m, int k) const { return bf2f(PB(A_CQN, bf16_t)[(size_t)m * 512 + k]); }
    __device__ float b(int, int k, int n) const { return p.in[10][((size_t)l * 256 + k) * 768 + n]; }
    __device__ void c(int, int m, int n, float acc, float) const { PB(A_QR, bf16_t)[(size_t)m * 1024 + (n / 96) * 128 + n % 96] = f2bf(acc); } };
struct FKV { Params p; int l; int N, K; int pad;
    __device__ int M(int) const { return T_; }
    __device__ float a(int, int m, int k) const { return bf2f(PB(A_CQN, bf16_t)[(size_t)m * 512 + 256 + k]); }
    __device__ float b(int, int k, int n) const { return p.in[11][((size_t)l * 256 + k) * 1024 + n]; }
    __device__ void c(int, int m, int n, float acc, float) const { PB(A_KVR, bf16_t)[(size_t)m * 1024 + n] = f2bf(acc); } };
struct FZ1 { Params p; int l; int N, K; int pad;
    __device__ int M(int) const { return T_; }
    __device__ float a(int, int m, int k) const { return bf2f(PB(A_HL, bf16_t)[(size_t)m * D_ + k]); }
    __device__ float b(int, int k, int n) const { return p.in[20][((size_t)l * D_ + k) * D_ + n]; }
    __device__ void c(int, int m, int n, float acc, float) const { PB(A_Z1, float)[(size_t)m * D_ + n] = bf2f(PB(A_G, bf16_t)[(size_t)m * 2048 + n]) * acc; } };
struct FZ { Params p; int l; int N, K; int pad;
    __device__ int M(int) const { return T_; }
    __device__ float a(int, int m, int k) const { return bf2f(PB(A_O, bf16_t)[(size_t)m * 512 + k]); }
    __device__ float b(int, int k, int n) const { return p.in[14][((size_t)l * 512 + k) * D_ + n]; }
    __device__ void c(int, int m, int n, float acc, float) const { PB(A_Z, bf16_t)[(size_t)m * D_ + n] = f2bf(PB(A_Z1, float)[(size_t)m * D_ + n] + bf2f(PB(A_G, bf16_t)[(size_t)m * 2048 + 1024 + n]) * acc); } };
struct FRes { Params p; int l; int N, K; int pad;
    __device__ int M(int) const { return T_; }
    __device__ float a(int, int m, int k) const { return bf2f(PB(A_Z, bf16_t)[(size_t)m * D_ + k]); }
    __device__ float b(int, int k, int n) const { return p.in[21][((size_t)l * D_ + k) * D_ + n]; }
    __device__ void c(int, int m, int n, float acc, float) const { const float* xs = (l == 0) ? p.in[0] : p.out; const int b = m / S_;
        p.out[(size_t)m * D_ + n] = xs[(size_t)m * D_ + n] + PB(WS_MOD, float)[((size_t)l * 8 + b) * 6144 + 2048 + n] * acc; } };
struct FUp { Params p; int l; int N, K; int pad;
    __device__ int M(int) const { return T_; }
    __device__ float a(int, int m, int k) const { return bf2f(PB(A_XN, bf16_t)[(size_t)m * D_ + k]); }
    __device__ float b(int, int k, int n) const { return p.in[22][((size_t)(l >> 1) * D_ + k) * FF + n]; }
    __device__ float b2(int, int k, int n) const { return p.in[23][((size_t)(l >> 1) * D_ + k) * FF + n]; }
    __device__ void c(int, int m, int n, float acc, float acc2) const { PB(A_HID, bf16_t)[(size_t)m * FF + n] = f2bf(siluf_(acc) * acc2); } };
struct FDown { Params p; int l; int N, K; int pad;
    __device__ int M(int) const { return T_; }
    __device__ float a(int, int m, int k) const { return bf2f(PB(A_HID, bf16_t)[(size_t)m * FF + k]); }
    __device__ float b(int, int k, int n) const { return p.in[24][((size_t)(l >> 1) * FF + k) * D_ + n]; }
    __device__ void c(int, int m, int n, float acc, float) const { const int b = m / S_;
        p.out[(size_t)m * D_ + n] += PB(WS_MOD, float)[((size_t)l * 8 + b) * 6144 + 5120 + n] * acc; } };
__device__ __forceinline__ int moe_rowbase(const unsigned* cnt, int e) { int rb = 0; for (int i = 0; i < e; ++i) rb += (int)((cnt[64 * i] + 255u) >> 8) << 8; return rb; }
struct FMUp { Params p; int l; int N, K; int pad;
    __device__ int M(int z) const { return (int)(PB(WS_CTL, unsigned) + CW_CNT + (l >> 1) * 1024)[64 * z]; }
    __device__ float a(int z, int m, int k) const { const int tok = PB(WS_LIST, int)[(size_t)z * T_ + m] >> 1; return bf2f(PB(A_XN, bf16_t)[(size_t)tok * D_ + k]); }
    __device__ float b(int z, int k, int n) const { return p.in[26][(((size_t)(l >> 1) * NE + z) * D_ + k) * FF + n]; }
    __device__ float b2(int z, int k, int n) const { return p.in[27][(((size_t)(l >> 1) * NE + z) * D_ + k) * FF + n]; }
    __device__ void c(int z, int m, int n, float acc, float acc2) const { const int rb = moe_rowbase(PB(WS_CTL, unsigned) + CW_CNT + (l >> 1) * 1024, z); PB(A_HID, bf16_t)[(size_t)(rb + m) * FF + n] = f2bf(siluf_(acc) * acc2); } };
struct FMDown { Params p; int l; int N, K; int pad;
    __device__ int M(int z) const { return (int)(PB(WS_CTL, unsigned) + CW_CNT + (l >> 1) * 1024)[64 * z]; }
    __device__ float a(int z, int m, int k) const { const int rb = moe_rowbase(PB(WS_CTL, unsigned) + CW_CNT + (l >> 1) * 1024, z); return bf2f(PB(A_HID, bf16_t)[(size_t)(rb + m) * FF + k]); }
    __device__ float b(int z, int k, int n) const { return p.in[28][(((size_t)(l >> 1) * NE + z) * FF + k) * D_ + n]; }
    __device__ void c(int z, int m, int n, float acc, float) const { const int ent = PB(WS_LIST, int)[(size_t)z * T_ + m]; const int tok = ent >> 1;
        float* Y = (ent & 1) ? PB(A_Y1, float) : PB(A_Y0, float); Y[(size_t)tok * D_ + n] = PB(WS_TW, float)[ent] * acc; } };

__global__ __launch_bounds__(256) void naive_gates(Params p, int l) {
    const size_t gid = (size_t)blockIdx.x * 256 + threadIdx.x;
    const int ch = (int)(gid & (D_ - 1)), t = (int)(gid >> 10), b = t / S_, s = t % S_, nb = ch >> 7, e = ch & 127;
    const bf16_t* UP = PB(A_UP, bf16_t);
    const float* cw = p.in[15] + (size_t)l * 4 * D_; const float* cb = p.in[16] + (size_t)l * D_;
    const float* gw = p.in[17] + (size_t)l * 4 * NE * 128 * 128;
    const float* gb = p.in[18] + (size_t)l * 4 * D_;
    const float* ap = p.in[19] + (size_t)l * 2 * D_;
    float acc[4];
#pragma unroll
    for (int q = 0; q < 4; ++q) acc[q] = gb[q * D_ + ch];
    const bf16_t* urow = UP + ((size_t)b * SP + s) * D_;
    float ucme = 0.f;
    for (int d = 0; d < 128; ++d) {
        const int c = nb * 128 + d;
        float uc = cb[c];
#pragma unroll
        for (int tap = 0; tap < 4; ++tap) uc += bf2f(urow[(size_t)tap * D_ + c]) * cw[tap * D_ + c];
        if (d == e) ucme = uc;
#pragma unroll
        for (int q = 0; q < 4; ++q) acc[q] += uc * gw[(((size_t)q * NE + nb) * 128 + d) * 128 + e];
    }
    bf16_t* LAB = PB(A_LAB, bf16_t);
    unsigned w[2];
#pragma unroll
    for (int dir = 0; dir < 2; ++dir) {
        const float r = sigmoidf_(acc[dir * 2]), ig = sigmoidf_(acc[dir * 2 + 1]);
        const float la = -8.0f * r * softplusf_(ap[dir * D_ + ch]);
        float mult = sqrtf(-expm1f(2.0f * la));
        if ((dir == 0 && s == 0) || (dir == 1 && s == S_ - 1)) mult = 1.0f;
        w[dir] = pk2(la, mult * ig * ucme);
    }
    *(u32x2*)(LAB + ((size_t)t * D_ + ch) * 4) = (u32x2){w[0], w[1]};
}
__global__ __launch_bounds__(256) void naive_attn(Params p) {
    const int gid = blockIdx.x * 256 + threadIdx.x;
    const int q = gid % S_, bh = gid / S_, b = bh / H_, h = bh % H_;
    const bf16_t* Q = PB(A_Q, bf16_t) + ((size_t)bh * S_ + q) * QKD; const bf16_t* K = PB(A_K, bf16_t) + (size_t)bh * S_ * QKD; const bf16_t* V = PB(A_V, bf16_t) + (size_t)bh * S_ * VD;
    float qv[QKD], o[VD];
#pragma unroll
    for (int d = 0; d < QKD; ++d) qv[d] = bf2f(Q[d]);
#pragma unroll
    for (int d = 0; d < VD; ++d) o[d] = 0.f;
    float m = -1e30f, lsum = 0.f;
    for (int j = 0; j < S_; ++j) {
        const u32x4* kr = (const u32x4*)(K + (size_t)j * QKD); float sc = 0.f;
#pragma unroll
        for (int c = 0; c < QKD / 8; ++c) { const u32x4 w = kr[c];
#pragma unroll
            for (int i = 0; i < 4; ++i) sc += qv[c * 8 + 2 * i] * __uint_as_float(w[i] << 16) + qv[c * 8 + 2 * i + 1] * __uint_as_float(w[i] & 0xffff0000u); }
        const float mn = fmaxf(m, sc), al = exp2f(m - mn), pj = exp2f(sc - mn);
        lsum = lsum * al + pj; m = mn;
        const u32x4* vr = (const u32x4*)(V + (size_t)j * VD);
#pragma unroll
        for (int c = 0; c < VD / 8; ++c) { const u32x4 w = vr[c];
#pragma unroll
            for (int i = 0; i < 4; ++i) { o[c * 8 + 2 * i] = o[c * 8 + 2 * i] * al + pj * __uint_as_float(w[i] << 16); o[c * 8 + 2 * i + 1] = o[c * 8 + 2 * i + 1] * al + pj * __uint_as_float(w[i] & 0xffff0000u); } }
    }
    bf16_t* O = PB(A_O, bf16_t) + ((size_t)b * S_ + q) * 512 + h * VD;
    const float inv = 1.0f / lsum;
#pragma unroll
    for (int d = 0; d < VD; ++d) O[d] = f2bf(o[d] * inv);
}

#define LAS __attribute__((address_space(3)))
typedef short bf16x8 __attribute__((ext_vector_type(8)));
#define LDS_WAIT() asm volatile("s_waitcnt lgkmcnt(0)" ::: "memory")

constexpr size_t WE_WIN = 0;
constexpr size_t WE_WUQ = WE_WIN + (size_t)L_ * 4864 * 1024;
constexpr size_t WE_WUKV = WE_WUQ + (size_t)L_ * 1024 * 256;
constexpr size_t WE_WG = WE_WUKV + (size_t)L_ * 1024 * 256;
constexpr size_t WE_WOL = WE_WG + (size_t)L_ * 4096 * 512;
constexpr size_t WE_WOM = WE_WOL + (size_t)L_ * 1024 * 1024;
constexpr size_t WE_WOUT = WE_WOM + (size_t)L_ * 1024 * 512;
constexpr size_t WE_FGU = WE_WOUT + (size_t)L_ * 1024 * 1024;
constexpr size_t WE_FD = WE_FGU + (size_t)2 * 5632 * 1024;
constexpr size_t WE_MGU = WE_FD + (size_t)2 * 1024 * 2816;
constexpr size_t WE_MD = WE_MGU + (size_t)16 * 5632 * 1024;
constexpr size_t WE_END = WE_MD + (size_t)16 * 1024 * 2816;
static_assert(WS_WEI + WE_END * 2 <= WS_AR, "weights region");

__device__ __forceinline__ unsigned cvt_pk_bf16(float lo, float hi) { unsigned r; asm volatile("v_cvt_pk_bf16_f32 %0, %1, %2" : "=v"(r) : "v"(lo), "v"(hi)); return r; }

namespace pg8 {
constexpr int BM = 256, BK = 64, HALF = 128, HTB = HALF * BK * 2, STAGE_BYTES = 8 * HTB, NXCD = 8, WGM = 8;
__host__ __device__ __forceinline__ int lds_byte(int r, int c) { const int st = (r >> 4) * 2 + (c >> 5), rr = r & 15, cc = c & 31, ob = rr * 64 + cc * 2; return st * 1024 + (ob ^ (((ob >> 9) & 1) << 5)); }
__host__ __device__ __forceinline__ void stage_rc(int b, int& R, int& C) { const int st = b / 1024, sb = b % 1024, swz = sb ^ (((sb >> 9) & 1) << 5); R = (st >> 1) * 16 + swz / 64; C = (st & 1) * 32 + (swz % 64) / 2; }
__host__ __device__ __forceinline__ int perm32(int rho) { const int n = rho >> 4, i = rho & 15; return 8 * (i >> 2) + 4 * n + (i & 3); }

struct Unit { int pm, pn; const char* A; const char* B; int aux; };
struct GemmCfg { int lda, ldb, K; unsigned apair; };

struct TileOrder {
    int nM, nN, nwg, G, c;
    __device__ __forceinline__ void init(int nM_, int nN_, int G_, int c_) { nM = nM_; nN = nN_; nwg = nM * nN; G = G_; c = c_; }
    __device__ __forceinline__ bool tile(int i, int& pm, int& pn) const {
        const long L = (long)i * G + c; if (L >= nwg) return false;
        int wgid = (int)L; { const int q = nwg / NXCD, r = nwg % NXCD, xcd = wgid % NXCD, off = wgid / NXCD; wgid = (xcd < r ? xcd * (q + 1) : r * (q + 1) + (xcd - r) * q) + off; }
        const int nig = WGM * nN, gid = wgid / nig, fm = gid * WGM, gsz = (nM - fm) < WGM ? (nM - fm) : WGM;
        pm = fm + ((wgid % nig) % gsz); pn = (wgid % nig) / gsz; return true;
    }
};
struct StdOrder {
    TileOrder T; const char* A0; const char* B0; size_t astep, bstep;
    __device__ __forceinline__ void init(int nM, int nN, int G, int c, const void* A, const void* B, int lda, int ldb) { T.init(nM, nN, G, c); A0 = (const char*)A; B0 = (const char*)B; astep = (size_t)BM * lda * 2; bstep = (size_t)BM * ldb * 2; }
    __device__ __forceinline__ bool next(int i, Unit& u) const { if (!T.tile(i, u.pm, u.pn)) return false; u.A = A0 + u.pm * astep; u.B = B0 + u.pn * bstep; u.aux = 0; return true; }
    __device__ __forceinline__ unsigned row_off(int, int) const { return 0u; }
};

#define PG8_SA(b, h) (((b) * 2 + (h)) * HTB)
#define PG8_SB(b, h) ((4 + (b) * 2 + (h)) * HTB)
#define PG8_GLDS(gp, lp) __builtin_amdgcn_global_load_lds((const unsigned*)(gp), (LAS unsigned*)(lp), 16, 0, 0)
#define PG8_STAGE_B(bufoff, gbase) do { _Pragma("unroll") for (int _i = 0; _i < 2; ++_i) PG8_GLDS((gbase) + voffB[_i], lds + (bufoff) + ldsw + _i * 8192); } while (0)
#define PG8_STAGE_A(bufoff, gbase, h, nx) do { _Pragma("unroll") for (int _i = 0; _i < 2; ++_i) PG8_GLDS((gbase) + ((GATHER && (nx)) ? vAn[h][_i] : vA[h][_i]), lds + (bufoff) + ldsw + _i * 8192); } while (0)
#define PG8_LDA(dst, b, h) do { _Pragma("unroll") for (int m = 0; m < 4; ++m) _Pragma("unroll") for (int k = 0; k < 2; ++k) dst[m][k] = *(const LAS bf16x8*)(lds + PG8_SA(b, h) + aoff + m * 2048 + k * 1024); } while (0)
#define PG8_LDB(dst, b, h) do { _Pragma("unroll") for (int n = 0; n < 2; ++n) _Pragma("unroll") for (int k = 0; k < 2; ++k) dst[n][k] = *(const LAS bf16x8*)(lds + PG8_SB(b, h) + boff + n * 2048 + k * 1024); } while (0)
#define PG8_MMA(ai, bj, At, Bt) do { __builtin_amdgcn_s_setprio(1); _Pragma("unroll") for (int m = 0; m < 4; ++m) _Pragma("unroll") for (int n = 0; n < 2; ++n) _Pragma("unroll") for (int k = 0; k < 2; ++k) \
        acc[ai][bj][m][n] = __builtin_amdgcn_mfma_f32_16x16x32_bf16(Bt[n][k], At[m][k], acc[ai][bj][m][n], 0, 0, 0); __builtin_amdgcn_s_setprio(0); } while (0)
#define PG8_WAIT_V(n) asm volatile("s_waitcnt vmcnt(" #n ")" ::: "memory")
#define PG8_WAIT_L(n) asm volatile("s_waitcnt lgkmcnt(" #n ")" ::: "memory")
#define PG8_BAR __builtin_amdgcn_s_barrier()
#define PG8_SCHED __builtin_amdgcn_sched_barrier(0)

template <class Epi, class Sched, bool ALIGN_EPI, bool GATHER>
__device__ __forceinline__ void gemm_phase(LAS unsigned char* lds, const GemmCfg g, const Sched& S, const Epi& E, int tid_in) {
    int tid = tid_in; asm volatile("" : "+v"(tid));
    const int wid = __builtin_amdgcn_readfirstlane(tid >> 6), lane = tid & 63, wr = wid >> 2, wc = wid & 3, fr = lane & 15, fq = lane >> 4;
    const int nt = g.K / BK;
    unsigned voffB[2], vA[2][2], vAn[2][2]; int Rr[2], Cc[2];
#pragma unroll
    for (int i = 0; i < 2; ++i) { int R, C; stage_rc(tid * 16 + i * 8192, R, C); Rr[i] = R; Cc[i] = C; const int Rb = Epi::PERM ? ((R & ~31) + perm32(R & 31)) : R;
        voffB[i] = (unsigned)(Rb * g.ldb + C) * 2u;
#pragma unroll
        for (int h = 0; h < 2; ++h) { vA[h][i] = (unsigned)((h * HALF + R) * g.lda + C) * 2u; vAn[h][i] = vA[h][i]; } }
    const size_t hstepB = (size_t)HALF * g.ldb * 2;
    const unsigned apair = g.apair;
    const unsigned ldsw = (unsigned)wid * 1024u;
    const int aoff = lds_byte(wr * 64 + fr, fq * 8), boff = lds_byte(wc * 32 + fr, fq * 8);
    Unit cur, nxt; int ui = 0;
    if (!S.next(0, cur)) return;
    if constexpr (GATHER) {
#pragma unroll
        for (int i = 0; i < 2; ++i)
#pragma unroll
            for (int h = 0; h < 2; ++h) { vA[h][i] = S.row_off(0, h * HALF + Rr[i]) + (unsigned)Cc[i] * 2u; vAn[h][i] = vA[h][i]; }
    }
    f32x4 acc[2][2][4][2];
#pragma unroll
    for (int a = 0; a < 2; ++a)
#pragma unroll
        for (int b = 0; b < 2; ++b)
#pragma unroll
            for (int m = 0; m < 4; ++m)
#pragma unroll
                for (int n = 0; n < 2; ++n) acc[a][b][m][n] = (f32x4){0.f, 0.f, 0.f, 0.f};
    bf16x8 At[4][2], B0[2][2], B1[2][2];
    const char* cA = cur.A; const char* cB = cur.B;
    PG8_STAGE_B(PG8_SB(0, 0), cB); PG8_STAGE_B(PG8_SB(0, 1), cB + hstepB); PG8_STAGE_A(PG8_SA(0, 0), cA, 0, false); PG8_STAGE_A(PG8_SA(0, 1), cA, 1, false);
    if (wr == 1) PG8_BAR;
    PG8_WAIT_V(2); PG8_BAR;
    PG8_STAGE_B(PG8_SB(1, 0), cB + 128); PG8_STAGE_A(PG8_SA(1, 0), cA + 128, 0, false); PG8_STAGE_B(PG8_SB(1, 1), cB + hstepB + 128);
    PG8_WAIT_V(6); PG8_BAR;
#pragma unroll 1
    for (;;) {
        const bool has_next = S.next(ui + 1, nxt);
        if constexpr (GATHER) { if (has_next) {
#pragma unroll
            for (int i = 0; i < 2; ++i)
#pragma unroll
                for (int h = 0; h < 2; ++h) vAn[h][i] = S.row_off(ui + 1, h * HALF + Rr[i]) + (unsigned)Cc[i] * 2u; } }
        const char* nA = has_next ? nxt.A : cA; const char* nB = has_next ? nxt.B : cB;
#pragma unroll 1
        for (int t = 0; t < nt; t += 2) {
            const bool last = (t == nt - 2);
            const char* ab = cA + (size_t)(t >> 1) * apair;
            const char* a1 = ab + 128;
            const char* a2 = last ? nA : ab + apair; const char* b2 = last ? nB : cB + (size_t)(t + 2) * 128;
            const char* a3 = a2 + 128; const char* b3 = b2 + 128;
            PG8_LDB(B0, 0, 0); PG8_LDB(B1, 0, 1); PG8_SCHED; PG8_LDA(At, 0, 0); PG8_STAGE_A(PG8_SA(1, 1), a1, 1, false);
            PG8_WAIT_V(8); PG8_WAIT_L(0); PG8_BAR; PG8_MMA(0, 0, At, B0); PG8_MMA(0, 1, At, B1); PG8_BAR; PG8_SCHED;
            PG8_LDA(At, 0, 1); PG8_STAGE_B(PG8_SB(0, 0), b2); PG8_STAGE_B(PG8_SB(0, 1), b2 + hstepB); PG8_STAGE_A(PG8_SA(0, 0), a2, 0, last);
            PG8_WAIT_V(8); PG8_WAIT_L(0); PG8_BAR; PG8_MMA(1, 0, At, B0); PG8_MMA(1, 1, At, B1); PG8_BAR; PG8_SCHED;
            PG8_LDB(B0, 1, 0); PG8_LDB(B1, 1, 1); PG8_SCHED; PG8_LDA(At, 1, 0); PG8_STAGE_A(PG8_SA(0, 1), a2, 1, last);
            PG8_WAIT_V(8); PG8_WAIT_L(0); PG8_BAR; PG8_MMA(0, 0, At, B0); PG8_MMA(0, 1, At, B1); PG8_BAR; PG8_SCHED;
            PG8_LDA(At, 1, 1); PG8_STAGE_B(PG8_SB(1, 0), b3); PG8_STAGE_B(PG8_SB(1, 1), b3 + hstepB); PG8_STAGE_A(PG8_SA(1, 0), a3, 0, last);
            PG8_WAIT_V(8); PG8_WAIT_L(0); PG8_BAR; PG8_MMA(1, 0, At, B0); PG8_MMA(1, 1, At, B1); PG8_BAR; PG8_SCHED;
        }
        if constexpr (ALIGN_EPI) { if (wr == 0) PG8_BAR; }
        E(acc, cur, wr, wc, fr, fq);
        if (!has_next) break;
#pragma unroll
        for (int a = 0; a < 2; ++a)
#pragma unroll
            for (int b = 0; b < 2; ++b)
#pragma unroll
                for (int m = 0; m < 4; ++m)
#pragma unroll
                    for (int n = 0; n < 2; ++n) acc[a][b][m][n] = (f32x4){0.f, 0.f, 0.f, 0.f};
        cur = nxt; cA = nA; cB = nB; ++ui;
        if constexpr (GATHER) {
#pragma unroll
            for (int i = 0; i < 2; ++i)
#pragma unroll
                for (int h = 0; h < 2; ++h) vA[h][i] = vAn[h][i]; }
        if constexpr (ALIGN_EPI) { if (wr == 1) PG8_BAR; }
    }
    PG8_WAIT_V(0);
    if constexpr (!ALIGN_EPI) { if (wr == 0) PG8_BAR; }
    PG8_BAR;
}
}
using pg8::Unit;
typedef f32x4 AccT[2][2][4][2];

__device__ __forceinline__ f32x4 sig4(f32x4 v) { f32x4 o; o.x = sigmoidf_(v.x); o.y = sigmoidf_(v.y); o.z = sigmoidf_(v.z); o.w = sigmoidf_(v.w); return o; }
__device__ __forceinline__ f32x4 gelu4(f32x4 v) { f32x4 o; o.x = gelu_tanh(v.x); o.y = gelu_tanh(v.y); o.z = gelu_tanh(v.z); o.w = gelu_tanh(v.w); return o; }
__device__ __forceinline__ u32x4 pack8(f32x4 a, f32x4 b) { u32x4 w; w.x = cvt_pk_bf16(a.x, a.y); w.y = cvt_pk_bf16(a.z, a.w); w.z = cvt_pk_bf16(b.x, b.y); w.w = cvt_pk_bf16(b.z, b.w); return w; }
__device__ __forceinline__ f32x4 unpack4(u32x2 w) { return (f32x4){__uint_as_float(w.x << 16), __uint_as_float(w.x & 0xffff0000u), __uint_as_float(w.y << 16), __uint_as_float(w.y & 0xffff0000u)}; }

struct EpiWin { static constexpr bool PERM = true; Params p;
    __device__ __forceinline__ void operator()(const AccT& acc, const Unit& u, int wr, int wc, int fr, int fq) const {
        const int pn = u.pn, row0 = u.pm * 256 + wr * 64 + fr, cl = wc * 32 + fq * 8;
        if (pn == 18) {
            if (wc == 0) { float* KR = PB(A_KR, float);
#pragma unroll
                for (int ai = 0; ai < 2; ++ai)
#pragma unroll
                    for (int m = 0; m < 4; ++m) { const size_t row = row0 + ai * 128 + m * 16; *(f32x4*)(KR + row * 32 + fq * 8) = acc[ai][0][m][0]; *(f32x4*)(KR + row * 32 + fq * 8 + 4) = acc[ai][0][m][1]; } }
            return;
        }
        bf16_t* base; int ld, act = 0; bool rmap = false;
        if (pn < 2) { base = PB(A_CQKV, bf16_t) + pn * 256; ld = 512; }
        else if (pn < 6) { base = PB(A_UP, bf16_t) + (pn - 2) * 256; ld = 1024; rmap = true; }
        else if (pn < 10) { base = PB(A_YG, bf16_t) + (pn - 6) * 256; ld = 1024; act = 1; }
        else { base = PB(A_G, bf16_t) + (pn - 10) * 256; ld = 2048; act = 2; }
#pragma unroll
        for (int ai = 0; ai < 2; ++ai)
#pragma unroll
            for (int m = 0; m < 4; ++m) { const int row = row0 + ai * 128 + m * 16; const size_t rr = rmap ? (size_t)(row + (row >> 11) * 4 + 2) : (size_t)row;
#pragma unroll
                for (int bj = 0; bj < 2; ++bj) { f32x4 v0 = acc[ai][bj][m][0], v1 = acc[ai][bj][m][1];
                    if (act == 1) { v0 = gelu4(v0); v1 = gelu4(v1); } else if (act == 2) { v0 = sig4(v0); v1 = sig4(v1); }
                    *(u32x4*)(base + rr * ld + bj * 128 + cl) = pack8(v0, v1); } }
    } };
struct EpiBf { static constexpr bool PERM = true; bf16_t* O; int ld;
    __device__ __forceinline__ void operator()(const AccT& acc, const Unit& u, int wr, int wc, int fr, int fq) const {
        const int row0 = u.pm * 256 + wr * 64 + fr, c0 = u.pn * 256 + wc * 32 + fq * 8;
#pragma unroll
        for (int ai = 0; ai < 2; ++ai)
#pragma unroll
            for (int m = 0; m < 4; ++m) { bf16_t* rp = O + (size_t)(row0 + ai * 128 + m * 16) * ld + c0;
#pragma unroll
                for (int bj = 0; bj < 2; ++bj) *(u32x4*)(rp + bj * 128) = pack8(acc[ai][bj][m][0], acc[ai][bj][m][1]); }
    } };
struct EpiZ1 { static constexpr bool PERM = false; Params p;
    __device__ __forceinline__ void operator()(const AccT& acc, const Unit& u, int wr, int wc, int fr, int fq) const {
        const int row0 = u.pm * 256 + wr * 64 + fr, c0 = u.pn * 256 + wc * 32 + fq * 4; const bf16_t* G = PB(A_G, bf16_t); float* Z1 = PB(A_Z1, float);
#pragma unroll
        for (int ai = 0; ai < 2; ++ai)
#pragma unroll
            for (int m = 0; m < 4; ++m) { const size_t row = row0 + ai * 128 + m * 16;
#pragma unroll
                for (int bj = 0; bj < 2; ++bj)
#pragma unroll
                    for (int n = 0; n < 2; ++n) { const int c = c0 + bj * 128 + n * 16; const f32x4 gg = unpack4(*(const u32x2*)(G + row * 2048 + c)); *(f32x4*)(Z1 + row * D_ + c) = gg * acc[ai][bj][m][n]; } }
    } };
struct EpiZ { static constexpr bool PERM = false; Params p;
    __device__ __forceinline__ void operator()(const AccT& acc, const Unit& u, int wr, int wc, int fr, int fq) const {
        const int row0 = u.pm * 256 + wr * 64 + fr, c0 = u.pn * 256 + wc * 32 + fq * 4; const bf16_t* G = PB(A_G, bf16_t); const float* Z1 = PB(A_Z1, float); bf16_t* Z = PB(A_Z, bf16_t);
#pragma unroll
        for (int ai = 0; ai < 2; ++ai)
#pragma unroll
            for (int m = 0; m < 4; ++m) { const size_t row = row0 + ai * 128 + m * 16;
#pragma unroll
                for (int bj = 0; bj < 2; ++bj)
#pragma unroll
                    for (int n = 0; n < 2; ++n) { const int c = c0 + bj * 128 + n * 16; const f32x4 gg = unpack4(*(const u32x2*)(G + row * 2048 + 1024 + c));
                        const f32x4 v = *(const f32x4*)(Z1 + row * D_ + c) + gg * acc[ai][bj][m][n]; u32x2 w; w.x = cvt_pk_bf16(v.x, v.y); w.y = cvt_pk_bf16(v.z, v.w); *(u32x2*)(Z + row * D_ + c) = w; } }
    } };
struct EpiRes { static constexpr bool PERM = false; const float* xsrc; float* out; const float* gate  ;
    __device__ __forceinline__ void operator()(const AccT& acc, const Unit& u, int wr, int wc, int fr, int fq) const {
        const int row0 = u.pm * 256 + wr * 64 + fr, c0 = u.pn * 256 + wc * 32 + fq * 4; const float* gr = gate + (size_t)(u.pm >> 3) * 6144;
        f32x4 gv[2][2];
#pragma unroll
        for (int bj = 0; bj < 2; ++bj)
#pragma unroll
            for (int n = 0; n < 2; ++n) gv[bj][n] = *(const f32x4*)(gr + c0 + bj * 128 + n * 16);
#pragma unroll
        for (int ai = 0; ai < 2; ++ai)
#pragma unroll
            for (int m = 0; m < 4; ++m) { const size_t row = row0 + ai * 128 + m * 16;
#pragma unroll
                for (int bj = 0; bj < 2; ++bj)
#pragma unroll
                    for (int n = 0; n < 2; ++n) { const int c = c0 + bj * 128 + n * 16; *(f32x4*)(out + row * D_ + c) = *(const f32x4*)(xsrc + row * D_ + c) + gv[bj][n] * acc[ai][bj][m][n]; } }
    } };
struct EpiUp { static constexpr bool PERM = true; bf16_t* HID;
    __device__ __forceinline__ void operator()(const AccT& acc, const Unit& u, int wr, int wc, int fr, int fq) const {
        const int row0 = u.pm * 256 + wr * 64 + fr, c0 = u.pn * 128 + wc * 32 + fq * 8;
#pragma unroll
        for (int ai = 0; ai < 2; ++ai)
#pragma unroll
            for (int m = 0; m < 4; ++m) { const size_t row = row0 + ai * 128 + m * 16; f32x4 h0, h1;
                { const f32x4 a = acc[ai][0][m][0], b = acc[ai][1][m][0]; h0 = (f32x4){siluf_(a.x) * b.x, siluf_(a.y) * b.y, siluf_(a.z) * b.z, siluf_(a.w) * b.w}; }
                { const f32x4 a = acc[ai][0][m][1], b = acc[ai][1][m][1]; h1 = (f32x4){siluf_(a.x) * b.x, siluf_(a.y) * b.y, siluf_(a.z) * b.z, siluf_(a.w) * b.w}; }
                *(u32x4*)(HID + row * FF + c0) = pack8(h0, h1); }
    } };
struct EpiGates { static constexpr bool PERM = false; Params p; int l;
    __device__ __forceinline__ void operator()(const AccT& acc, const Unit& u, int wr, int wc, int fr, int fq) const {
        const int pn = u.pn, ch0 = (pn >> 1) * 128 + (pn & 1) * 64 + 16 * wc + 4 * fq;
        const float* GB = PB(WS_GB, float) + (size_t)l * 4096 + pn * 256 + 32 * wc + 4 * fq;
        const float* SPT = PB(WS_GB, float) + L_ * 4096 + (size_t)l * 2 * D_ + ch0;
        const float* CW = p.in[15] + (size_t)l * 4 * D_ + ch0; const float* CB = p.in[16] + (size_t)l * D_ + ch0;
        const bf16_t* UP = PB(A_UP, bf16_t); bf16_t* LAB = PB(A_LAB, bf16_t);
#pragma unroll
        for (int ai = 0; ai < 2; ++ai)
#pragma unroll
            for (int m = 0; m < 4; ++m) { const int row = u.pm * 256 + ai * 128 + wr * 64 + m * 16 + fr, b = row >> 11, s = row & (S_ - 1);
                asm volatile("" ::: "memory");
                const bf16_t* ur = UP + ((size_t)b * SP + s) * D_ + ch0;
                f32x4 uc = *(const f32x4*)CB;
#pragma unroll
                for (int tap = 0; tap < 4; ++tap) uc = uc + unpack4(*(const u32x2*)(ur + (size_t)tap * D_)) * *(const f32x4*)(CW + tap * D_);
                unsigned w[2][4];
#pragma unroll
                for (int dir = 0; dir < 2; ++dir) { const f32x4 r = sig4(acc[ai][dir][m][0] + *(const f32x4*)(GB + 128 * dir)), ig = sig4(acc[ai][dir][m][1] + *(const f32x4*)(GB + 128 * dir + 16)); const f32x4 la = r * *(const f32x4*)(SPT + dir * D_);
                    const bool first = (dir == 0) ? (s == 0) : (s == S_ - 1);
#pragma unroll
                    for (int j = 0; j < 4; ++j) { const float mult = first ? 1.0f : sqrtf(fmaxf(1.0f - __expf(2.0f * la[j]), 0.f)); w[dir][j] = cvt_pk_bf16(la[j], mult * ig[j] * uc[j]); } }
                u32x4* dst = (u32x4*)(LAB + ((size_t)row * D_ + ch0) * 4);
                dst[0] = (u32x4){w[0][0], w[1][0], w[0][1], w[1][1]}; dst[1] = (u32x4){w[0][2], w[1][2], w[0][3], w[1][3]}; }
    } };
struct GatesOrder {
    pg8::TileOrder T; const char* UPb; const char* B0;
    __device__ __forceinline__ void init(int G, int c, const void* up, const void* wg) { T.init(64, 16, G, c); UPb = (const char*)up; B0 = (const char*)wg; }
    __device__ __forceinline__ bool next(int i, Unit& u) const { if (!T.tile(i, u.pm, u.pn)) return false; const int b = u.pm >> 3, s0 = (u.pm & 7) * 256;
        u.A = UPb + (((size_t)b * SP + s0) * D_ + (u.pn >> 1) * 128) * 2; u.B = B0 + (size_t)u.pn * 256 * 512 * 2; u.aux = 0; return true; }
    __device__ __forceinline__ unsigned row_off(int, int) const { return 0u; }
};

__device__ __forceinline__ void moe_meta_fill(const Params& p, int l, volatile LAS unsigned* meta, int tid) {
    if (tid == 0) { const unsigned* cnt = PB(WS_CTL, unsigned) + CW_CNT + (l >> 1) * 1024; unsigned tb = 0;
        for (int e = 0; e < NE; ++e) { const unsigned c = __hip_atomic_load(cnt + 64 * e, __ATOMIC_RELAXED, __HIP_MEMORY_SCOPE_AGENT); meta[e] = c; meta[8 + e] = tb; tb += (c + 255u) >> 8; }
        meta[16] = tb; }
    __syncthreads();
}
__device__ __forceinline__ int xcd_remap(int L, int nwg) { const int q = nwg / 8, r = nwg % 8, xcd = L % 8, off = L / 8; return (xcd < r ? xcd * (q + 1) : r * (q + 1) + (xcd - r) * q) + off; }
struct MoeOrder {
    volatile LAS unsigned* meta; LAS unsigned* tok; int G, c, npn, nwg; const char* A0; const char* B0; size_t atile, bexp, btile;
    __device__ __forceinline__ void locate(int L, int& rt, int& pn, int& e, int& j) const {
        const int wgid = xcd_remap(L, nwg); rt = wgid / npn; pn = wgid - rt * npn; e = 0;
#pragma unroll
        for (int k = 1; k < NE; ++k) e += (rt >= (int)meta[8 + k]) ? 1 : 0;
        j = rt - (int)meta[8 + e];
    }
    __device__ __forceinline__ bool next(int i, Unit& u) const {
        const int L = i * G + c; if (L >= nwg) return false;
        int rt, pn, e, j; locate(L, rt, pn, e, j);
        rt = __builtin_amdgcn_readfirstlane(rt); pn = __builtin_amdgcn_readfirstlane(pn); e = __builtin_amdgcn_readfirstlane(e); j = __builtin_amdgcn_readfirstlane(j);
        u.pm = rt; u.pn = pn; u.aux = e | (j << 4); u.A = A0 + (size_t)rt * atile; u.B = B0 + (size_t)e * bexp + (size_t)pn * btile; return true;
    }
    __device__ __forceinline__ unsigned row_off(int i, int r) const { return tok[i * 256 + r]; }
    __device__ __forceinline__ void fill_tok(const Params& p, int tid) const {
        const int* list = PB(WS_LIST, int);
        for (int idx = tid; idx < 16 * 256; idx += 512) { const int i = idx >> 8, r = idx & 255, L = i * G + c; unsigned off = 0u;
            if (L < nwg) { int rt, pn, e, j; locate(L, rt, pn, e, j); const int pos = j * 256 + r; if (pos < (int)meta[e]) off = (unsigned)(list[(size_t)e * T_ + pos] >> 1) * (unsigned)(D_ * 2); }
            tok[idx] = off; }
        __syncthreads();
    }
};
struct EpiMoeDown { static constexpr bool PERM = false; Params p; int l;
    __device__ __forceinline__ void operator()(const AccT& acc, const Unit& u, int wr, int wc, int fr, int fq) const {
        const int e = u.aux & 15, j = u.aux >> 4; const int cnt = (int)(PB(WS_CTL, unsigned) + CW_CNT + (l >> 1) * 1024)[64 * e];
        const int* list = PB(WS_LIST, int) + (size_t)e * T_; const float* tw = PB(WS_TW, float); const int c0 = u.pn * 256 + wc * 32 + fq * 4;
#pragma unroll
        for (int ai = 0; ai < 2; ++ai)
#pragma unroll
            for (int m = 0; m < 4; ++m) { const int pos = j * 256 + ai * 128 + wr * 64 + m * 16 + fr;
                if (pos < cnt) { const int ent = list[pos]; const float w = tw[ent]; float* Y = ((ent & 1) ? PB(A_Y1, float) : PB(A_Y0, float)) + (size_t)(ent >> 1) * D_ + c0;
#pragma unroll
                    for (int bj = 0; bj < 2; ++bj)
#pragma unroll
                        for (int n = 0; n < 2; ++n) *(f32x4*)(Y + bj * 128 + n * 16) = acc[ai][bj][m][n] * w; } }
    } };

namespace att {
typedef short s16x4 __attribute__((ext_vector_type(4)));
typedef float f32x16 __attribute__((ext_vector_type(16)));
constexpr int KVBLK = 64, SHM_V = KVBLK * VD * 2  , SHM_K = KVBLK * 256  , LDS_ATT = 2 * SHM_V + 2 * SHM_K + 8 * 64 * 4;
constexpr float THR2 = 11.5f;
#define KSWZ(row, colB) ((row) * 256 + ((colB) ^ (((row) & 7) << 4)))
#define SBAR() __builtin_amdgcn_sched_barrier(0)
__device__ __forceinline__ int crow(int r, int hi) { return (r & 3) + 8 * (r >> 2) + 4 * hi; }
__device__ __forceinline__ void partialSM(f32x16& p0, f32x16& p1, float& m_reg, float& mn, float& alpha) {
    float pmax = p0[0];
#pragma unroll
    for (int r = 1; r < 16; ++r) pmax = fmaxf(pmax, p0[r]);
#pragma unroll
    for (int r = 0; r < 16; ++r) pmax = fmaxf(pmax, p1[r]);
    { auto rr = __builtin_amdgcn_permlane32_swap(__float_as_uint(pmax), __float_as_uint(pmax), false, false); pmax = fmaxf(__uint_as_float(rr[0]), __uint_as_float(rr[1])); }
    if (__builtin_expect(__all(pmax - m_reg <= THR2), 1)) { mn = m_reg; alpha = 1.f; }
    else { mn = fmaxf(m_reg, pmax); alpha = __builtin_amdgcn_exp2f(m_reg - mn); m_reg = mn; }
#pragma unroll
    for (int r = 0; r < 16; ++r) p0[r] = p0[r] - mn;
#pragma unroll
    for (int r = 0; r < 16; ++r) p1[r] = p1[r] - mn;
#pragma unroll
    for (int r = 0; r < 16; ++r) p0[r] = __builtin_amdgcn_exp2f(p0[r]);
}
__device__ __forceinline__ void finishSM(f32x16& p0, f32x16& p1, float alpha, float& l_reg, bf16x8& pa0, bf16x8& pa1, bf16x8& pa2, bf16x8& pa3) {
#pragma unroll
    for (int r = 0; r < 16; ++r) p1[r] = __builtin_amdgcn_exp2f(p1[r]);
    float ps = 0;
#pragma unroll
    for (int r = 0; r < 16; ++r) ps += p0[r];
#pragma unroll
    for (int r = 0; r < 16; ++r) ps += p1[r];
    { auto rr = __builtin_amdgcn_permlane32_swap(__float_as_uint(ps), __float_as_uint(ps), false, false); ps = __uint_as_float(rr[0]) + __uint_as_float(rr[1]); }
    l_reg = l_reg * alpha + ps;
#define PK4(P, BASE, OUT) do { unsigned a0 = cvt_pk_bf16(P[BASE + 0], P[BASE + 1]), a1 = cvt_pk_bf16(P[BASE + 2], P[BASE + 3]);   \
    unsigned b0 = cvt_pk_bf16(P[BASE + 4], P[BASE + 5]), b1 = cvt_pk_bf16(P[BASE + 6], P[BASE + 7]);                              \
    auto r0 = __builtin_amdgcn_permlane32_swap(a0, b0, false, false); auto r1 = __builtin_amdgcn_permlane32_swap(a1, b1, false, false); \
    u32x4 w = {r0[0], r1[0], r0[1], r1[1]}; OUT = *reinterpret_cast<bf16x8*>(&w); } while (0)
    PK4(p0, 0, pa0); PK4(p0, 8, pa1); PK4(p1, 0, pa2); PK4(p1, 8, pa3);
#undef PK4
}
__device__ __forceinline__ void qkt(f32x16& p0, f32x16& p1, const LAS char* Ks, const bf16x8* qr, int r32, int hi) {
    p0 = f32x16{}; p1 = f32x16{};
#pragma unroll
    for (int d0 = 0; d0 < 6; ++d0) { const int cb = (d0 * 16 + hi * 8) * 2;
        const bf16x8 b0 = *(const LAS bf16x8*)(Ks + KSWZ(r32, cb));
        const bf16x8 b1 = *(const LAS bf16x8*)(Ks + KSWZ(32 + r32, cb));
        p0 = __builtin_amdgcn_mfma_f32_32x32x16_bf16(b0, qr[d0], p0, 0, 0, 0);
        p1 = __builtin_amdgcn_mfma_f32_32x32x16_bf16(b1, qr[d0], p1, 0, 0, 0); }
}
__device__ __forceinline__ int v_st(int k, int c) { const int kk = (k & ~0xC) | ((k & 4) << 1) | ((k & 8) >> 1); return ((kk >> 3) * 2 + (c >> 5)) * 512 + ((kk & 7) * 32 + (c & 31)) * 2; }
__device__ __forceinline__ int v_rd_base(int lane) { return ((lane & 3) << 3) | (((lane >> 2) & 3) << 6) | (((lane >> 4) & 1) << 5) | (((lane >> 5) & 1) << 8); }
constexpr int v_rd_off(int d0, int ks, int half) { return d0 * 512 + ks * 2048 + half * 1024; }
template <int OFF> __device__ __forceinline__ s16x4 tr_read(int vb) { s16x4 r; asm volatile("ds_read_b64_tr_b16 %0, %1 offset:%2" : "=&v"(r) : "v"(vb), "i"(OFF) : "memory"); return r; }
template <int D0> __device__ __forceinline__ void pv_one(f32x16& od, int vb, bf16x8 pa0, bf16x8 pa1, bf16x8 pa2, bf16x8 pa3) {
    const s16x4 l0 = tr_read<v_rd_off(D0, 0, 0)>(vb), h0 = tr_read<v_rd_off(D0, 0, 1)>(vb), l1 = tr_read<v_rd_off(D0, 1, 0)>(vb), h1 = tr_read<v_rd_off(D0, 1, 1)>(vb);
    const s16x4 l2 = tr_read<v_rd_off(D0, 2, 0)>(vb), h2 = tr_read<v_rd_off(D0, 2, 1)>(vb), l3 = tr_read<v_rd_off(D0, 3, 0)>(vb), h3 = tr_read<v_rd_off(D0, 3, 1)>(vb);
    asm volatile("s_waitcnt lgkmcnt(0)" ::: "memory"); SBAR();
#define PKV(L, H) (bf16x8){L[0], L[1], L[2], L[3], H[0], H[1], H[2], H[3]}
    od = __builtin_amdgcn_mfma_f32_32x32x16_bf16(pa0, PKV(l0, h0), od, 0, 0, 0);
    od = __builtin_amdgcn_mfma_f32_32x32x16_bf16(pa1, PKV(l1, h1), od, 0, 0, 0);
    od = __builtin_amdgcn_mfma_f32_32x32x16_bf16(pa2, PKV(l2, h2), od, 0, 0, 0);
    od = __builtin_amdgcn_mfma_f32_32x32x16_bf16(pa3, PKV(l3, h3), od, 0, 0, 0);
#undef PKV
}
__device__ __forceinline__ void pv_d0(f32x16* o, int vb, bf16x8 pa0, bf16x8 pa1, bf16x8 pa2, bf16x8 pa3) { pv_one<0>(o[0], vb, pa0, pa1, pa2, pa3); pv_one<1>(o[1], vb, pa0, pa1, pa2, pa3); }

__device__ __forceinline__ void attn_unit(const bf16_t* __restrict__ Qb, const bf16_t* __restrict__ Kh, const bf16_t* __restrict__ Vh, bf16_t* __restrict__ Ob, int seq, LAS char* lds, int tid) {
    const int wid = tid >> 6, lane = tid & 63, r32 = lane & 31, hi = lane >> 5;
    LAS char* V_lds = lds; LAS char* K_lds = lds + 2 * SHM_V;
    LAS float* ws = (LAS float*)(lds + 2 * SHM_V + 2 * SHM_K) + wid * 64; LAS float* li_l = ws; LAS float* al_l = ws + 32;
    float m_reg = -1e30f, l_reg = 0; f32x16 o[2] = {}; bf16x8 qr[6];
    const bf16_t* Qw = Qb + (size_t)(wid * 32 + r32) * QKD + hi * 8;
#pragma unroll
    for (int d0 = 0; d0 < 6; ++d0) qr[d0] = *(const bf16x8*)(Qw + d0 * 16);
    const int vrow = tid >> 3, vch = tid & 7, vst = v_st(vrow, vch * 8);
    const int k0row = tid / 12, k0ch = tid % 12; const bool k1ok = tid < 256; const int id1 = k1ok ? tid + 512 : tid, k1row = id1 / 12, k1ch = id1 % 12;
    const int kst0 = KSWZ(k0row, k0ch * 16), kst1 = KSWZ(k1row, k1ch * 16);
    const int vb0 = (int)(uintptr_t)V_lds + v_rd_base(lane);
    struct { bf16x8 v, k0, k1; } sr_[2];
    const unsigned vgo = (unsigned)(vrow * VD + vch * 8) * 2u, kgo0 = (unsigned)(k0row * QKD + k0ch * 8) * 2u, kgo1 = (unsigned)(k1row * QKD + k1ch * 8) * 2u;
#define SLOAD(i, kk0) do { const char* vt_ = (const char*)Vh + (size_t)(kk0) * (VD * 2); const char* kt_ = (const char*)Kh + (size_t)(kk0) * (QKD * 2); \
    sr_[i].v = *(const bf16x8*)(vt_ + vgo); sr_[i].k0 = *(const bf16x8*)(kt_ + kgo0); sr_[i].k1 = *(const bf16x8*)(kt_ + kgo1); } while (0)
#define SWRITE(b, i) do { *(LAS bf16x8*)(V_lds + (b) * SHM_V + vst) = sr_[i].v; *(LAS bf16x8*)(K_lds + (b) * SHM_K + kst0) = sr_[i].k0; if (k1ok) *(LAS bf16x8*)(K_lds + (b) * SHM_K + kst1) = sr_[i].k1; } while (0)
#define SWAIT() asm volatile("s_waitcnt vmcnt(3)" ::: "memory")
#define RESC(a) do { if (__any((a) < 1.f)) { if (hi == 0) al_l[r32] = (a); asm volatile("s_waitcnt lgkmcnt(0)" ::: "memory"); \
    _Pragma("unroll") for (int d = 0; d < 2; ++d) _Pragma("unroll") for (int r = 0; r < 16; ++r) o[d][r] *= al_l[crow(r, hi)]; } } while (0)
    f32x16 pA0, pA1, pB0, pB1; float mnA, mnB, alA, alB; bf16x8 pa0, pa1, pa2, pa3; const int NT = seq / KVBLK;
    constexpr int SE = 0, SO = 1;
    SLOAD(SE, 0); asm volatile("s_waitcnt vmcnt(0)" ::: "memory"); SWRITE(0, SE); __syncthreads();
    qkt(pA0, pA1, K_lds, qr, r32, hi); partialSM(pA0, pA1, m_reg, mnA, alA);
    SLOAD(SO, KVBLK); if (2 < NT) SLOAD(SE, 2 * KVBLK);
    SWAIT(); SWRITE(1, SO); __syncthreads();
#pragma unroll 1
    for (int j = 1; j + 1 < NT; j += 2) {
        SBAR(); qkt(pB0, pB1, K_lds + SHM_K, qr, r32, hi);
        finishSM(pA0, pA1, alA, l_reg, pa0, pa1, pa2, pa3); SBAR();
        SLOAD(SO, (j + 2) * KVBLK); SBAR();
        pv_d0(o, vb0, pa0, pa1, pa2, pa3); partialSM(pB0, pB1, m_reg, mnB, alB);
        __syncthreads(); SWAIT(); SWRITE(0, SE);
        RESC(alB); __syncthreads();
        SBAR(); qkt(pA0, pA1, K_lds, qr, r32, hi);
        finishSM(pB0, pB1, alB, l_reg, pa0, pa1, pa2, pa3); SBAR();
        if (j + 3 < NT) SLOAD(SE, (j + 3) * KVBLK); SBAR();
        pv_d0(o, vb0 + SHM_V, pa0, pa1, pa2, pa3); partialSM(pA0, pA1, m_reg, mnA, alA);
        __syncthreads(); SWAIT(); SWRITE(1, SO);
        RESC(alA); __syncthreads();
    }
    SBAR(); qkt(pB0, pB1, K_lds + SHM_K, qr, r32, hi);
    finishSM(pA0, pA1, alA, l_reg, pa0, pa1, pa2, pa3); SBAR();
    pv_d0(o, vb0, pa0, pa1, pa2, pa3); partialSM(pB0, pB1, m_reg, mnB, alB);
    __syncthreads(); RESC(alB);
    finishSM(pB0, pB1, alB, l_reg, pa0, pa1, pa2, pa3); SBAR();
    pv_d0(o, vb0 + SHM_V, pa0, pa1, pa2, pa3);
    if (hi == 0) li_l[r32] = l_reg; asm volatile("s_waitcnt lgkmcnt(0)" ::: "memory");
    bf16_t* Ow = Ob + (size_t)(wid * 32) * 512;
#pragma unroll
    for (int r = 0; r < 16; ++r) { const int orow = crow(r, hi); const float rl = __builtin_amdgcn_rcpf(li_l[orow]);
#pragma unroll
        for (int d0 = 0; d0 < 2; ++d0) Ow[(size_t)orow * 512 + d0 * 32 + r32] = f2bf(o[d0][r] * rl); }
    __syncthreads();
#undef SLOAD
#undef SWRITE
#undef SWAIT
#undef RESC
}
#undef KSWZ
#undef SBAR
}
__device__ __forceinline__ void ph_attn(const Params& p, LAS unsigned char* lds, int blk, int G, int tid) {
    const bf16_t* Q = PB(A_Q, bf16_t); const bf16_t* K = PB(A_K, bf16_t); const bf16_t* V = PB(A_V, bf16_t); bf16_t* O = PB(A_O, bf16_t);
#pragma unroll 1
    for (int i = 0;; ++i) {
        const int L = i * G + blk; if (L >= B_ * H_ * 8) break;
        int bh, qb;
        if (G == 256) { const int x = blk & 7, y = blk >> 3; bh = i * 32 + x * 4 + (y >> 3); qb = y & 7; } else { bh = L >> 3; qb = L & 7; }
        const int b = bh >> 3, h = bh & 7;
        att::attn_unit(Q + ((size_t)bh * S_ + qb * 256) * QKD, K + (size_t)bh * S_ * QKD, V + (size_t)bh * S_ * VD, O + ((size_t)b * S_ + qb * 256) * 512 + h * VD, S_, (LAS char*)lds, tid);
    }
}

__device__ __forceinline__ void tr_item(const float* src, size_t ldw, int k0, const float* ksc, bf16_t* dst, int Kd, LAS float* scr, int lane) {
#pragma unroll 8
    for (int i = 0; i < 32; ++i) { const int kk = 2 * i + (lane >> 5); float v = src ? src[(size_t)(k0 + kk) * ldw] : 0.f; if (ksc) v *= ksc[kk]; scr[kk * 33 + (lane & 31)] = v; }
    LDS_WAIT(); asm volatile("" ::: "memory");
    const int c = lane & 7;
#pragma unroll
    for (int j = 0; j < 4; ++j) { const int n = (lane >> 3) + 8 * j; const LAS float* s = scr + (8 * c) * 33 + n;
        u32x4 o; o.x = pk2(s[0 * 33], s[1 * 33]); o.y = pk2(s[2 * 33], s[3 * 33]); o.z = pk2(s[4 * 33], s[5 * 33]); o.w = pk2(s[6 * 33], s[7 * 33]);
        *(u32x4*)(dst + (size_t)n * Kd + 8 * c) = o; }
    LDS_WAIT(); asm volatile("" ::: "memory");
}
__device__ __forceinline__ void p0_weights(const Params& p, LAS float* scr, int gw, int ngw, int lane) {
    bf16_t* WB = PB(WS_WEI, bf16_t);
    constexpr int PER_L = 4992, N_L = L_ * PER_L, PER_F = 4224, N_D = 2 * PER_F, N_M = 16 * PER_F;
    const int cl = lane & 31;
    for (int it = gw; it < N_L + N_D + N_M; it += ngw) {
        const float* src = nullptr; size_t ldw = 0; int k0 = 0; const float* ksc = nullptr; bf16_t* dst = nullptr; int Kd = 0;
        if (it < N_L) {
            const int l = it / PER_L; int r = it % PER_L;
            if (r < 2432) { const int kb = r & 15, nd0 = (r >> 4) * 32; const int sc = nd0 < 512 ? nd0 : (nd0 < 4608 ? nd0 + 32 : (nd0 < 4640 ? 512 + nd0 - 4608 : -1));
                if (sc >= 0) src = p.in[7] + (size_t)l * D_ * INC + sc + cl; ldw = INC; k0 = kb * 64; Kd = 1024; dst = WB + WE_WIN + ((size_t)l * 4864 + nd0) * 1024 + k0; }
            else if ((r -= 2432) < 128) { const int kb = r & 3, nd0 = (r >> 2) * 32, h = nd0 >> 7, d = nd0 & 127;
                if (d < 96) src = p.in[10] + (size_t)l * 256 * 768 + h * 96 + d + cl; ldw = 768; k0 = kb * 64; Kd = 256; dst = WB + WE_WUQ + ((size_t)l * 1024 + nd0) * 256 + k0; }
            else if ((r -= 128) < 128) { const int kb = r & 3, nd0 = (r >> 2) * 32;
                src = p.in[11] + (size_t)l * 256 * 1024 + nd0 + cl; ldw = 1024; k0 = kb * 64; Kd = 256; dst = WB + WE_WUKV + ((size_t)l * 1024 + nd0) * 256 + k0; }
            else if ((r -= 128) < 1024) { const int kh = r & 1, tap = (r >> 1) & 3, grp = (r >> 3) & 7, pn = r >> 6, nbk = pn >> 1, hc = pn & 1, dir = grp >> 2, wc = grp & 3, gate = cl >> 4, e = hc * 64 + 16 * wc + (cl & 15);
                src = p.in[17] + ((((size_t)l * 2 + dir) * 2 + gate) * NE + nbk) * 128 * 128 + e; ldw = 128; k0 = kh * 64; ksc = p.in[15] + ((size_t)l * 4 + tap) * D_ + nbk * 128 + k0; Kd = 512;
                dst = WB + WE_WG + ((size_t)l * 4096 + pn * 256 + grp * 32) * 512 + tap * 128 + k0; }
            else if ((r -= 1024) < 512) { const int kb = r & 15, nd0 = (r >> 4) * 32;
                src = p.in[20] + (size_t)l * D_ * D_ + nd0 + cl; ldw = 1024; k0 = kb * 64; Kd = 1024; dst = WB + WE_WOL + ((size_t)l * 1024 + nd0) * 1024 + k0; }
            else if ((r -= 512) < 256) { const int kb = r & 7, nd0 = (r >> 3) * 32;
                src = p.in[14] + (size_t)l * 512 * D_ + nd0 + cl; ldw = 1024; k0 = kb * 64; Kd = 512; dst = WB + WE_WOM + ((size_t)l * 1024 + nd0) * 512 + k0; }
            else { r -= 256; const int kb = r & 15, nd0 = (r >> 4) * 32;
                src = p.in[21] + (size_t)l * D_ * D_ + nd0 + cl; ldw = 1024; k0 = kb * 64; Kd = 1024; dst = WB + WE_WOUT + ((size_t)l * 1024 + nd0) * 1024 + k0; }
        } else {
            const bool moe = it >= N_L + N_D; int r = moe ? it - N_L - N_D : it - N_L; const int ie = r / PER_F; r %= PER_F;
            const float* Wg = (moe ? p.in[26] : p.in[22]) + (size_t)ie * D_ * FF; const float* Wu = (moe ? p.in[27] : p.in[23]) + (size_t)ie * D_ * FF; const float* Wd = (moe ? p.in[28] : p.in[24]) + (size_t)ie * FF * D_;
            bf16_t* GU = WB + (moe ? WE_MGU : WE_FGU) + (size_t)ie * 5632 * 1024; bf16_t* DN = WB + (moe ? WE_MD : WE_FD) + (size_t)ie * 1024 * 2816;
            if (r < 2816) { const int kb = r & 15, nd0 = (r >> 4) * 32, pn = nd0 >> 8, rr = nd0 & 255;
                src = (rr < 128 ? Wg : Wu) + pn * 128 + (rr & 127) + cl; ldw = FF; k0 = kb * 64; Kd = 1024; dst = GU + (size_t)nd0 * 1024 + k0; }
            else { r -= 2816; const int kb = r % 44, nd0 = (r / 44) * 32;
                src = Wd + nd0 + cl; ldw = 1024; k0 = kb * 64; Kd = 2816; dst = DN + (size_t)nd0 * 2816 + k0; }
        }
        tr_item(src, ldw, k0, ksc, dst, Kd, scr, lane);
    }
}
__device__ __forceinline__ void p0_gbias(const Params& p, int gt, int ngt) {
    float* GB = PB(WS_GB, float);
    for (int idx = gt; idx < L_ * 4096; idx += ngt) {
        const int l = idx >> 12, pn = (idx >> 8) & 15, c = idx & 255, dir = c >> 7, wc = (c >> 5) & 3, n = (c >> 4) & 1, fq = (c >> 2) & 3, j = c & 3;
        const int nbk = pn >> 1, e = (pn & 1) * 64 + 16 * wc + 4 * fq + j, ch = nbk * 128 + e;
        const float* gwp = p.in[17] + ((((size_t)l * 2 + dir) * 2 + n) * NE + nbk) * 128 * 128 + e; const float* cb = p.in[16] + (size_t)l * D_ + nbk * 128;
        float sacc = p.in[18][(((size_t)l * 2 + dir) * 2 + n) * D_ + ch];
        for (int k = 0; k < 128; ++k) sacc += cb[k] * gwp[(size_t)k * 128];
        GB[idx] = sacc;
    }
    float* SPT = PB(WS_GB, float) + L_ * 4096;
    for (int idx = gt; idx < L_ * 2 * D_; idx += ngt) SPT[idx] = -8.0f * softplusf_(p.in[19][idx]);
}

#define XB_TMO      128
#define XB_XCNT(j)  (256  + 64 * (j))
#define XB_XSUB(j)  (1280 + 64 * (j))
#define XB_XGEN(j)  (2304 + 64 * (j))
#define XB_TOP      3328
#define XB_TOPGEN   3392
#define XCD_BAR_WORDS 3456
#define XB_SPIN_CAP (1u << 18)
__device__ __forceinline__ unsigned xb_ld(unsigned* p)              { return __hip_atomic_load(p, __ATOMIC_RELAXED, __HIP_MEMORY_SCOPE_AGENT); }
__device__ __forceinline__ unsigned xb_add(unsigned* p, unsigned v) { return __hip_atomic_fetch_add(p, v, __ATOMIC_RELAXED, __HIP_MEMORY_SCOPE_AGENT); }
__device__ __forceinline__ unsigned xb_xcc_id() { return (unsigned)__builtin_amdgcn_s_getreg((3 << 11) | 20) & 0xFu; }
#define XB_SPIN(cond, bar) do { unsigned _sp = 0; while (cond) { __builtin_amdgcn_s_sleep(1); \
    if ((++_sp & 255u) == 0u) { if (xb_ld(&(bar)[XB_TMO])) break; if (_sp > XB_SPIN_CAP) { atomicAdd(&(bar)[XB_TMO], 1u); break; } } } } while (0)
struct XcdBarrier { unsigned* bar; unsigned x; volatile LAS unsigned* st; };
__device__ __forceinline__ XcdBarrier xcd_barrier_post(unsigned* bar, volatile LAS unsigned* st) {
    XcdBarrier b; b.bar = bar; b.x = xb_xcc_id(); b.st = st;
    if (threadIdx.x == 0) (void)xb_add(&bar[XB_XCNT(b.x)], 1u);
    return b;
}
__device__ __forceinline__ void xcd_barrier_complete(unsigned* bar, unsigned x, unsigned& nloc, unsigned& nx) {
    const unsigned G = gridDim.x * gridDim.y * gridDim.z;
    unsigned sum, cnt, mine, sp = 0u;
    for (;;) {
        sum = 0u; cnt = 0u; mine = 0u;
#pragma unroll
        for (unsigned j = 0; j < 16; ++j) { const unsigned c = xb_ld(&bar[XB_XCNT(j)]); sum += c; cnt += (c > 0u) ? 1u : 0u; }
        mine = xb_ld(&bar[XB_XCNT(x)]);
        if (sum == G) break;
        __builtin_amdgcn_s_sleep(1);
        if ((++sp & 255u) == 0u) { if (xb_ld(&bar[XB_TMO])) break; if (sp > XB_SPIN_CAP) { atomicAdd(&bar[XB_TMO], 1u); break; } }
    }
    nloc = mine > 0u ? mine : 1u; nx = cnt > 0u ? cnt : 1u;
}
__device__ __forceinline__ void xcd_barrier(const XcdBarrier& b) {
    asm volatile("s_waitcnt vmcnt(0)" ::: "memory");
    __syncthreads();
    if (threadIdx.x == 0) {
        unsigned* bar = b.bar;
        __builtin_amdgcn_s_waitcnt(0);
        unsigned nloc = b.st[0], nx = b.st[1];
        if (nloc == 0u) { xcd_barrier_complete(bar, b.x, nloc, nx); b.st[0] = nloc; b.st[1] = nx; }
        const unsigned old = xb_add(&bar[XB_XSUB(b.x)], 1u);
        const unsigned gen = old / nloc;
        if (old + 1u == (gen + 1u) * nloc) {
            __builtin_amdgcn_fence(__ATOMIC_RELEASE, "agent");
            asm volatile("s_waitcnt vmcnt(0)" ::: "memory");
            const unsigned og = xb_add(&bar[XB_TOP], 1u);
            const unsigned tg = og / nx;
            if (og + 1u == (tg + 1u) * nx) xb_add(&bar[XB_TOPGEN], 1u);
            else XB_SPIN(xb_ld(&bar[XB_TOPGEN]) == tg, bar);
            __builtin_amdgcn_fence(__ATOMIC_ACQUIRE, "agent");
            xb_add(&bar[XB_XGEN(b.x)], 1u);
            asm volatile("s_waitcnt vmcnt(0)" ::: "memory");
        } else {
            XB_SPIN(xb_ld(&bar[XB_XGEN(b.x)]) == gen, bar);
            __builtin_amdgcn_fence(__ATOMIC_ACQUIRE, "agent");
            asm volatile("s_waitcnt vmcnt(0)" ::: "memory");
        }
    }
    __syncthreads();
}

constexpr int RING_BYTES = 131072, LDS_TOK = RING_BYTES, LDS_MISC = RING_BYTES + 16384, LDS_BYTES = LDS_MISC + 1024;
constexpr int NPL = 14;
enum { SS_NORM1 = 0, SS_WIN, SS_PREP1, SS_QG, SS_KVG, SS_GATES, SS_PREP2, SS_ATTN, SS_Z1, SS_Z, SS_RES, SS_NORM2, SS_UP, SS_DOWN };
constexpr int ST_FINAL = 1 + L_ * NPL, NSTEPS = ST_FINAL + 1;
struct Args { Params p; int s_lo, s_hi, li, pad; };
typedef const Args __attribute__((address_space(4)))* KArgsP;
#if defined(__HIP_DEVICE_COMPILE__)
#define KP() ({ KArgsP _k = (KArgsP)__builtin_amdgcn_kernarg_segment_ptr(); asm volatile("" : "+s"(_k)); _k->p; })
#else
#define KP() (a.p)
#endif

__global__ void __launch_bounds__(512, 2) mk_fwd(Args a) {
    extern __shared__ __attribute__((aligned(16))) unsigned char lds_raw[];
    LAS unsigned char* lds = (LAS unsigned char*)lds_raw;
    const int tid = threadIdx.x;
    const int wave_s = __builtin_amdgcn_readfirstlane(tid >> 6);
#define PH_BEGIN const Params p = KP(); int tid_ = wave_s * 64 + (int)__builtin_amdgcn_mbcnt_hi(~0u, __builtin_amdgcn_mbcnt_lo(~0u, 0u)); asm volatile("" : "+v"(tid_)); int blk_ = blockIdx.x, G = gridDim.x; asm volatile("" : "+s"(blk_), "+s"(G)); \
    const int lane = tid_ & 63, wave = __builtin_amdgcn_readfirstlane(tid_ >> 6), gw = blk_ * 8 + wave, ngw = G * 8, gt = blk_ * 512 + tid_, ngt = G * 512; (void)lane; (void)gw; (void)ngw; (void)gt; (void)ngt;
    volatile LAS unsigned* MISC = (volatile LAS unsigned*)(lds + LDS_MISC);
    for (int u = tid; u < 256; u += 512) MISC[u] = 0u;
    __syncthreads();
    XcdBarrier bar; { const Params p = KP(); bar.bar = PB(WS_CTL, unsigned) + CW_BAR + a.li * XCD_BAR_WORDS; bar.x = 0; bar.st = nullptr;
    if (a.s_hi - a.s_lo > 1) bar = xcd_barrier_post(PB(WS_CTL, unsigned) + CW_BAR + a.li * XCD_BAR_WORDS, MISC + 8); }
#define IN(s) (a.s_lo <= (s) && (s) < a.s_hi)
#define SEAM(s) do { if (IN(s) && IN((s) + 1)) xcd_barrier(bar); } while (0)
#define WB PB(WS_WEI, bf16_t)
#define MOD PB(WS_MOD, float)
    if (IN(0)) { PH_BEGIN
        p0_weights(p, (LAS float*)(lds + wave * 16384), gw, ngw, lane);
        __syncthreads();
        ph_mod(p, (float*)lds_raw, blk_, G);
        ph_tables(p, gt, ngt);
        p0_gbias(p, gt, ngt);
    }
    SEAM(0);
    for (int l = 0; l < L_; ++l) {
        const int sb = 1 + l * NPL;
        if (IN(sb + SS_NORM1)) { PH_BEGIN ph_zero_pads(p, gt, ngt); ph_norm(p, l, 1, gw, ngw, lane); }
        SEAM(sb + SS_NORM1);
        if (IN(sb + SS_WIN)) { PH_BEGIN
            pg8::GemmCfg g{1024, 1024, 1024, 256u}; pg8::StdOrder S; S.init(64, 19, G, blk_, PB(A_XN, bf16_t), WB + WE_WIN + (size_t)l * 4864 * 1024, 1024, 1024);
            EpiWin E{p}; pg8::gemm_phase<EpiWin, pg8::StdOrder, true, false>(lds, g, S, E, tid_);
        }
        SEAM(sb + SS_WIN);
        if (IN(sb + SS_PREP1)) { PH_BEGIN ph_prep1(p, l, gw, ngw, lane); }
        SEAM(sb + SS_PREP1);
        if (IN(sb + SS_QG)) { PH_BEGIN
            pg8::GemmCfg g{512, 256, 256, 256u}; pg8::StdOrder S; S.init(64, 4, G, blk_, PB(A_CQN, bf16_t), WB + WE_WUQ + (size_t)l * 1024 * 256, 512, 256);
            EpiBf E{PB(A_QR, bf16_t), 1024}; pg8::gemm_phase<EpiBf, pg8::StdOrder, true, false>(lds, g, S, E, tid_);
        }
        if (IN(sb + SS_KVG)) { PH_BEGIN
            pg8::GemmCfg g{512, 256, 256, 256u}; pg8::StdOrder S; S.init(64, 4, G, blk_, PB(A_CQN, bf16_t) + 256, WB + WE_WUKV + (size_t)l * 1024 * 256, 512, 256);
            EpiBf E{PB(A_KVR, bf16_t), 1024}; pg8::gemm_phase<EpiBf, pg8::StdOrder, true, false>(lds, g, S, E, tid_);
        }
        if (IN(sb + SS_GATES)) { PH_BEGIN
            pg8::GemmCfg g{1024, 512, 512, 2048u}; GatesOrder S; S.init(G, blk_, PB(A_UP, bf16_t), WB + WE_WG + (size_t)l * 4096 * 512);
            EpiGates E{p, l}; pg8::gemm_phase<EpiGates, GatesOrder, true, false>(lds, g, S, E, tid_);
        }
        SEAM(sb + SS_GATES);
        if (IN(sb + SS_PREP2)) { PH_BEGIN ph_prep2(p, l, gw, ngw, lane); ph_scan_agg(p, gt, ngt); }
        SEAM(sb + SS_PREP2);
        if (IN(sb + SS_ATTN)) { PH_BEGIN
            if (a.pad & 1) ph_attn(p, lds, blk_, G, tid_);
            ph_scan_fin(p, gt, ngt); }
        SEAM(sb + SS_ATTN);
        if (IN(sb + SS_Z1)) { PH_BEGIN
            pg8::GemmCfg g{1024, 1024, 1024, 256u}; pg8::StdOrder S; S.init(64, 4, G, blk_, PB(A_HL, bf16_t), WB + WE_WOL + (size_t)l * 1024 * 1024, 1024, 1024);
            EpiZ1 E{p}; pg8::gemm_phase<EpiZ1, pg8::StdOrder, true, false>(lds, g, S, E, tid_);
        }
        SEAM(sb + SS_Z1);
        if (IN(sb + SS_Z)) { PH_BEGIN
            pg8::GemmCfg g{512, 512, 512, 256u}; pg8::StdOrder S; S.init(64, 4, G, blk_, PB(A_O, bf16_t), WB + WE_WOM + (size_t)l * 1024 * 512, 512, 512);
            EpiZ E{p}; pg8::gemm_phase<EpiZ, pg8::StdOrder, true, false>(lds, g, S, E, tid_);
        }
        SEAM(sb + SS_Z);
        if (IN(sb + SS_RES)) { PH_BEGIN
            pg8::GemmCfg g{1024, 1024, 1024, 256u}; pg8::StdOrder S; S.init(64, 4, G, blk_, PB(A_Z, bf16_t), WB + WE_WOUT + (size_t)l * 1024 * 1024, 1024, 1024);
            EpiRes E{l == 0 ? p.in[0] : p.out, p.out, MOD + (size_t)l * 8 * 6144 + 2048}; pg8::gemm_phase<EpiRes, pg8::StdOrder, true, false>(lds, g, S, E, tid_);
        }
        SEAM(sb + SS_RES);
        if (IN(sb + SS_NORM2)) { PH_BEGIN ph_norm(p, l, 2, gw, ngw, lane); }
        SEAM(sb + SS_NORM2);
        if (IN(sb + SS_UP)) { PH_BEGIN
            if (!(l & 1)) {
                pg8::GemmCfg g{1024, 1024, 1024, 256u}; pg8::StdOrder S; S.init(64, 22, G, blk_, PB(A_XN, bf16_t), WB + WE_FGU + (size_t)(l >> 1) * 5632 * 1024, 1024, 1024);
                EpiUp E{PB(A_HID, bf16_t)}; pg8::gemm_phase<EpiUp, pg8::StdOrder, true, false>(lds, g, S, E, tid_);
            } else {
                volatile LAS unsigned* meta = MISC + 16; moe_meta_fill(p, l, meta, tid_);
                MoeOrder S; S.meta = meta; S.tok = (LAS unsigned*)(lds + LDS_TOK); S.G = G; S.c = blk_; S.npn = 22; S.nwg = (int)meta[16] * 22; S.A0 = (const char*)PB(A_XN, bf16_t); S.atile = 0;
                S.B0 = (const char*)(WB + WE_MGU + (size_t)(l >> 1) * 8 * 5632 * 1024); S.bexp = (size_t)5632 * 1024 * 2; S.btile = (size_t)256 * 1024 * 2;
                S.fill_tok(p, tid_);
                pg8::GemmCfg g{1024, 1024, 1024, 256u}; EpiUp E{PB(A_HID, bf16_t)}; pg8::gemm_phase<EpiUp, MoeOrder, true, true>(lds, g, S, E, tid_);
            }
        }
        SEAM(sb + SS_UP);
        if (IN(sb + SS_DOWN)) { PH_BEGIN
            if (!(l & 1)) {
                pg8::GemmCfg g{FF, FF, FF, 256u}; pg8::StdOrder S; S.init(64, 4, G, blk_, PB(A_HID, bf16_t), WB + WE_FD + (size_t)(l >> 1) * 1024 * 2816, FF, FF);
                EpiRes E{p.out, p.out, MOD + (size_t)l * 8 * 6144 + 5120}; pg8::gemm_phase<EpiRes, pg8::StdOrder, true, false>(lds, g, S, E, tid_);
            } else {
                volatile LAS unsigned* meta = MISC + 16; moe_meta_fill(p, l, meta, tid_);
                MoeOrder S; S.meta = meta; S.tok = (LAS unsigned*)(lds + LDS_TOK); S.G = G; S.c = blk_; S.npn = 4; S.nwg = (int)meta[16] * 4; S.A0 = (const char*)PB(A_HID, bf16_t); S.atile = (size_t)256 * FF * 2;
                S.B0 = (const char*)(WB + WE_MD + (size_t)(l >> 1) * 8 * 1024 * 2816); S.bexp = (size_t)1024 * 2816 * 2; S.btile = (size_t)256 * 2816 * 2;
                pg8::GemmCfg g{FF, FF, FF, 256u}; EpiMoeDown E{p, l}; pg8::gemm_phase<EpiMoeDown, MoeOrder, true, false>(lds, g, S, E, tid_);
            }
        }
        SEAM(sb + SS_DOWN);
    }
    if (IN(ST_FINAL)) { PH_BEGIN ph_final(p, gt, ngt); }
#undef IN
#undef SEAM
#undef WB
#undef MOD
}

template <class F, bool DUAL> static void launch_naive(F f, int Mmax, int Z, hipStream_t st) {
    dim3 grid((f.N + 63) / 64, (Mmax + 63) / 64, Z);
    hipLaunchKernelGGL((naive_gemm<F, DUAL>), grid, dim3(256), 0, st, f);
}
#ifndef FAST_MASK
#define FAST_MASK 0x3FFF
#endif
#ifndef FAST_ATTN
#define FAST_ATTN 1
#endif
#ifndef FAST_MOE
#define FAST_MOE 1
#endif
static bool step_fast(int ss, int l) {
    if (ss == SS_ATTN) return FAST_ATTN != 0;
    if ((ss == SS_UP || ss == SS_DOWN) && (l & 1)) return FAST_MOE != 0;
    return ((FAST_MASK >> ss) & 1) != 0;
}
extern "C" void kernel_launch(void* const* d_in, const int* in_sizes, int n_in, void* d_out, int out_size, void* d_ws, size_t ws_size, hipStream_t stream) {
    if (n_in != 29 || out_size != T_ * D_ || ws_size < WS_END) { fprintf(stderr, "kernel_launch: bad shapes n_in %d out %d ws %zu (need %zu)\n", n_in, out_size, ws_size, (size_t)WS_END); return; }
    Params p{};
    for (int i = 0; i < 29; ++i) p.in[i] = (const float*)d_in[i];
    p.out = (float*)d_out; p.ws = (unsigned char*)d_ws;
    static int grid = 0;
    if (!grid) {
        (void)hipFuncSetAttribute((const void*)mk_fwd, hipFuncAttributeMaxDynamicSharedMemorySize, LDS_BYTES);
        int dev = 0, cus = 0; (void)hipGetDevice(&dev); (void)hipDeviceGetAttribute(&cus, hipDeviceAttributeMultiprocessorCount, dev);
        grid = cus > 0 ? cus : 256;
    }
    (void)hipMemsetAsync((char*)d_ws + WS_CTL, 0, CTL_BYTES, stream);
    const int TG = 1024;
    auto run = [&](int s) { Args a{}; a.p = p; a.s_lo = s; a.s_hi = s + 1; a.li = 0; a.pad = FAST_ATTN ? 1 : 0; hipLaunchKernelGGL(mk_fwd, dim3(grid), dim3(512), LDS_BYTES, stream, a); };
#ifndef ONE_LAUNCH
#define ONE_LAUNCH 1
#endif
    if (ONE_LAUNCH) { Args a{}; a.p = p; a.s_lo = 0; a.s_hi = NSTEPS; a.li = 0; a.pad = 1; hipLaunchKernelGGL(mk_fwd, dim3(grid), dim3(512), LDS_BYTES, stream, a); return; }
    run(0);
    for (int l = 0; l < L_; ++l) {
        const int sb = 1 + l * NPL;
        run(sb + SS_NORM1);
        if (step_fast(SS_WIN, l)) run(sb + SS_WIN); else launch_naive<FWin, false>(FWin{p, l, INC, D_, 0}, T_, 1, stream);
        run(sb + SS_PREP1);
        if (step_fast(SS_QG, l)) run(sb + SS_QG); else launch_naive<FQ, false>(FQ{p, l, 768, 256, 0}, T_, 1, stream);
        if (step_fast(SS_KVG, l)) run(sb + SS_KVG); else launch_naive<FKV, false>(FKV{p, l, 1024, 256, 0}, T_, 1, stream);
        if (step_fast(SS_GATES, l)) run(sb + SS_GATES); else hipLaunchKernelGGL(naive_gates, dim3(T_ * D_ / 256), dim3(256), 0, stream, p, l);
        run(sb + SS_PREP2);
        if (!step_fast(SS_ATTN, l)) hipLaunchKernelGGL(naive_attn, dim3(B_ * H_ * S_ / 256), dim3(256), 0, stream, p);
        run(sb + SS_ATTN);
        if (step_fast(SS_Z1, l)) run(sb + SS_Z1); else launch_naive<FZ1, false>(FZ1{p, l, D_, D_, 0}, T_, 1, stream);
        if (step_fast(SS_Z, l)) run(sb + SS_Z); else launch_naive<FZ, false>(FZ{p, l, D_, 512, 0}, T_, 1, stream);
        if (step_fast(SS_RES, l)) run(sb + SS_RES); else launch_naive<FRes, false>(FRes{p, l, D_, D_, 0}, T_, 1, stream);
        run(sb + SS_NORM2);
        if (!(l & 1)) {
            if (step_fast(SS_UP, l)) run(sb + SS_UP); else launch_naive<FUp, true>(FUp{p, l, FF, D_, 0}, T_, 1, stream);
            if (step_fast(SS_DOWN, l)) run(sb + SS_DOWN); else launch_naive<FDown, false>(FDown{p, l, D_, FF, 0}, T_, 1, stream);
        } else {
            if (step_fast(SS_UP, l)) run(sb + SS_UP); else launch_naive<FMUp, true>(FMUp{p, l, FF, D_, 0}, T_, NE, stream);
            if (step_fast(SS_DOWN, l)) run(sb + SS_DOWN); else launch_naive<FMDown, false>(FMDown{p, l, D_, FF, 0}, T_, NE, stream);
        }
    }
    run(ST_FINAL);
    (void)TG;
}
```

```cpp
#include <hip/hip_runtime.h>
#include <cstdio>
#include <cstdint>

constexpr int B_ = 8, S_ = 2048, T_ = B_ * S_, D_ = 1024, L_ = 4, H_ = 8;
constexpr int QKD = 96, VD = 64, FF = 2816, NE = 8, INC = 4640;
constexpr int SP = S_ + 4;
constexpr float EPS = 1e-6f;
constexpr float QSCALE = 0.10206207261596577f * 1.4426950408889634f;

typedef unsigned short bf16_t;
typedef float f32x4 __attribute__((ext_vector_type(4)));
typedef unsigned u32x4 __attribute__((ext_vector_type(4)));
typedef unsigned u32x2 __attribute__((ext_vector_type(2)));

constexpr size_t MiB = 1u << 20;
constexpr size_t WS_CTL = 0, CTL_BYTES = 1 * MiB;
constexpr size_t WS_MOD = 1 * MiB;
constexpr size_t WS_COS = 2 * MiB, WS_SIN = 3 * MiB;
constexpr size_t WS_GB = 4 * MiB;
constexpr size_t WS_LIST = 5 * MiB;
constexpr size_t WS_TW = 6 * MiB;
constexpr size_t WS_SSP = 7 * MiB;
constexpr size_t WS_AGG = 8 * MiB;
constexpr size_t WS_WEI = 16 * MiB;
constexpr size_t WS_AR = 392 * MiB;
constexpr size_t A_XN = WS_AR + 0 * MiB;
constexpr size_t A_CQKV = WS_AR + 32 * MiB;
constexpr size_t A_KR = WS_AR + 48 * MiB;
constexpr size_t A_KPE = WS_AR + 50 * MiB;
constexpr size_t A_UP = WS_AR + 52 * MiB;
constexpr size_t A_YG = WS_AR + 86 * MiB;
constexpr size_t A_G = WS_AR + 118 * MiB;
constexpr size_t A_CQN = WS_AR + 182 * MiB;
constexpr size_t A_QR = WS_AR + 198 * MiB;
constexpr size_t A_KVR = WS_AR + 230 * MiB;
constexpr size_t A_LAB = WS_AR + 262 * MiB;
constexpr size_t A_Q = WS_AR + 0 * MiB;
constexpr size_t A_K = WS_AR + 24 * MiB;
constexpr size_t A_V = WS_AR + 52 * MiB;
constexpr size_t A_O = WS_AR + 198 * MiB;
constexpr size_t A_HL = WS_AR + 230 * MiB;
constexpr size_t A_Z1 = WS_AR + 262 * MiB;
constexpr size_t A_Z = WS_AR + 326 * MiB;
constexpr size_t A_HID = WS_AR + 32 * MiB;
constexpr size_t A_Y0 = WS_AR + 262 * MiB;
constexpr size_t A_Y1 = WS_AR + 326 * MiB;
constexpr size_t WS_END = WS_AR + 390 * MiB;
constexpr int CW_CNT = 65536;
constexpr int CW_BAR = 4096;

struct Params { const float* in[29]; float* out; unsigned char* ws; };

#define PB(off, type) ((type*)(p.ws + (off)))

__device__ __forceinline__ float bf2f(bf16_t v) { return __uint_as_float(((unsigned)v) << 16); }
__device__ __forceinline__ bf16_t f2bf(float f) { unsigned u = __float_as_uint(f); u += 0x7fffu + ((u >> 16) & 1u); return (bf16_t)(u >> 16); }
__device__ __forceinline__ unsigned pk2(float lo, float hi) { return (unsigned)f2bf(lo) | ((unsigned)f2bf(hi) << 16); }
__device__ __forceinline__ float sigmoidf_(float x) { return __builtin_amdgcn_rcpf(1.0f + __builtin_amdgcn_exp2f(-1.4426950408889634f * x)); }
__device__ __forceinline__ float siluf_(float x) { return x * sigmoidf_(x); }
__device__ __forceinline__ float gelu_tanh(float x) { const float u = 0.7978845608028654f * (x + 0.044715f * x * x * x); return x * sigmoidf_(2.0f * u); }
__device__ __forceinline__ float softplusf_(float x) { return fmaxf(x, 0.f) + log1pf(__expf(-fabsf(x))); }
__device__ __forceinline__ float wave_sum(float v) {
#pragma unroll
    for (int o = 1; o < 64; o <<= 1) v += __shfl_xor(v, o);
    return v;
}

#define LAS __attribute__((address_space(3)))
__device__ __forceinline__ void ph_mod(const Params& p, LAS float* lds, int blk, int nblk, int tid) {
    const int lane = tid & 63, w = tid >> 6;
    const float* c = p.in[1]; const float* aw = p.in[3]; const float* ab = p.in[4];
    float* mod = PB(WS_MOD, float);
    for (int i = tid; i < B_ * D_; i += 512) lds[i] = siluf_(c[i]);
    __syncthreads();
    LAS float* red = lds + B_ * D_;
    for (int item = blk; item < L_ * 96; item += nblk) {
        const int l = item / 96, n0 = (item % 96) * 64;
        float acc[8];
#pragma unroll
        for (int b = 0; b < 8; ++b) acc[b] = 0.f;
        const float* wp = aw + ((size_t)l * D_ + w * 128) * 6144 + n0 + lane;
#pragma unroll 1
        for (int k0 = 0; k0 < 128; k0 += 16) {
            float wv[16];
#pragma unroll
            for (int k = 0; k < 16; ++k) wv[k] = wp[(size_t)(k0 + k) * 6144];
#pragma unroll
            for (int k = 0; k < 16; ++k)
#pragma unroll
                for (int b = 0; b < 8; ++b) acc[b] += lds[b * D_ + w * 128 + k0 + k] * wv[k];
        }
#pragma unroll
        for (int b = 0; b < 8; ++b) red[(w * 8 + b) * 64 + lane] = acc[b];
        __syncthreads();
        {
            const int b = tid >> 6, n = tid & 63; float s = 0.f;
#pragma unroll
            for (int ww = 0; ww < 8; ++ww) s += red[(ww * 8 + b) * 64 + n];
            mod[((size_t)l * 8 + b) * 6144 + n0 + n] = s + ab[l * 6144 + n0 + n];
        }
        __syncthreads();
    }
}
__device__ __forceinline__ void ph_tables(const Params& p, int gt, int ngt) {
    const int* pos = (const int*)p.in[2];
    float* cs = PB(WS_COS, float); float* sn = PB(WS_SIN, float);
    for (int i = gt; i < T_ * 16; i += ngt) {
        const int t = i >> 4, j = i & 15;
        const float inv = 1.0f / powf(10000.0f, (float)(2 * j) / 32.0f);
        const float ang = (float)pos[t] * inv;
        cs[i] = (float)cos((double)ang); sn[i] = (float)sin((double)ang);
    }
}
__device__ __forceinline__ void ph_zero_pads(const Params& p, int gt, int ngt) {
    bf16_t* up = PB(A_UP, bf16_t);
    for (int i = gt; i < B_ * 4 * D_; i += ngt) {
        const int b = i / (4 * D_), r = (i / D_) & 3, c = i & (D_ - 1);
        const int row = (r < 2) ? r : (S_ + r);
        up[((size_t)b * SP + row) * D_ + c] = 0;
    }
}
__device__ __forceinline__ void ph_norm(const Params& p, int l, int sub, int gw, int ngw, int lane) {
    constexpr int RB = 4;
    const float* __restrict__ xsrc = (l == 0 && sub == 1) ? p.in[0] : p.out;
    const bool combine = (sub == 1 && l > 0 && ((l - 1) & 1));
    const bool route = (sub == 2 && (l & 1));
    const float* __restrict__ g = p.in[sub == 1 ? 5 : 6] + l * D_;
    const float* __restrict__ mod = PB(WS_MOD, float);
    bf16_t* __restrict__ XN = PB(A_XN, bf16_t);
    const float* __restrict__ Y0 = PB(A_Y0, float); const float* __restrict__ Y1 = PB(A_Y1, float);
    const float* __restrict__ wr = p.in[25] + (size_t)(l >> 1) * D_ * NE;
    unsigned* cnt = PB(WS_CTL, unsigned) + CW_CNT + (l >> 1) * 1024;
    int* list = PB(WS_LIST, int); float* tw = PB(WS_TW, float);
    for (int base = gw * RB; base < T_; base += ngw * RB) {
        const int b = base / S_;
        const float* mrow = mod + ((size_t)l * 8 + b) * 6144 + (sub == 1 ? 0 : 3072);
        f32x4 v[RB][4];
#pragma unroll
        for (int rr = 0; rr < RB; ++rr)
#pragma unroll
            for (int j = 0; j < 4; ++j) v[rr][j] = *(const f32x4*)(xsrc + (size_t)(base + rr) * D_ + 4 * lane + 256 * j);
        if (combine) {
            const float* g2 = mod + ((size_t)(l - 1) * 8 + b) * 6144 + 5120;
#pragma unroll
            for (int rr = 0; rr < RB; ++rr)
#pragma unroll
                for (int j = 0; j < 4; ++j) {
                    const size_t o = (size_t)(base + rr) * D_ + 4 * lane + 256 * j;
                    const f32x4 a = *(const f32x4*)(Y0 + o), c2 = *(const f32x4*)(Y1 + o), gg = *(const f32x4*)(g2 + 4 * lane + 256 * j);
                    v[rr][j] = v[rr][j] + gg * (a + c2);
                    *(f32x4*)(p.out + o) = v[rr][j];
                }
        }
        float ss[RB];
#pragma unroll
        for (int rr = 0; rr < RB; ++rr) { ss[rr] = 0.f;
#pragma unroll
            for (int j = 0; j < 4; ++j) ss[rr] += (v[rr][j].x * v[rr][j].x + v[rr][j].y * v[rr][j].y) + (v[rr][j].z * v[rr][j].z + v[rr][j].w * v[rr][j].w); }
#pragma unroll
        for (int o = 1; o < 64; o <<= 1)
#pragma unroll
            for (int rr = 0; rr < RB; ++rr) ss[rr] += __shfl_xor(ss[rr], o);
#pragma unroll
        for (int j = 0; j < 4; ++j) {
            const int c0 = 4 * lane + 256 * j;
            const f32x4 gg = *(const f32x4*)(g + c0), sh = *(const f32x4*)(mrow + c0), sc = *(const f32x4*)(mrow + 1024 + c0);
            const f32x4 gs = gg * (sc + 1.0f);
#pragma unroll
            for (int rr = 0; rr < RB; ++rr) {
                const float rstd = rsqrtf(ss[rr] * (1.0f / D_) + EPS);
                v[rr][j] = v[rr][j] * rstd * gs + sh;
                u32x2 o; o.x = pk2(v[rr][j].x, v[rr][j].y); o.y = pk2(v[rr][j].z, v[rr][j].w);
                *(u32x2*)(XN + (size_t)(base + rr) * D_ + c0) = o;
            }
        }
        if (route) {
            float lg[RB][8];
#pragma unroll
            for (int rr = 0; rr < RB; ++rr)
#pragma unroll
                for (int e = 0; e < 8; ++e) lg[rr][e] = 0.f;
#pragma unroll
            for (int j = 0; j < 4; ++j)
#pragma unroll
                for (int i = 0; i < 4; ++i) {
                    const int k = 4 * lane + 256 * j + i;
                    const f32x4 w0 = *(const f32x4*)(wr + (size_t)k * 8), w1 = *(const f32x4*)(wr + (size_t)k * 8 + 4);
#pragma unroll
                    for (int rr = 0; rr < RB; ++rr) { const float hv = v[rr][j][i];
                        lg[rr][0] += hv * w0.x; lg[rr][1] += hv * w0.y; lg[rr][2] += hv * w0.z; lg[rr][3] += hv * w0.w;
                        lg[rr][4] += hv * w1.x; lg[rr][5] += hv * w1.y; lg[rr][6] += hv * w1.z; lg[rr][7] += hv * w1.w; }
                }
#pragma unroll
            for (int o = 1; o < 64; o <<= 1)
#pragma unroll
                for (int rr = 0; rr < RB; ++rr)
#pragma unroll
                    for (int e = 0; e < 8; ++e) lg[rr][e] += __shfl_xor(lg[rr][e], o);
#pragma unroll
            for (int rr = 0; rr < RB; ++rr) {
                const int row = base + rr;
                int i1 = 0; float v1 = lg[rr][0];
#pragma unroll
                for (int e = 1; e < 8; ++e) if (lg[rr][e] > v1) { v1 = lg[rr][e]; i1 = e; }
                int i2 = -1; float v2 = -3.0e38f;
#pragma unroll
                for (int e = 0; e < 8; ++e) if (e != i1 && lg[rr][e] > v2) { v2 = lg[rr][e]; i2 = e; }
                const float ex = __expf(v2 - v1), w1 = 1.0f / (1.0f + ex), w2 = ex * w1;
                if (lane == 0) {
                    const unsigned p1 = atomicAdd(cnt + 64 * i1, 1u); list[(size_t)i1 * T_ + p1] = row * 2;
                    const unsigned p2 = atomicAdd(cnt + 64 * i2, 1u); list[(size_t)i2 * T_ + p2] = row * 2 + 1;
                    tw[row * 2] = w1; tw[row * 2 + 1] = w2;
                }
            }
        }
    }
}
__device__ __forceinline__ void ph_final(const Params& p, int gt, int ngt) {
    const float* __restrict__ mod = PB(WS_MOD, float); const float* __restrict__ Y0 = PB(A_Y0, float); const float* __restrict__ Y1 = PB(A_Y1, float);
    for (int i = gt; i < T_ * D_ / 4; i += ngt) {
        const int row = i >> 8, c0 = (i & 255) * 4, b = row / S_;
        const f32x4 gg = *(const f32x4*)(mod + ((size_t)(L_ - 1) * 8 + b) * 6144 + 5120 + c0);
        const size_t o = (size_t)row * D_ + c0;
        *(f32x4*)(p.out + o) = *(const f32x4*)(p.out + o) + gg * (*(const f32x4*)(Y0 + o) + *(const f32x4*)(Y1 + o));
    }
}
__device__ __forceinline__ void ph_prep2(const Params& p, int l, int gw, int ngw, int lane) {
    constexpr int RB = 2;
    const bf16_t* __restrict__ QR = PB(A_QR, bf16_t); const bf16_t* __restrict__ KVR = PB(A_KVR, bf16_t); const float* __restrict__ KR = PB(A_KR, float);
    const float* __restrict__ SSP = PB(WS_SSP, float);
    const float* __restrict__ cs = PB(WS_COS, float); const float* __restrict__ sn = PB(WS_SIN, float);
    bf16_t* __restrict__ Q = PB(A_Q, bf16_t); bf16_t* __restrict__ K = PB(A_K, bf16_t); bf16_t* __restrict__ V = PB(A_V, bf16_t);
    const int h = lane >> 3, sub = lane & 7, subq = sub < 6 ? sub : 0, subk = sub < 4 ? sub : 0, subp = (sub == 5) ? 1 : 0;
    float qg[16], kg[16];
#pragma unroll
    for (int i = 0; i < 16; ++i) { qg[i] = sub < 6 ? p.in[12][l * QKD + sub * 16 + i] : 0.f; kg[i] = sub < 6 ? p.in[13][l * QKD + sub * 16 + i] : 0.f; }
    for (int base = gw * RB; base < T_; base += ngw * RB) {
        u32x4 qa[RB][2], ka[RB][2], va[RB]; f32x4 kp[RB][4], cc[RB][4], sc[RB][4], sp[RB][2];
#pragma unroll
        for (int rr = 0; rr < RB; ++rr) { const size_t row = base + rr;
            qa[rr][0] = *(const u32x4*)(QR + row * 1024 + h * 128 + subq * 16); qa[rr][1] = *(const u32x4*)(QR + row * 1024 + h * 128 + subq * 16 + 8);
            ka[rr][0] = *(const u32x4*)(KVR + row * 1024 + h * 128 + subk * 16); ka[rr][1] = *(const u32x4*)(KVR + row * 1024 + h * 128 + subk * 16 + 8);
            va[rr] = *(const u32x4*)(KVR + row * 1024 + h * 128 + 64 + sub * 8);
            sp[rr][0] = *(const f32x4*)(SSP + row * 8); sp[rr][1] = *(const f32x4*)(SSP + row * 8 + 4);
#pragma unroll
            for (int i = 0; i < 4; ++i) { kp[rr][i] = *(const f32x4*)(KR + row * 32 + subp * 16 + 4 * i); cc[rr][i] = *(const f32x4*)(cs + row * 16 + 4 * i); sc[rr][i] = *(const f32x4*)(sn + row * 16 + 4 * i); } }
#pragma unroll
        for (int rr = 0; rr < RB; ++rr) { const int row = base + rr, b = row / S_, s = row % S_;
            const float rq = rsqrtf(((sp[rr][0].x + sp[rr][0].y) + (sp[rr][0].z + sp[rr][0].w)) * (1.0f / 256.0f) + EPS);
            const float rk = rsqrtf(((sp[rr][1].x + sp[rr][1].y) + (sp[rr][1].z + sp[rr][1].w)) * (1.0f / 256.0f) + EPS);
            float c16[16], s16[16], v[16];
#pragma unroll
            for (int i = 0; i < 4; ++i) { c16[4 * i] = cc[rr][i].x; c16[4 * i + 1] = cc[rr][i].y; c16[4 * i + 2] = cc[rr][i].z; c16[4 * i + 3] = cc[rr][i].w;
                s16[4 * i] = sc[rr][i].x; s16[4 * i + 1] = sc[rr][i].y; s16[4 * i + 2] = sc[rr][i].z; s16[4 * i + 3] = sc[rr][i].w; }
#pragma unroll
            for (int i = 0; i < 4; ++i) { v[2 * i] = __uint_as_float(qa[rr][0][i] << 16); v[2 * i + 1] = __uint_as_float(qa[rr][0][i] & 0xffff0000u); v[8 + 2 * i] = __uint_as_float(qa[rr][1][i] << 16); v[9 + 2 * i] = __uint_as_float(qa[rr][1][i] & 0xffff0000u); }
            {
                float o[16], ss = 0.f;
#pragma unroll
                for (int i = 0; i < 16; ++i) { const float x = (sub < 6) ? v[i] * rq : 0.f; const float pr = __shfl_xor(x, 1);
                    o[i] = (sub == 4) ? (x * c16[i] - pr * s16[i]) : ((sub == 5) ? (pr * s16[i] + x * c16[i]) : x); ss += o[i] * o[i]; }
                ss += __shfl_xor(ss, 1); ss += __shfl_xor(ss, 2); ss += __shfl_xor(ss, 4);
                const float rstd = rsqrtf(ss * (1.0f / QKD) + EPS) * QSCALE;
                if (sub < 6) {
                    u32x4 w0, w1;
#pragma unroll
                    for (int i = 0; i < 4; ++i) { w0[i] = pk2(o[2 * i] * rstd * qg[2 * i], o[2 * i + 1] * rstd * qg[2 * i + 1]); w1[i] = pk2(o[8 + 2 * i] * rstd * qg[8 + 2 * i], o[9 + 2 * i] * rstd * qg[9 + 2 * i]); }
                    bf16_t* dst = Q + (((size_t)b * H_ + h) * S_ + s) * QKD + sub * 16;
                    *(u32x4*)dst = w0; *(u32x4*)(dst + 8) = w1;
                }
            }
            {
                float kv[16], ss = 0.f;
#pragma unroll
                for (int i = 0; i < 4; ++i) { kv[2 * i] = __uint_as_float(ka[rr][0][i] << 16) * rk; kv[2 * i + 1] = __uint_as_float(ka[rr][0][i] & 0xffff0000u) * rk; kv[8 + 2 * i] = __uint_as_float(ka[rr][1][i] << 16) * rk; kv[9 + 2 * i] = __uint_as_float(ka[rr][1][i] & 0xffff0000u) * rk; }
                if (sub >= 4) {
#pragma unroll
                    for (int i = 0; i < 4; ++i) { kv[4 * i] = kp[rr][i].x; kv[4 * i + 1] = kp[rr][i].y; kv[4 * i + 2] = kp[rr][i].z; kv[4 * i + 3] = kp[rr][i].w; }
                }
#pragma unroll
                for (int i = 0; i < 16; ++i) { const float x = (sub < 6) ? kv[i] : 0.f; const float pr = __shfl_xor(x, 1);
                    kv[i] = (sub == 4) ? (x * c16[i] - pr * s16[i]) : ((sub == 5) ? (pr * s16[i] + x * c16[i]) : x); ss += kv[i] * kv[i]; }
                ss += __shfl_xor(ss, 1); ss += __shfl_xor(ss, 2); ss += __shfl_xor(ss, 4);
                const float rstd = rsqrtf(ss * (1.0f / QKD) + EPS);
                if (sub < 6) {
                    u32x4 w0, w1;
#pragma unroll
                    for (int i = 0; i < 4; ++i) { w0[i] = pk2(kv[2 * i] * rstd * kg[2 * i], kv[2 * i + 1] * rstd * kg[2 * i + 1]); w1[i] = pk2(kv[8 + 2 * i] * rstd * kg[8 + 2 * i], kv[9 + 2 * i] * rstd * kg[9 + 2 * i]); }
                    bf16_t* dst = K + (((size_t)b * H_ + h) * S_ + s) * QKD + sub * 16;
                    *(u32x4*)dst = w0; *(u32x4*)(dst + 8) = w1;
                }
            }
            { u32x4 w;
#pragma unroll
              for (int i = 0; i < 4; ++i) w[i] = pk2(__uint_as_float(va[rr][i] << 16) * rk, __uint_as_float(va[rr][i] & 0xffff0000u) * rk);
              *(u32x4*)(V + (((size_t)b * H_ + h) * S_ + s) * VD + sub * 8) = w; }
        }
    }
}
constexpr int SCH = 32, NCH = S_ / SCH;
__device__ __forceinline__ void ph_scan(const Params& p, LAS unsigned char* lds, int blk, int G, int tid) {
    const bf16_t* __restrict__ LAB = PB(A_LAB, bf16_t); const bf16_t* __restrict__ YG = PB(A_YG, bf16_t); bf16_t* __restrict__ HL = PB(A_HL, bf16_t);
    LAS f32x4* AG = (LAS f32x4*)lds;
    const int lane = tid & 63, wave = tid >> 6, c32 = lane & 31, seg = wave * 2 + (lane >> 5);
#pragma unroll 1
    for (int item = blk; item < B_ * 32; item += G) {
        const int b = item >> 5, ch = (item & 31) * 32 + c32;
        const size_t r0 = (size_t)b * S_ + (size_t)seg * 128;
        f32x4 mine[4];
#pragma unroll 1
        for (int q = 0; q < 4; ++q) {
            u32x2 w[SCH];
#pragma unroll
            for (int t = 0; t < SCH; ++t) w[t] = *(const u32x2*)(LAB + ((r0 + q * SCH + t) * D_ + ch) * 4);
            float Af = 0.f, Hf = 0.f, Ab = 0.f, Hb = 0.f, Pb = 1.f;
#pragma unroll
            for (int t = 0; t < SCH; ++t) {
                const float laf = __uint_as_float(w[t].x << 16), bfv = __uint_as_float(w[t].x & 0xffff0000u), lab = __uint_as_float(w[t].y << 16), bbv = __uint_as_float(w[t].y & 0xffff0000u);
                Hf = __expf(laf) * Hf + bfv; Af += laf;
                Hb += Pb * bbv; Pb *= __expf(lab); Ab += lab;
            }
            const f32x4 a = (f32x4){__expf(Af), Hf, __expf(Ab), Hb};
            AG[(seg * 4 + q) * 32 + c32] = a;
            if (q == 0) mine[0] = a; else if (q == 1) mine[1] = a; else if (q == 2) mine[2] = a; else mine[3] = a;
        }
        __syncthreads();
        float hf = 0.f, hbin[4];
        for (int cc = 0; cc < seg * 4; ++cc) { const f32x4 a = AG[cc * 32 + c32]; hf = a.x * hf + a.y; }
        { float hb = 0.f;
          for (int cc = NCH - 1; cc >= seg * 4 + 4; --cc) { const f32x4 a = AG[cc * 32 + c32]; hb = a.z * hb + a.w; }
          hbin[3] = hb; hb = mine[3].z * hb + mine[3].w; hbin[2] = hb; hb = mine[2].z * hb + mine[2].w; hbin[1] = hb; hb = mine[1].z * hb + mine[1].w; hbin[0] = hb; }
#pragma unroll 1
        for (int q = 0; q < 4; ++q) {
            u32x2 w[SCH]; bf16_t yg[SCH];
#pragma unroll
            for (int t = 0; t < SCH; ++t) { w[t] = *(const u32x2*)(LAB + ((r0 + q * SCH + t) * D_ + ch) * 4); yg[t] = YG[(r0 + q * SCH + t) * D_ + ch]; }
#pragma unroll
            for (int t = 0; t < SCH; ++t) { hf = __expf(__uint_as_float(w[t].x << 16)) * hf + __uint_as_float(w[t].x & 0xffff0000u); w[t].x = __float_as_uint(hf); }
            float hb = (q == 0) ? hbin[0] : (q == 1) ? hbin[1] : (q == 2) ? hbin[2] : hbin[3];
#pragma unroll
            for (int t = SCH - 1; t >= 0; --t) {
                hb = __expf(__uint_as_float(w[t].y << 16)) * hb + __uint_as_float(w[t].y & 0xffff0000u);
                HL[(r0 + q * SCH + t) * D_ + ch] = f2bf((__uint_as_float(w[t].x) + hb) * bf2f(yg[t]));
            }
        }
        __syncthreads();
    }
}

typedef short bf16x8 __attribute__((ext_vector_type(8)));
#define LDS_WAIT() asm volatile("s_waitcnt lgkmcnt(0)" ::: "memory")

constexpr size_t WE_WIN = 0;
constexpr size_t WE_WUQ = WE_WIN + (size_t)L_ * 4864 * 1024;
constexpr size_t WE_WUKV = WE_WUQ + (size_t)L_ * 1024 * 256;
constexpr size_t WE_WG = WE_WUKV + (size_t)L_ * 1024 * 256;
constexpr size_t WE_WOL = WE_WG + (size_t)L_ * 4096 * 512;
constexpr size_t WE_WOM = WE_WOL + (size_t)L_ * 1024 * 1024;
constexpr size_t WE_WOUT = WE_WOM + (size_t)L_ * 1024 * 512;
constexpr size_t WE_FGU = WE_WOUT + (size_t)L_ * 1024 * 1024;
constexpr size_t WE_FD = WE_FGU + (size_t)2 * 5632 * 1024;
constexpr size_t WE_MGU = WE_FD + (size_t)2 * 1024 * 2816;
constexpr size_t WE_MD = WE_MGU + (size_t)16 * 5632 * 1024;
constexpr size_t WE_END = WE_MD + (size_t)16 * 1024 * 2816;
static_assert(WS_WEI + WE_END * 2 <= WS_AR, "weights region");

__device__ __forceinline__ unsigned cvt_pk_bf16(float lo, float hi) { unsigned r; asm volatile("v_cvt_pk_bf16_f32 %0, %1, %2" : "=v"(r) : "v"(lo), "v"(hi)); return r; }

namespace pg8 {
constexpr int BM = 256, BK = 64, HALF = 128, HTB = HALF * BK * 2, STAGE_BYTES = 8 * HTB, NXCD = 8, WGM = 8;
__host__ __device__ __forceinline__ int lds_byte(int r, int c) { const int st = (r >> 4) * 2 + (c >> 5), rr = r & 15, cc = c & 31, ob = rr * 64 + cc * 2; return st * 1024 + (ob ^ (((ob >> 9) & 1) << 5)); }
__host__ __device__ __forceinline__ void stage_rc(int b, int& R, int& C) { const int st = b / 1024, sb = b % 1024, swz = sb ^ (((sb >> 9) & 1) << 5); R = (st >> 1) * 16 + swz / 64; C = (st & 1) * 32 + (swz % 64) / 2; }
__host__ __device__ __forceinline__ int perm32(int rho) { const int n = rho >> 4, i = rho & 15; return 8 * (i >> 2) + 4 * n + (i & 3); }

struct Unit { int pm, pn; const char* A; const char* B; int aux; };
struct GemmCfg { int lda, ldb, K; unsigned apair; };

struct TileOrder {
    int nM, nN, nwg, G, c;
    __device__ __forceinline__ void init(int nM_, int nN_, int G_, int c_) { nM = nM_; nN = nN_; nwg = nM * nN; G = G_; c = c_; }
    __device__ __forceinline__ bool tile(int i, int& pm, int& pn) const {
        const long L = (long)i * G + c; if (L >= nwg) return false;
        int wgid = (int)L; { const int q = nwg / NXCD, r = nwg % NXCD, xcd = wgid % NXCD, off = wgid / NXCD; wgid = (xcd < r ? xcd * (q + 1) : r * (q + 1) + (xcd - r) * q) + off; }
        const int nig = WGM * nN, gid = wgid / nig, fm = gid * WGM, gsz = (nM - fm) < WGM ? (nM - fm) : WGM;
        pm = fm + ((wgid % nig) % gsz); pn = (wgid % nig) / gsz; return true;
    }
};
struct StdOrder {
    TileOrder T; const char* A0; const char* B0; size_t astep, bstep;
    __device__ __forceinline__ void init(int nM, int nN, int G, int c, const void* A, const void* B, int lda, int ldb) { T.init(nM, nN, G, c); A0 = (const char*)A; B0 = (const char*)B; astep = (size_t)BM * lda * 2; bstep = (size_t)BM * ldb * 2; }
    __device__ __forceinline__ bool next(int i, Unit& u) const { if (!T.tile(i, u.pm, u.pn)) return false; u.A = A0 + u.pm * astep; u.B = B0 + u.pn * bstep; u.aux = 0; return true; }
    __device__ __forceinline__ unsigned row_off(int, int) const { return 0u; }
};

#define PG8_SA(b, h) (((b) * 2 + (h)) * HTB)
#define PG8_SB(b, h) ((4 + (b) * 2 + (h)) * HTB)
#define PG8_GLDS(gp, lp) __builtin_amdgcn_global_load_lds((const unsigned*)(gp), (LAS unsigned*)(lp), 16, 0, 0)
#define PG8_STAGE_B(bufoff, gbase) do { _Pragma("unroll") for (int _i = 0; _i < 2; ++_i) PG8_GLDS((gbase) + voffB[_i], lds + (bufoff) + ldsw + _i * 8192); } while (0)
#define PG8_STAGE_A(bufoff, gbase, h, nx) do { _Pragma("unroll") for (int _i = 0; _i < 2; ++_i) PG8_GLDS((gbase) + ((GATHER && (nx)) ? vAn[h][_i] : vA[h][_i]), lds + (bufoff) + ldsw + _i * 8192); } while (0)
#define PG8_LDA(dst, b, h) do { _Pragma("unroll") for (int m = 0; m < 4; ++m) _Pragma("unroll") for (int k = 0; k < 2; ++k) dst[m][k] = *(const LAS bf16x8*)(lds + PG8_SA(b, h) + aoff + m * 2048 + k * 1024); } while (0)
#define PG8_LDB(dst, b, h) do { _Pragma("unroll") for (int n = 0; n < 2; ++n) _Pragma("unroll") for (int k = 0; k < 2; ++k) dst[n][k] = *(const LAS bf16x8*)(lds + PG8_SB(b, h) + boff + n * 2048 + k * 1024); } while (0)
#define PG8_MMA(ai, bj, At, Bt) do { __builtin_amdgcn_s_setprio(1); _Pragma("unroll") for (int m = 0; m < 4; ++m) _Pragma("unroll") for (int n = 0; n < 2; ++n) _Pragma("unroll") for (int k = 0; k < 2; ++k) \
        acc[ai][bj][m][n] = __builtin_amdgcn_mfma_f32_16x16x32_bf16(Bt[n][k], At[m][k], acc[ai][bj][m][n], 0, 0, 0); __builtin_amdgcn_s_setprio(0); } while (0)
#define PG8_WAIT_V(n) asm volatile("s_waitcnt vmcnt(" #n ")" ::: "memory")
#define PG8_WAIT_L(n) asm volatile("s_waitcnt lgkmcnt(" #n ")" ::: "memory")
#define PG8_BAR __builtin_amdgcn_s_barrier()
#define PG8_SCHED __builtin_amdgcn_sched_barrier(0)

template <class Epi, class Sched, bool ALIGN_EPI, bool GATHER>
__device__ __forceinline__ void gemm_phase(LAS unsigned char* lds, const GemmCfg g, const Sched& S, const Epi& E, int tid_in) {
    int tid = tid_in; asm volatile("" : "+v"(tid));
    const int wid = __builtin_amdgcn_readfirstlane(tid >> 6), lane = tid & 63, wr = wid >> 2, wc = wid & 3, fr = lane & 15, fq = lane >> 4;
    const int nt = g.K / BK;
    unsigned voffB[2], vA[2][2], vAn[2][2]; int Rr[2], Cc[2];
#pragma unroll
    for (int i = 0; i < 2; ++i) { int R, C; stage_rc(tid * 16 + i * 8192, R, C); Rr[i] = R; Cc[i] = C; const int Rb = Epi::PERM ? ((R & ~31) + perm32(R & 31)) : R;
        voffB[i] = (unsigned)(Rb * g.ldb + C) * 2u;
#pragma unroll
        for (int h = 0; h < 2; ++h) { vA[h][i] = (unsigned)((h * HALF + R) * g.lda + C) * 2u; vAn[h][i] = vA[h][i]; } }
    const size_t hstepB = (size_t)HALF * g.ldb * 2;
    const unsigned apair = g.apair;
    const unsigned ldsw = (unsigned)wid * 1024u;
    const int aoff = lds_byte(wr * 64 + fr, fq * 8), boff = lds_byte(wc * 32 + fr, fq * 8);
    Unit cur, nxt; int ui = 0;
    if (!S.next(0, cur)) return;
    if constexpr (GATHER) {
#pragma unroll
        for (int i = 0; i < 2; ++i)
#pragma unroll
            for (int h = 0; h < 2; ++h) { vA[h][i] = S.row_off(0, h * HALF + Rr[i]) + (unsigned)Cc[i] * 2u; vAn[h][i] = vA[h][i]; }
    }
    f32x4 acc[2][2][4][2];
#pragma unroll
    for (int a = 0; a < 2; ++a)
#pragma unroll
        for (int b = 0; b < 2; ++b)
#pragma unroll
            for (int m = 0; m < 4; ++m)
#pragma unroll
                for (int n = 0; n < 2; ++n) acc[a][b][m][n] = (f32x4){0.f, 0.f, 0.f, 0.f};
    bf16x8 At[4][2], B0[2][2], B1[2][2];
    const char* cA = cur.A; const char* cB = cur.B;
    PG8_STAGE_B(PG8_SB(0, 0), cB); PG8_STAGE_B(PG8_SB(0, 1), cB + hstepB); PG8_STAGE_A(PG8_SA(0, 0), cA, 0, false); PG8_STAGE_A(PG8_SA(0, 1), cA, 1, false);
    if (wr == 1) PG8_BAR;
    PG8_WAIT_V(2); PG8_BAR;
    PG8_STAGE_B(PG8_SB(1, 0), cB + 128); PG8_STAGE_A(PG8_SA(1, 0), cA + 128, 0, false); PG8_STAGE_B(PG8_SB(1, 1), cB + hstepB + 128);
    PG8_WAIT_V(6); PG8_BAR;
#pragma unroll 1
    for (;;) {
        const bool has_next = S.next(ui + 1, nxt);
        if constexpr (GATHER) { if (has_next) {
#pragma unroll
            for (int i = 0; i < 2; ++i)
#pragma unroll
                for (int h = 0; h < 2; ++h) vAn[h][i] = S.row_off(ui + 1, h * HALF + Rr[i]) + (unsigned)Cc[i] * 2u; } }
        const char* nA = has_next ? nxt.A : cA; const char* nB = has_next ? nxt.B : cB;
#pragma unroll 1
        for (int t = 0; t < nt; t += 2) {
            const bool last = (t == nt - 2);
            const char* ab = cA + (size_t)(t >> 1) * apair;
            const char* a1 = ab + 128;
            const char* a2 = last ? nA : ab + apair; const char* b2 = last ? nB : cB + (size_t)(t + 2) * 128;
            const char* a3 = a2 + 128; const char* b3 = b2 + 128;
            PG8_LDB(B0, 0, 0); PG8_LDB(B1, 0, 1); PG8_SCHED; PG8_LDA(At, 0, 0); PG8_STAGE_A(PG8_SA(1, 1), a1, 1, false);
            PG8_WAIT_V(8); PG8_WAIT_L(0); PG8_BAR; PG8_MMA(0, 0, At, B0); PG8_MMA(0, 1, At, B1); PG8_BAR; PG8_SCHED;
            PG8_LDA(At, 0, 1); PG8_STAGE_B(PG8_SB(0, 0), b2); PG8_STAGE_B(PG8_SB(0, 1), b2 + hstepB); PG8_STAGE_A(PG8_SA(0, 0), a2, 0, last);
            PG8_WAIT_V(8); PG8_WAIT_L(0); PG8_BAR; PG8_MMA(1, 0, At, B0); PG8_MMA(1, 1, At, B1); PG8_BAR; PG8_SCHED;
            PG8_LDB(B0, 1, 0); PG8_LDB(B1, 1, 1); PG8_SCHED; PG8_LDA(At, 1, 0); PG8_STAGE_A(PG8_SA(0, 1), a2, 1, last);
            PG8_WAIT_V(8); PG8_WAIT_L(0); PG8_BAR; PG8_MMA(0, 0, At, B0); PG8_MMA(0, 1, At, B1); PG8_BAR; PG8_SCHED;
            PG8_LDA(At, 1, 1); PG8_STAGE_B(PG8_SB(1, 0), b3); PG8_STAGE_B(PG8_SB(1, 1), b3 + hstepB); PG8_STAGE_A(PG8_SA(1, 0), a3, 0, last);
            PG8_WAIT_V(8); PG8_WAIT_L(0); PG8_BAR; PG8_MMA(1, 0, At, B0); PG8_MMA(1, 1, At, B1); PG8_BAR; PG8_SCHED;
        }
        if constexpr (ALIGN_EPI) { if (wr == 0) PG8_BAR; }
        E(acc, cur, wr, wc, fr, fq);
        if (!has_next) break;
#pragma unroll
        for (int a = 0; a < 2; ++a)
#pragma unroll
            for (int b = 0; b < 2; ++b)
#pragma unroll
                for (int m = 0; m < 4; ++m)
#pragma unroll
                    for (int n = 0; n < 2; ++n) acc[a][b][m][n] = (f32x4){0.f, 0.f, 0.f, 0.f};
        cur = nxt; cA = nA; cB = nB; ++ui;
        if constexpr (GATHER) {
#pragma unroll
            for (int i = 0; i < 2; ++i)
#pragma unroll
                for (int h = 0; h < 2; ++h) vA[h][i] = vAn[h][i]; }
        if constexpr (ALIGN_EPI) { if (wr == 1) PG8_BAR; }
    }
    PG8_WAIT_V(0);
    if constexpr (!ALIGN_EPI) { if (wr == 0) PG8_BAR; }
    PG8_BAR;
}
}
using pg8::Unit;
typedef f32x4 AccT[2][2][4][2];

__device__ __forceinline__ f32x4 sig4(f32x4 v) { f32x4 o; o.x = sigmoidf_(v.x); o.y = sigmoidf_(v.y); o.z = sigmoidf_(v.z); o.w = sigmoidf_(v.w); return o; }
__device__ __forceinline__ f32x4 gelu4(f32x4 v) { f32x4 o; o.x = gelu_tanh(v.x); o.y = gelu_tanh(v.y); o.z = gelu_tanh(v.z); o.w = gelu_tanh(v.w); return o; }
__device__ __forceinline__ u32x4 pack8(f32x4 a, f32x4 b) { u32x4 w; w.x = cvt_pk_bf16(a.x, a.y); w.y = cvt_pk_bf16(a.z, a.w); w.z = cvt_pk_bf16(b.x, b.y); w.w = cvt_pk_bf16(b.z, b.w); return w; }
__device__ __forceinline__ f32x4 unpack4(u32x2 w) { return (f32x4){__uint_as_float(w.x << 16), __uint_as_float(w.x & 0xffff0000u), __uint_as_float(w.y << 16), __uint_as_float(w.y & 0xffff0000u)}; }

struct EpiWin { static constexpr bool PERM = true; Params p;
    __device__ __forceinline__ void operator()(const AccT& acc, const Unit& u, int wr, int wc, int fr, int fq) const {
        const int pn = u.pn, row0 = u.pm * 256 + wr * 64 + fr, cl = wc * 32 + fq * 8;
        if (pn == 18) {
            if (wc == 0) { float* KR = PB(A_KR, float);
#pragma unroll
                for (int ai = 0; ai < 2; ++ai)
#pragma unroll
                    for (int m = 0; m < 4; ++m) { const size_t row = row0 + ai * 128 + m * 16; *(f32x4*)(KR + row * 32 + fq * 8) = acc[ai][0][m][0]; *(f32x4*)(KR + row * 32 + fq * 8 + 4) = acc[ai][0][m][1]; } }
            return;
        }
        bf16_t* base; int ld, act = 0; bool rmap = false;
        if (pn < 2) { base = PB(A_CQKV, bf16_t) + pn * 256; ld = 512;
            float* SSP = PB(WS_SSP, float);
#pragma unroll
            for (int ai = 0; ai < 2; ++ai)
#pragma unroll
                for (int m = 0; m < 4; ++m) { float ssq = 0.f;
#pragma unroll
                    for (int bj = 0; bj < 2; ++bj)
#pragma unroll
                        for (int n = 0; n < 2; ++n) { const f32x4 x = acc[ai][bj][m][n]; ssq += (x.x * x.x + x.y * x.y) + (x.z * x.z + x.w * x.w); }
                    ssq += __shfl_xor(ssq, 16); ssq += __shfl_xor(ssq, 32);
                    if (fq == 0) SSP[(size_t)(row0 + ai * 128 + m * 16) * 8 + pn * 4 + wc] = ssq; } }
        else if (pn < 6) { base = PB(A_UP, bf16_t) + (pn - 2) * 256; ld = 1024; rmap = true; }
        else if (pn < 10) { base = PB(A_YG, bf16_t) + (pn - 6) * 256; ld = 1024; act = 1; }
        else { base = PB(A_G, bf16_t) + (pn - 10) * 256; ld = 2048; act = 2; }
#pragma unroll
        for (int ai = 0; ai < 2; ++ai)
#pragma unroll
            for (int m = 0; m < 4; ++m) { const int row = row0 + ai * 128 + m * 16; const size_t rr = rmap ? (size_t)(row + (row >> 11) * 4 + 2) : (size_t)row;
#pragma unroll
                for (int bj = 0; bj < 2; ++bj) { f32x4 v0 = acc[ai][bj][m][0], v1 = acc[ai][bj][m][1];
                    if (act == 1) { v0 = gelu4(v0); v1 = gelu4(v1); } else if (act == 2) { v0 = sig4(v0); v1 = sig4(v1); }
                    *(u32x4*)(base + rr * ld + bj * 128 + cl) = pack8(v0, v1); } }
    } };
struct EpiBf { static constexpr bool PERM = true; bf16_t* O; int ld;
    __device__ __forceinline__ void operator()(const AccT& acc, const Unit& u, int wr, int wc, int fr, int fq) const {
        const int row0 = u.pm * 256 + wr * 64 + fr, c0 = u.pn * 256 + wc * 32 + fq * 8;
#pragma unroll
        for (int ai = 0; ai < 2; ++ai)
#pragma unroll
            for (int m = 0; m < 4; ++m) { bf16_t* rp = O + (size_t)(row0 + ai * 128 + m * 16) * ld + c0;
#pragma unroll
                for (int bj = 0; bj < 2; ++bj) *(u32x4*)(rp + bj * 128) = pack8(acc[ai][bj][m][0], acc[ai][bj][m][1]); }
    } };
struct EpiZ1 { static constexpr bool PERM = false; Params p;
    __device__ __forceinline__ void operator()(const AccT& acc, const Unit& u, int wr, int wc, int fr, int fq) const {
        const int row0 = u.pm * 256 + wr * 64 + fr, c0 = u.pn * 256 + wc * 32 + fq * 4; const bf16_t* G = PB(A_G, bf16_t); float* Z1 = PB(A_Z1, float);
#pragma unroll
        for (int ai = 0; ai < 2; ++ai)
#pragma unroll
            for (int m = 0; m < 4; ++m) { const size_t row = row0 + ai * 128 + m * 16;
#pragma unroll
                for (int bj = 0; bj < 2; ++bj)
#pragma unroll
                    for (int n = 0; n < 2; ++n) { const int c = c0 + bj * 128 + n * 16; const f32x4 gg = unpack4(*(const u32x2*)(G + row * 2048 + c)); *(f32x4*)(Z1 + row * D_ + c) = gg * acc[ai][bj][m][n]; } }
    } };
struct EpiZ { static constexpr bool PERM = false; Params p;
    __device__ __forceinline__ void operator()(const AccT& acc, const Unit& u, int wr, int wc, int fr, int fq) const {
        const int row0 = u.pm * 256 + wr * 64 + fr, c0 = u.pn * 256 + wc * 32 + fq * 4; const bf16_t* G = PB(A_G, bf16_t); const float* Z1 = PB(A_Z1, float); bf16_t* Z = PB(A_Z, bf16_t);
#pragma unroll
        for (int ai = 0; ai < 2; ++ai)
#pragma unroll
            for (int m = 0; m < 4; ++m) { const size_t row = row0 + ai * 128 + m * 16;
#pragma unroll
                for (int bj = 0; bj < 2; ++bj)
#pragma unroll
                    for (int n = 0; n < 2; ++n) { const int c = c0 + bj * 128 + n * 16; const f32x4 gg = unpack4(*(const u32x2*)(G + row * 2048 + 1024 + c));
                        const f32x4 v = *(const f32x4*)(Z1 + row * D_ + c) + gg * acc[ai][bj][m][n]; u32x2 w; w.x = cvt_pk_bf16(v.x, v.y); w.y = cvt_pk_bf16(v.z, v.w); *(u32x2*)(Z + row * D_ + c) = w; } }
    } };
struct EpiRes { static constexpr bool PERM = false; const float* xsrc; float* out; const float* gate  ;
    __device__ __forceinline__ void operator()(const AccT& acc, const Unit& u, int wr, int wc, int fr, int fq) const {
        const int row0 = u.pm * 256 + wr * 64 + fr, c0 = u.pn * 256 + wc * 32 + fq * 4; const float* gr = gate + (size_t)(u.pm >> 3) * 6144;
        f32x4 gv[2][2];
#pragma unroll
        for (int bj = 0; bj < 2; ++bj)
#pragma unroll
            for (int n = 0; n < 2; ++n) gv[bj][n] = *(const f32x4*)(gr + c0 + bj * 128 + n * 16);
#pragma unroll
        for (int ai = 0; ai < 2; ++ai)
#pragma unroll
            for (int m = 0; m < 4; ++m) { const size_t row = row0 + ai * 128 + m * 16;
#pragma unroll
                for (int bj = 0; bj < 2; ++bj)
#pragma unroll
                    for (int n = 0; n < 2; ++n) { const int c = c0 + bj * 128 + n * 16; *(f32x4*)(out + row * D_ + c) = *(const f32x4*)(xsrc + row * D_ + c) + gv[bj][n] * acc[ai][bj][m][n]; } }
    } };
struct EpiUp { static constexpr bool PERM = true; bf16_t* HID;
    __device__ __forceinline__ void operator()(const AccT& acc, const Unit& u, int wr, int wc, int fr, int fq) const {
        const int row0 = u.pm * 256 + wr * 64 + fr, c0 = u.pn * 128 + wc * 32 + fq * 8;
#pragma unroll
        for (int ai = 0; ai < 2; ++ai)
#pragma unroll
            for (int m = 0; m < 4; ++m) { const size_t row = row0 + ai * 128 + m * 16; f32x4 h0, h1;
                { const f32x4 a = acc[ai][0][m][0], b = acc[ai][1][m][0]; h0 = (f32x4){siluf_(a.x) * b.x, siluf_(a.y) * b.y, siluf_(a.z) * b.z, siluf_(a.w) * b.w}; }
                { const f32x4 a = acc[ai][0][m][1], b = acc[ai][1][m][1]; h1 = (f32x4){siluf_(a.x) * b.x, siluf_(a.y) * b.y, siluf_(a.z) * b.z, siluf_(a.w) * b.w}; }
                *(u32x4*)(HID + row * FF + c0) = pack8(h0, h1); }
    } };
struct EpiGates { static constexpr bool PERM = false; Params p; int l;
    __device__ __forceinline__ void operator()(const AccT& acc, const Unit& u, int wr, int wc, int fr, int fq) const {
        const int pn = u.pn, ch0 = (pn >> 1) * 128 + (pn & 1) * 64 + 16 * wc + 4 * fq;
        const float* GB = PB(WS_GB, float) + (size_t)l * 4096 + pn * 256 + 32 * wc + 4 * fq;
        const float* SPT = PB(WS_GB, float) + L_ * 4096 + (size_t)l * 2 * D_ + ch0;
        const float* CW = p.in[15] + (size_t)l * 4 * D_ + ch0; const float* CB = p.in[16] + (size_t)l * D_ + ch0;
        const bf16_t* UP = PB(A_UP, bf16_t); bf16_t* LAB = PB(A_LAB, bf16_t);
#pragma unroll
        for (int ai = 0; ai < 2; ++ai)
#pragma unroll
            for (int m = 0; m < 4; ++m) { const int row = u.pm * 256 + ai * 128 + wr * 64 + m * 16 + fr, b = row >> 11, s = row & (S_ - 1);
                asm volatile("" ::: "memory");
                const bf16_t* ur = UP + ((size_t)b * SP + s) * D_ + ch0;
                f32x4 uc = *(const f32x4*)CB;
#pragma unroll
                for (int tap = 0; tap < 4; ++tap) uc = uc + unpack4(*(const u32x2*)(ur + (size_t)tap * D_)) * *(const f32x4*)(CW + tap * D_);
                unsigned w[2][4];
#pragma unroll
                for (int dir = 0; dir < 2; ++dir) { const f32x4 r = sig4(acc[ai][dir][m][0] + *(const f32x4*)(GB + 128 * dir)), ig = sig4(acc[ai][dir][m][1] + *(const f32x4*)(GB + 128 * dir + 16)); const f32x4 la = r * *(const f32x4*)(SPT + dir * D_);
                    const bool first = (dir == 0) ? (s == 0) : (s == S_ - 1);
#pragma unroll
                    for (int j = 0; j < 4; ++j) { const float mult = first ? 1.0f : sqrtf(fmaxf(1.0f - __expf(2.0f * la[j]), 0.f)); w[dir][j] = cvt_pk_bf16(la[j], mult * ig[j] * uc[j]); } }
                u32x4* dst = (u32x4*)(LAB + ((size_t)row * D_ + ch0) * 4);
                dst[0] = (u32x4){w[0][0], w[1][0], w[0][1], w[1][1]}; dst[1] = (u32x4){w[0][2], w[1][2], w[0][3], w[1][3]}; }
    } };
struct GatesOrder {
    pg8::TileOrder T; const char* UPb; const char* B0;
    __device__ __forceinline__ void init(int G, int c, const void* up, const void* wg) { T.init(64, 16, G, c); UPb = (const char*)up; B0 = (const char*)wg; }
    __device__ __forceinline__ bool next(int i, Unit& u) const { if (!T.tile(i, u.pm, u.pn)) return false; const int b = u.pm >> 3, s0 = (u.pm & 7) * 256;
        u.A = UPb + (((size_t)b * SP + s0) * D_ + (u.pn >> 1) * 128) * 2; u.B = B0 + (size_t)u.pn * 256 * 512 * 2; u.aux = 0; return true; }
    __device__ __forceinline__ unsigned row_off(int, int) const { return 0u; }
};

__device__ __forceinline__ void moe_meta_fill(const Params& p, int l, volatile LAS unsigned* meta, int tid) {
    if (tid == 0) { const unsigned* cnt = PB(WS_CTL, unsigned) + CW_CNT + (l >> 1) * 1024; unsigned tb = 0;
        for (int e = 0; e < NE; ++e) { const unsigned c = __hip_atomic_load(cnt + 64 * e, __ATOMIC_RELAXED, __HIP_MEMORY_SCOPE_AGENT); meta[e] = c; meta[8 + e] = tb; tb += (c + 255u) >> 8; }
        meta[16] = tb; }
    __syncthreads();
}
__device__ __forceinline__ int xcd_remap(int L, int nwg) { const int q = nwg / 8, r = nwg % 8, xcd = L % 8, off = L / 8; return (xcd < r ? xcd * (q + 1) : r * (q + 1) + (xcd - r) * q) + off; }
struct MoeOrder {
    volatile LAS unsigned* meta; LAS unsigned* tok; int G, c, npn, nwg; const char* A0; const char* B0; size_t atile, bexp, btile;
    __device__ __forceinline__ void locate(int L, int& rt, int& pn, int& e, int& j) const {
        const int wgid = xcd_remap(L, nwg); rt = wgid / npn; pn = wgid - rt * npn; e = 0;
#pragma unroll
        for (int k = 1; k < NE; ++k) e += (rt >= (int)meta[8 + k]) ? 1 : 0;
        j = rt - (int)meta[8 + e];
    }
    __device__ __forceinline__ bool next(int i, Unit& u) const {
        const int L = i * G + c; if (L >= nwg) return false;
        int rt, pn, e, j; locate(L, rt, pn, e, j);
        rt = __builtin_amdgcn_readfirstlane(rt); pn = __builtin_amdgcn_readfirstlane(pn); e = __builtin_amdgcn_readfirstlane(e); j = __builtin_amdgcn_readfirstlane(j);
        u.pm = rt; u.pn = pn; u.aux = e | (j << 4); u.A = A0 + (size_t)rt * atile; u.B = B0 + (size_t)e * bexp + (size_t)pn * btile; return true;
    }
    __device__ __forceinline__ unsigned row_off(int i, int r) const { return tok[i * 256 + r]; }
    __device__ __forceinline__ void fill_tok(const Params& p, int tid) const {
        const int* list = PB(WS_LIST, int);
        for (int idx = tid; idx < 16 * 256; idx += 512) { const int i = idx >> 8, r = idx & 255, L = i * G + c; unsigned off = 0u;
            if (L < nwg) { int rt, pn, e, j; locate(L, rt, pn, e, j); const int pos = j * 256 + r; if (pos < (int)meta[e]) off = (unsigned)(list[(size_t)e * T_ + pos] >> 1) * (unsigned)(D_ * 2); }
            tok[idx] = off; }
        __syncthreads();
    }
};
struct EpiMoeDown { static constexpr bool PERM = false; Params p; int l;
    __device__ __forceinline__ void operator()(const AccT& acc, const Unit& u, int wr, int wc, int fr, int fq) const {
        const int e = u.aux & 15, j = u.aux >> 4; const int cnt = (int)(PB(WS_CTL, unsigned) + CW_CNT + (l >> 1) * 1024)[64 * e];
        const int* list = PB(WS_LIST, int) + (size_t)e * T_; const float* tw = PB(WS_TW, float); const int c0 = u.pn * 256 + wc * 32 + fq * 4;
#pragma unroll
        for (int ai = 0; ai < 2; ++ai)
#pragma unroll
            for (int m = 0; m < 4; ++m) { const int pos = j * 256 + ai * 128 + wr * 64 + m * 16 + fr;
                if (pos < cnt) { const int ent = list[pos]; const float w = tw[ent]; float* Y = ((ent & 1) ? PB(A_Y1, float) : PB(A_Y0, float)) + (size_t)(ent >> 1) * D_ + c0;
#pragma unroll
                    for (int bj = 0; bj < 2; ++bj)
#pragma unroll
                        for (int n = 0; n < 2; ++n) *(f32x4*)(Y + bj * 128 + n * 16) = acc[ai][bj][m][n] * w; } }
    } };

namespace att {
typedef short s16x4 __attribute__((ext_vector_type(4)));
typedef float f32x16 __attribute__((ext_vector_type(16)));
constexpr int KVBLK = 64, SHM_V = KVBLK * VD * 2  , SHM_K = KVBLK * 256  , LDS_ATT = 2 * SHM_V + 2 * SHM_K + 8 * 64 * 4;
constexpr float THR2 = 11.5f;
#define KSWZ(row, colB) ((row) * 256 + ((colB) ^ (((row) & 7) << 4)))
#define SBAR() __builtin_amdgcn_sched_barrier(0)
__device__ __forceinline__ int crow(int r, int hi) { return (r & 3) + 8 * (r >> 2) + 4 * hi; }
__device__ __forceinline__ void partialSM(f32x16& p0, f32x16& p1, float& m_reg, float& mn, float& alpha) {
    float pmax = p0[0];
#pragma unroll
    for (int r = 1; r < 16; ++r) pmax = fmaxf(pmax, p0[r]);
#pragma unroll
    for (int r = 0; r < 16; ++r) pmax = fmaxf(pmax, p1[r]);
    { auto rr = __builtin_amdgcn_permlane32_swap(__float_as_uint(pmax), __float_as_uint(pmax), false, false); pmax = fmaxf(__uint_as_float(rr[0]), __uint_as_float(rr[1])); }
    if (__builtin_expect(__all(pmax - m_reg <= THR2), 1)) { mn = m_reg; alpha = 1.f; }
    else { mn = fmaxf(m_reg, pmax); alpha = __builtin_amdgcn_exp2f(m_reg - mn); m_reg = mn; }
#pragma unroll
    for (int r = 0; r < 16; ++r) p0[r] = p0[r] - mn;
#pragma unroll
    for (int r = 0; r < 16; ++r) p1[r] = p1[r] - mn;
#pragma unroll
    for (int r = 0; r < 16; ++r) p0[r] = __builtin_amdgcn_exp2f(p0[r]);
}
__device__ __forceinline__ void finishSM(f32x16& p0, f32x16& p1, float alpha, float& l_reg, bf16x8& pa0, bf16x8& pa1, bf16x8& pa2, bf16x8& pa3) {
#pragma unroll
    for (int r = 0; r < 16; ++r) p1[r] = __builtin_amdgcn_exp2f(p1[r]);
    float ps = 0;
#pragma unroll
    for (int r = 0; r < 16; ++r) ps += p0[r];
#pragma unroll
    for (int r = 0; r < 16; ++r) ps += p1[r];
    { auto rr = __builtin_amdgcn_permlane32_swap(__float_as_uint(ps), __float_as_uint(ps), false, false); ps = __uint_as_float(rr[0]) + __uint_as_float(rr[1]); }
    l_reg = l_reg * alpha + ps;
#define PK4(P, BASE, OUT) do { unsigned a0 = cvt_pk_bf16(P[BASE + 0], P[BASE + 1]), a1 = cvt_pk_bf16(P[BASE + 2], P[BASE + 3]);   \
    unsigned b0 = cvt_pk_bf16(P[BASE + 4], P[BASE + 5]), b1 = cvt_pk_bf16(P[BASE + 6], P[BASE + 7]);                              \
    auto r0 = __builtin_amdgcn_permlane32_swap(a0, b0, false, false); auto r1 = __builtin_amdgcn_permlane32_swap(a1, b1, false, false); \
    u32x4 w = {r0[0], r1[0], r0[1], r1[1]}; OUT = *reinterpret_cast<bf16x8*>(&w); } while (0)
    PK4(p0, 0, pa0); PK4(p0, 8, pa1); PK4(p1, 0, pa2); PK4(p1, 8, pa3);
#undef PK4
}
__device__ __forceinline__ void qkt(f32x16& p0, f32x16& p1, const LAS char* Ks, const bf16x8* qr, int r32, int hi) {
    p0 = f32x16{}; p1 = f32x16{};
#pragma unroll
    for (int d0 = 0; d0 < 6; ++d0) { const int cb = (d0 * 16 + hi * 8) * 2;
        const bf16x8 b0 = *(const LAS bf16x8*)(Ks + KSWZ(r32, cb));
        const bf16x8 b1 = *(const LAS bf16x8*)(Ks + KSWZ(32 + r32, cb));
        p0 = __builtin_amdgcn_mfma_f32_32x32x16_bf16(b0, qr[d0], p0, 0, 0, 0);
        p1 = __builtin_amdgcn_mfma_f32_32x32x16_bf16(b1, qr[d0], p1, 0, 0, 0); }
}
__device__ __forceinline__ int v_st(int k, int c) { const int kk = (k & ~0xC) | ((k & 4) << 1) | ((k & 8) >> 1); return ((kk >> 3) * 2 + (c >> 5)) * 512 + ((kk & 7) * 32 + (c & 31)) * 2; }
__device__ __forceinline__ int v_rd_base(int lane) { return ((lane & 3) << 3) | (((lane >> 2) & 3) << 6) | (((lane >> 4) & 1) << 5) | (((lane >> 5) & 1) << 8); }
constexpr int v_rd_off(int d0, int ks, int half) { return d0 * 512 + ks * 2048 + half * 1024; }
template <int OFF> __device__ __forceinline__ s16x4 tr_read(int vb) { s16x4 r; asm volatile("ds_read_b64_tr_b16 %0, %1 offset:%2" : "=&v"(r) : "v"(vb), "i"(OFF) : "memory"); return r; }
template <int D0> __device__ __forceinline__ void pv_one(f32x16& od, int vb, bf16x8 pa0, bf16x8 pa1, bf16x8 pa2, bf16x8 pa3) {
    const s16x4 l0 = tr_read<v_rd_off(D0, 0, 0)>(vb), h0 = tr_read<v_rd_off(D0, 0, 1)>(vb), l1 = tr_read<v_rd_off(D0, 1, 0)>(vb), h1 = tr_read<v_rd_off(D0, 1, 1)>(vb);
    const s16x4 l2 = tr_read<v_rd_off(D0, 2, 0)>(vb), h2 = tr_read<v_rd_off(D0, 2, 1)>(vb), l3 = tr_read<v_rd_off(D0, 3, 0)>(vb), h3 = tr_read<v_rd_off(D0, 3, 1)>(vb);
    asm volatile("s_waitcnt lgkmcnt(0)" ::: "memory"); SBAR();
#define PKV(L, H) (bf16x8){L[0], L[1], L[2], L[3], H[0], H[1], H[2], H[3]}
    od = __builtin_amdgcn_mfma_f32_32x32x16_bf16(pa0, PKV(l0, h0), od, 0, 0, 0);
    od = __builtin_amdgcn_mfma_f32_32x32x16_bf16(pa1, PKV(l1, h1), od, 0, 0, 0);
    od = __builtin_amdgcn_mfma_f32_32x32x16_bf16(pa2, PKV(l2, h2), od, 0, 0, 0);
    od = __builtin_amdgcn_mfma_f32_32x32x16_bf16(pa3, PKV(l3, h3), od, 0, 0, 0);
#undef PKV
}
__device__ __forceinline__ void pv_d0(f32x16* o, int vb, bf16x8 pa0, bf16x8 pa1, bf16x8 pa2, bf16x8 pa3) { pv_one<0>(o[0], vb, pa0, pa1, pa2, pa3); pv_one<1>(o[1], vb, pa0, pa1, pa2, pa3); }

__device__ __forceinline__ void attn_unit(const bf16_t* __restrict__ Qb, const bf16_t* __restrict__ Kh, const bf16_t* __restrict__ Vh, bf16_t* __restrict__ Ob, int seq, LAS char* lds, int tid) {
    const int wid = tid >> 6, lane = tid & 63, r32 = lane & 31, hi = lane >> 5;
    LAS char* V_lds = lds; LAS char* K_lds = lds + 2 * SHM_V;
    LAS float* ws = (LAS float*)(lds + 2 * SHM_V + 2 * SHM_K) + wid * 64; LAS float* li_l = ws; LAS float* al_l = ws + 32;
    float m_reg = -1e30f, l_reg = 0; f32x16 o[2] = {}; bf16x8 qr[6];
    const bf16_t* Qw = Qb + (size_t)(wid * 32 + r32) * QKD + hi * 8;
#pragma unroll
    for (int d0 = 0; d0 < 6; ++d0) qr[d0] = *(const bf16x8*)(Qw + d0 * 16);
    const int vrow = tid >> 3, vch = tid & 7, vst = v_st(vrow, vch * 8);
    const int k0row = tid / 12, k0ch = tid % 12; const bool k1ok = tid < 256; const int id1 = k1ok ? tid + 512 : tid, k1row = id1 / 12, k1ch = id1 % 12;
    const int kst0 = KSWZ(k0row, k0ch * 16), kst1 = KSWZ(k1row, k1ch * 16);
    const int vb0 = (int)(uintptr_t)V_lds + v_rd_base(lane);
    struct { bf16x8 v, k0, k1; } sr_[2];
    const unsigned vgo = (unsigned)(vrow * VD + vch * 8) * 2u, kgo0 = (unsigned)(k0row * QKD + k0ch * 8) * 2u, kgo1 = (unsigned)(k1row * QKD + k1ch * 8) * 2u;
#define SLOAD(i, kk0) do { const char* vt_ = (const char*)Vh + (size_t)(kk0) * (VD * 2); const char* kt_ = (const char*)Kh + (size_t)(kk0) * (QKD * 2); \
    sr_[i].v = *(const bf16x8*)(vt_ + vgo); sr_[i].k0 = *(const bf16x8*)(kt_ + kgo0); sr_[i].k1 = *(const bf16x8*)(kt_ + kgo1); } while (0)
#define SWRITE(b, i) do { *(LAS bf16x8*)(V_lds + (b) * SHM_V + vst) = sr_[i].v; *(LAS bf16x8*)(K_lds + (b) * SHM_K + kst0) = sr_[i].k0; if (k1ok) *(LAS bf16x8*)(K_lds + (b) * SHM_K + kst1) = sr_[i].k1; } while (0)
#define SWAIT() asm volatile("s_waitcnt vmcnt(3)" ::: "memory")
#define RESC(a) do { if (__any((a) < 1.f)) { if (hi == 0) al_l[r32] = (a); asm volatile("s_waitcnt lgkmcnt(0)" ::: "memory"); \
    _Pragma("unroll") for (int d = 0; d < 2; ++d) _Pragma("unroll") for (int r = 0; r < 16; ++r) o[d][r] *= al_l[crow(r, hi)]; } } while (0)
    f32x16 pA0, pA1, pB0, pB1; float mnA, mnB, alA, alB; bf16x8 pa0, pa1, pa2, pa3; const int NT = seq / KVBLK;
    constexpr int SE = 0, SO = 1;
    SLOAD(SE, 0); asm volatile("s_waitcnt vmcnt(0)" ::: "memory"); SWRITE(0, SE); __syncthreads();
    qkt(pA0, pA1, K_lds, qr, r32, hi); partialSM(pA0, pA1, m_reg, mnA, alA);
    SLOAD(SO, KVBLK); if (2 < NT) SLOAD(SE, 2 * KVBLK);
    SWAIT(); SWRITE(1, SO); __syncthreads();
#pragma unroll 1
    for (int j = 1; j + 1 < NT; j += 2) {
        SBAR(); qkt(pB0, pB1, K_lds + SHM_K, qr, r32, hi);
        finishSM(pA0, pA1, alA, l_reg, pa0, pa1, pa2, pa3); SBAR();
        SLOAD(SO, (j + 2) * KVBLK); SBAR();
        pv_d0(o, vb0, pa0, pa1, pa2, pa3); partialSM(pB0, pB1, m_reg, mnB, alB);
        __syncthreads(); SWAIT(); SWRITE(0, SE);
        RESC(alB); __syncthreads();
        SBAR(); qkt(pA0, pA1, K_lds, qr, r32, hi);
        finishSM(pB0, pB1, alB, l_reg, pa0, pa1, pa2, pa3); SBAR();
        if (j + 3 < NT) SLOAD(SE, (j + 3) * KVBLK); SBAR();
        pv_d0(o, vb0 + SHM_V, pa0, pa1, pa2, pa3); partialSM(pA0, pA1, m_reg, mnA, alA);
        __syncthreads(); SWAIT(); SWRITE(1, SO);
        RESC(alA); __syncthreads();
    }
    SBAR(); qkt(pB0, pB1, K_lds + SHM_K, qr, r32, hi);
    finishSM(pA0, pA1, alA, l_reg, pa0, pa1, pa2, pa3); SBAR();
    pv_d0(o, vb0, pa0, pa1, pa2, pa3); partialSM(pB0, pB1, m_reg, mnB, alB);
    __syncthreads(); RESC(alB);
    finishSM(pB0, pB1, alB, l_reg, pa0, pa1, pa2, pa3); SBAR();
    pv_d0(o, vb0 + SHM_V, pa0, pa1, pa2, pa3);
    if (hi == 0) li_l[r32] = l_reg; asm volatile("s_waitcnt lgkmcnt(0)" ::: "memory");
    bf16_t* Ow = Ob + (size_t)(wid * 32) * 512;
#pragma unroll
    for (int r = 0; r < 16; ++r) { const int orow = crow(r, hi); const float rl = __builtin_amdgcn_rcpf(li_l[orow]);
#pragma unroll
        for (int d0 = 0; d0 < 2; ++d0) Ow[(size_t)orow * 512 + d0 * 32 + r32] = f2bf(o[d0][r] * rl); }
    __syncthreads();
#undef SLOAD
#undef SWRITE
#undef SWAIT
#undef RESC
}
#undef KSWZ
#undef SBAR
}
__device__ __forceinline__ void ph_attn(const Params& p, LAS unsigned char* lds, int blk, int G, int tid) {
    const bf16_t* Q = PB(A_Q, bf16_t); const bf16_t* K = PB(A_K, bf16_t); const bf16_t* V = PB(A_V, bf16_t); bf16_t* O = PB(A_O, bf16_t);
#pragma unroll 1
    for (int i = 0;; ++i) {
        const int L = i * G + blk; if (L >= B_ * H_ * 8) break;
        int bh, qb;
        if (G == 256) { const int x = blk & 7, y = blk >> 3; bh = i * 32 + x * 4 + (y >> 3); qb = y & 7; } else { bh = L >> 3; qb = L & 7; }
        const int b = bh >> 3, h = bh & 7;
        att::attn_unit(Q + ((size_t)bh * S_ + qb * 256) * QKD, K + (size_t)bh * S_ * QKD, V + (size_t)bh * S_ * VD, O + ((size_t)b * S_ + qb * 256) * 512 + h * VD, S_, (LAS char*)lds, tid);
    }
}

__device__ __forceinline__ void tr_item64(const float* src4, size_t ldw, int k0, const float* ksc, bf16_t* dst, int Kd, LAS float* scr, int lane) {
    const int r = lane >> 4, c4 = lane & 15;
    f32x4 v[16];
#pragma unroll
    for (int i = 0; i < 16; ++i) v[i] = src4 ? *(const f32x4*)(src4 + (size_t)(k0 + 4 * i + r) * ldw) : (f32x4){0.f, 0.f, 0.f, 0.f};
#pragma unroll
    for (int i = 0; i < 16; ++i) { const int kk = 4 * i + r; f32x4 x = v[i]; if (ksc) x = x * ksc[kk]; LAS float* d = scr + kk * 65 + 4 * c4; d[0] = x.x; d[1] = x.y; d[2] = x.z; d[3] = x.w; }
    LDS_WAIT(); asm volatile("" ::: "memory");
    const int c = lane & 7;
#pragma unroll
    for (int j = 0; j < 8; ++j) { const int n = (lane >> 3) + 8 * j; const LAS float* sp = scr + (8 * c) * 65 + n;
        u32x4 o; o.x = pk2(sp[0 * 65], sp[1 * 65]); o.y = pk2(sp[2 * 65], sp[3 * 65]); o.z = pk2(sp[4 * 65], sp[5 * 65]); o.w = pk2(sp[6 * 65], sp[7 * 65]);
        *(u32x4*)(dst + (size_t)n * Kd + 8 * c) = o; }
    LDS_WAIT(); asm volatile("" ::: "memory");
}
__device__ __forceinline__ void p0_weights(const Params& p, LAS float* scr, int gw, int ngw, int lane) {
    bf16_t* WB = PB(WS_WEI, bf16_t);
    constexpr int PER_L = 2496, N_L = L_ * PER_L, PER_F = 2112, N_D = 2 * PER_F, N_M = 16 * PER_F;
    const int c4 = (lane & 15) * 4;
    for (int it = gw; it < N_L + N_D + N_M; it += ngw) {
        const float* src = nullptr; size_t ldw = 0; int k0 = 0; const float* ksc = nullptr; bf16_t* dst = nullptr; int Kd = 0;
        if (it < N_L) {
            const int l = it / PER_L; int r = it % PER_L;
            if (r < 1216) { const int kb = r & 15, nd0 = (r >> 4) * 64, nd = nd0 + c4; const int sc = nd < 512 ? nd : (nd < 4608 ? nd + 32 : (nd < 4640 ? 512 + nd - 4608 : -1));
                if (sc >= 0) src = p.in[7] + (size_t)l * D_ * INC + sc; ldw = INC; k0 = kb * 64; Kd = 1024; dst = WB + WE_WIN + ((size_t)l * 4864 + nd0) * 1024 + k0; }
            else if ((r -= 1216) < 64) { const int kb = r & 3, nd0 = (r >> 2) * 64, nd = nd0 + c4, h = nd >> 7, d = nd & 127;
                if (d < 96) src = p.in[10] + (size_t)l * 256 * 768 + h * 96 + d; ldw = 768; k0 = kb * 64; Kd = 256; ksc = p.in[8] + l * 256 + k0; dst = WB + WE_WUQ + ((size_t)l * 1024 + nd0) * 256 + k0; }
            else if ((r -= 64) < 64) { const int kb = r & 3, nd0 = (r >> 2) * 64;
                src = p.in[11] + (size_t)l * 256 * 1024 + nd0 + c4; ldw = 1024; k0 = kb * 64; Kd = 256; ksc = p.in[9] + l * 256 + k0; dst = WB + WE_WUKV + ((size_t)l * 1024 + nd0) * 256 + k0; }
            else if ((r -= 64) < 512) { const int kh = r & 1, tap = (r >> 1) & 3, b4 = (r >> 3) & 3, pn = r >> 5, nbk = pn >> 1, hc = pn & 1, c = b4 * 64 + c4, dir = c >> 7, wc = (c >> 5) & 3, gate = (c >> 4) & 1, e = hc * 64 + 16 * wc + (c & 15);
                src = p.in[17] + ((((size_t)l * 2 + dir) * 2 + gate) * NE + nbk) * 128 * 128 + e; ldw = 128; k0 = kh * 64; ksc = p.in[15] + ((size_t)l * 4 + tap) * D_ + nbk * 128 + k0; Kd = 512;
                dst = WB + WE_WG + ((size_t)l * 4096 + pn * 256 + b4 * 64) * 512 + tap * 128 + k0; }
            else if ((r -= 512) < 256) { const int kb = r & 15, nd0 = (r >> 4) * 64;
                src = p.in[20] + (size_t)l * D_ * D_ + nd0 + c4; ldw = 1024; k0 = kb * 64; Kd = 1024; dst = WB + WE_WOL + ((size_t)l * 1024 + nd0) * 1024 + k0; }
            else if ((r -= 256) < 128) { const int kb = r & 7, nd0 = (r >> 3) * 64;
                src = p.in[14] + (size_t)l * 512 * D_ + nd0 + c4; ldw = 1024; k0 = kb * 64; Kd = 512; dst = WB + WE_WOM + ((size_t)l * 1024 + nd0) * 512 + k0; }
            else { r -= 128; const int kb = r & 15, nd0 = (r >> 4) * 64;
                src = p.in[21] + (size_t)l * D_ * D_ + nd0 + c4; ldw = 1024; k0 = kb * 64; Kd = 1024; dst = WB + WE_WOUT + ((size_t)l * 1024 + nd0) * 1024 + k0; }
        } else {
            const bool moe = it >= N_L + N_D; int r = moe ? it - N_L - N_D : it - N_L; const int ie = r / PER_F; r %= PER_F;
            const float* Wg = (moe ? p.in[26] : p.in[22]) + (size_t)ie * D_ * FF; const float* Wu = (moe ? p.in[27] : p.in[23]) + (size_t)ie * D_ * FF; const float* Wd = (moe ? p.in[28] : p.in[24]) + (size_t)ie * FF * D_;
            bf16_t* GU = WB + (moe ? WE_MGU : WE_FGU) + (size_t)ie * 5632 * 1024; bf16_t* DN = WB + (moe ? WE_MD : WE_FD) + (size_t)ie * 1024 * 2816;
            if (r < 1408) { const int kb = r & 15, nd0 = (r >> 4) * 64, nd = nd0 + c4, pn = nd >> 8, rr = nd & 255;
                src = (rr < 128 ? Wg : Wu) + pn * 128 + (rr & 127); ldw = FF; k0 = kb * 64; Kd = 1024; dst = GU + (size_t)nd0 * 1024 + k0; }
            else { r -= 1408; const int kb = r % 44, nd0 = (r / 44) * 64;
                src = Wd + nd0 + c4; ldw = 1024; k0 = kb * 64; Kd = 2816; dst = DN + (size_t)nd0 * 2816 + k0; }
        }
        tr_item64(src, ldw, k0, ksc, dst, Kd, scr, lane);
    }
}
__device__ __forceinline__ void p0_gbias(const Params& p, int gt, int ngt) {
    float* GB = PB(WS_GB, float);
    for (int idx = gt; idx < L_ * 4096; idx += ngt) {
        const int l = idx >> 12, pn = (idx >> 8) & 15, c = idx & 255, dir = c >> 7, wc = (c >> 5) & 3, n = (c >> 4) & 1, fq = (c >> 2) & 3, j = c & 3;
        const int nbk = pn >> 1, e = (pn & 1) * 64 + 16 * wc + 4 * fq + j, ch = nbk * 128 + e;
        const float* gwp = p.in[17] + ((((size_t)l * 2 + dir) * 2 + n) * NE + nbk) * 128 * 128 + e; const float* cb = p.in[16] + (size_t)l * D_ + nbk * 128;
        float sacc = p.in[18][(((size_t)l * 2 + dir) * 2 + n) * D_ + ch];
        for (int k = 0; k < 128; ++k) sacc += cb[k] * gwp[(size_t)k * 128];
        GB[idx] = sacc;
    }
    float* SPT = PB(WS_GB, float) + L_ * 4096;
    for (int idx = gt; idx < L_ * 2 * D_; idx += ngt) SPT[idx] = -8.0f * softplusf_(p.in[19][idx]);
}

#define XB_TMO      128
#define XB_XCNT(j)  (256  + 64 * (j))
#define XB_XSUB(j)  (1280 + 64 * (j))
#define XB_XGEN(j)  (2304 + 64 * (j))
#define XB_TOP      3328
#define XB_TOPGEN   3392
#define XCD_BAR_WORDS 3456
#define XB_SPIN_CAP (1u << 18)
__device__ __forceinline__ unsigned xb_ld(unsigned* p)              { return __hip_atomic_load(p, __ATOMIC_RELAXED, __HIP_MEMORY_SCOPE_AGENT); }
__device__ __forceinline__ unsigned xb_add(unsigned* p, unsigned v) { return __hip_atomic_fetch_add(p, v, __ATOMIC_RELAXED, __HIP_MEMORY_SCOPE_AGENT); }
__device__ __forceinline__ unsigned xb_xcc_id() { return (unsigned)__builtin_amdgcn_s_getreg((3 << 11) | 20) & 0xFu; }
#define XB_SPIN(cond, bar) do { unsigned _sp = 0; while (cond) { __builtin_amdgcn_s_sleep(1); \
    if ((++_sp & 255u) == 0u) { if (xb_ld(&(bar)[XB_TMO])) break; if (_sp > XB_SPIN_CAP) { atomicAdd(&(bar)[XB_TMO], 1u); break; } } } } while (0)
struct XcdBarrier { unsigned* bar; unsigned x; volatile LAS unsigned* st; };
__device__ __forceinline__ XcdBarrier xcd_barrier_post(unsigned* bar, volatile LAS unsigned* st) {
    XcdBarrier b; b.bar = bar; b.x = xb_xcc_id(); b.st = st;
    if (threadIdx.x == 0) (void)xb_add(&bar[XB_XCNT(b.x)], 1u);
    return b;
}
__device__ __forceinline__ void xcd_barrier_complete(unsigned* bar, unsigned x, unsigned& nloc, unsigned& nx) {
    const unsigned G = gridDim.x * gridDim.y * gridDim.z;
    unsigned sum, cnt, mine, sp = 0u;
    for (;;) {
        sum = 0u; cnt = 0u; mine = 0u;
#pragma unroll
        for (unsigned j = 0; j < 16; ++j) { const unsigned c = xb_ld(&bar[XB_XCNT(j)]); sum += c; cnt += (c > 0u) ? 1u : 0u; }
        mine = xb_ld(&bar[XB_XCNT(x)]);
        if (sum == G) break;
        __builtin_amdgcn_s_sleep(1);
        if ((++sp & 255u) == 0u) { if (xb_ld(&bar[XB_TMO])) break; if (sp > XB_SPIN_CAP) { atomicAdd(&bar[XB_TMO], 1u); break; } }
    }
    nloc = mine > 0u ? mine : 1u; nx = cnt > 0u ? cnt : 1u;
}
__device__ __forceinline__ void xcd_barrier(const XcdBarrier& b) {
    asm volatile("s_waitcnt vmcnt(0)" ::: "memory");
    __syncthreads();
    if (threadIdx.x == 0) {
        unsigned* bar = b.bar;
        __builtin_amdgcn_s_waitcnt(0);
        unsigned nloc = b.st[0], nx = b.st[1];
        if (nloc == 0u) { xcd_barrier_complete(bar, b.x, nloc, nx); b.st[0] = nloc; b.st[1] = nx; }
        const unsigned old = xb_add(&bar[XB_XSUB(b.x)], 1u);
        const unsigned gen = old / nloc;
        if (old + 1u == (gen + 1u) * nloc) {
            __builtin_amdgcn_fence(__ATOMIC_RELEASE, "agent");
            asm volatile("s_waitcnt vmcnt(0)" ::: "memory");
            const unsigned og = xb_add(&bar[XB_TOP], 1u);
            const unsigned tg = og / nx;
            if (og + 1u == (tg + 1u) * nx) xb_add(&bar[XB_TOPGEN], 1u);
            else XB_SPIN(xb_ld(&bar[XB_TOPGEN]) == tg, bar);
            __builtin_amdgcn_fence(__ATOMIC_ACQUIRE, "agent");
            xb_add(&bar[XB_XGEN(b.x)], 1u);
            asm volatile("s_waitcnt vmcnt(0)" ::: "memory");
        } else {
            XB_SPIN(xb_ld(&bar[XB_XGEN(b.x)]) == gen, bar);
            __builtin_amdgcn_fence(__ATOMIC_ACQUIRE, "agent");
            asm volatile("s_waitcnt vmcnt(0)" ::: "memory");
        }
    }
    __syncthreads();
}

constexpr int RING_BYTES = 131072, LDS_TOK = RING_BYTES, LDS_MISC = RING_BYTES + 16384, LDS_BYTES = LDS_MISC + 1024;
constexpr int NPL = 14;
enum { SS_NORM1 = 0, SS_WIN, SS_PREP1, SS_QG, SS_KVG, SS_GATES, SS_PREP2, SS_ATTN, SS_Z1, SS_Z, SS_RES, SS_NORM2, SS_UP, SS_DOWN };
constexpr int ST_FINAL = 1 + L_ * NPL, NSTEPS = ST_FINAL + 1;
struct Args { Params p; int s_lo, s_hi, li, pad; };
typedef const Args __attribute__((address_space(4)))* KArgsP;
#if defined(__HIP_DEVICE_COMPILE__)
#define KP() ({ KArgsP _k = (KArgsP)__builtin_amdgcn_kernarg_segment_ptr(); asm volatile("" : "+s"(_k)); _k->p; })
#else
#define KP() (a.p)
#endif

__global__ void __launch_bounds__(512, 2) mk_fwd(Args a) {
    extern __shared__ __attribute__((aligned(16))) unsigned char lds_raw[];
    LAS unsigned char* lds = (LAS unsigned char*)lds_raw;
    const int tid = threadIdx.x;
    const int wave_s = __builtin_amdgcn_readfirstlane(tid >> 6);
#define PH_BEGIN const Params p = KP(); int tid_ = wave_s * 64 + (int)__builtin_amdgcn_mbcnt_hi(~0u, __builtin_amdgcn_mbcnt_lo(~0u, 0u)); asm volatile("" : "+v"(tid_)); int blk_ = blockIdx.x, G = gridDim.x; asm volatile("" : "+s"(blk_), "+s"(G)); \
    const int lane = tid_ & 63, wave = __builtin_amdgcn_readfirstlane(tid_ >> 6), gw = blk_ * 8 + wave, ngw = G * 8, gt = blk_ * 512 + tid_, ngt = G * 512; (void)lane; (void)gw; (void)ngw; (void)gt; (void)ngt;
    volatile LAS unsigned* MISC = (volatile LAS unsigned*)(lds + LDS_MISC);
    for (int u = tid; u < 256; u += 512) MISC[u] = 0u;
    __syncthreads();
    XcdBarrier bar; { const Params p = KP(); bar.bar = PB(WS_CTL, unsigned) + CW_BAR + a.li * XCD_BAR_WORDS; bar.x = 0; bar.st = nullptr;
    if (a.s_hi - a.s_lo > 1) bar = xcd_barrier_post(PB(WS_CTL, unsigned) + CW_BAR + a.li * XCD_BAR_WORDS, MISC + 8); }
#ifndef PROBE_REPEAT
#define PROBE_REPEAT 0
#endif
#define REP(bit) for (int rep_ = 0; rep_ < 1 + ((PROBE_REPEAT >> (bit)) & 1); ++rep_)
#define IN(s) (a.s_lo <= (s) && (s) < a.s_hi)
#define SEAM(s) do { if (IN(s) && IN((s) + 1)) xcd_barrier(bar); } while (0)
#define WB PB(WS_WEI, bf16_t)
#define MOD PB(WS_MOD, float)
    if (IN(0)) REP(14) { PH_BEGIN
        p0_weights(p, (LAS float*)(lds + wave * 16640), gw, ngw, lane);
        __syncthreads();
        ph_mod(p, (LAS float*)lds, blk_, G, tid_);
        ph_tables(p, gt, ngt);
        p0_gbias(p, gt, ngt);
    }
    SEAM(0);
    for (int l = 0; l < L_; ++l) {
        const int sb = 1 + l * NPL;
        if (IN(sb + SS_NORM1)) { PH_BEGIN ph_zero_pads(p, gt, ngt); ph_norm(p, l, 1, gw, ngw, lane); }
        SEAM(sb + SS_NORM1);
        if (IN(sb + SS_WIN)) REP(SS_WIN) { PH_BEGIN
            pg8::GemmCfg g{1024, 1024, 1024, 256u}; pg8::StdOrder S; S.init(64, 19, G, blk_, PB(A_XN, bf16_t), WB + WE_WIN + (size_t)l * 4864 * 1024, 1024, 1024);
            EpiWin E{p}; pg8::gemm_phase<EpiWin, pg8::StdOrder, true, false>(lds, g, S, E, tid_);
        }
        SEAM(sb + SS_WIN);
        if (IN(sb + SS_QG)) REP(SS_QG) { PH_BEGIN
            pg8::GemmCfg g{512, 256, 256, 256u}; pg8::StdOrder S; S.init(64, 4, G, blk_, PB(A_CQKV, bf16_t), WB + WE_WUQ + (size_t)l * 1024 * 256, 512, 256);
            EpiBf E{PB(A_QR, bf16_t), 1024}; pg8::gemm_phase<EpiBf, pg8::StdOrder, true, false>(lds, g, S, E, tid_);
        }
        if (IN(sb + SS_KVG)) REP(SS_KVG) { PH_BEGIN
            pg8::GemmCfg g{512, 256, 256, 256u}; pg8::StdOrder S; S.init(64, 4, G, blk_, PB(A_CQKV, bf16_t) + 256, WB + WE_WUKV + (size_t)l * 1024 * 256, 512, 256);
            EpiBf E{PB(A_KVR, bf16_t), 1024}; pg8::gemm_phase<EpiBf, pg8::StdOrder, true, false>(lds, g, S, E, tid_);
        }
        if (IN(sb + SS_GATES)) REP(SS_GATES) { PH_BEGIN
            pg8::GemmCfg g{1024, 512, 512, 2048u}; GatesOrder S; S.init(G, blk_, PB(A_UP, bf16_t), WB + WE_WG + (size_t)l * 4096 * 512);
            EpiGates E{p, l}; pg8::gemm_phase<EpiGates, GatesOrder, true, false>(lds, g, S, E, tid_);
        }
        SEAM(sb + SS_GATES);
        if (IN(sb + SS_PREP2)) { PH_BEGIN REP(SS_PREP2) ph_prep2(p, l, gw, ngw, lane); }
        SEAM(sb + SS_PREP2);
        if (IN(sb + SS_ATTN)) { PH_BEGIN
            if (a.pad & 1) REP(SS_ATTN) ph_attn(p, lds, blk_, G, tid_);
            REP(16) ph_scan(p, lds, blk_, G, tid_); }
        SEAM(sb + SS_ATTN);
        if (IN(sb + SS_Z1)) REP(SS_Z1) { PH_BEGIN
            pg8::GemmCfg g{1024, 1024, 1024, 256u}; pg8::StdOrder S; S.init(64, 4, G, blk_, PB(A_HL, bf16_t), WB + WE_WOL + (size_t)l * 1024 * 1024, 1024, 1024);
            EpiZ1 E{p}; pg8::gemm_phase<EpiZ1, pg8::StdOrder, true, false>(lds, g, S, E, tid_);
        }
        if (IN(sb + SS_Z)) REP(SS_Z) { PH_BEGIN
            pg8::GemmCfg g{512, 512, 512, 256u}; pg8::StdOrder S; S.init(64, 4, G, blk_, PB(A_O, bf16_t), WB + WE_WOM + (size_t)l * 1024 * 512, 512, 512);
            EpiZ E{p}; pg8::gemm_phase<EpiZ, pg8::StdOrder, true, false>(lds, g, S, E, tid_);
        }
        SEAM(sb + SS_Z);
        if (IN(sb + SS_RES)) { PH_BEGIN
            pg8::GemmCfg g{1024, 1024, 1024, 256u}; pg8::StdOrder S; S.init(64, 4, G, blk_, PB(A_Z, bf16_t), WB + WE_WOUT + (size_t)l * 1024 * 1024, 1024, 1024);
            EpiRes E{l == 0 ? p.in[0] : p.out, p.out, MOD + (size_t)l * 8 * 6144 + 2048}; pg8::gemm_phase<EpiRes, pg8::StdOrder, true, false>(lds, g, S, E, tid_);
        }
        SEAM(sb + SS_RES);
        if (IN(sb + SS_NORM2)) { PH_BEGIN ph_norm(p, l, 2, gw, ngw, lane); }
        SEAM(sb + SS_NORM2);
        if (IN(sb + SS_UP)) { PH_BEGIN
            if (!(l & 1)) REP(SS_UP) {
                pg8::GemmCfg g{1024, 1024, 1024, 256u}; pg8::StdOrder S; S.init(64, 22, G, blk_, PB(A_XN, bf16_t), WB + WE_FGU + (size_t)(l >> 1) * 5632 * 1024, 1024, 1024);
                EpiUp E{PB(A_HID, bf16_t)}; pg8::gemm_phase<EpiUp, pg8::StdOrder, true, false>(lds, g, S, E, tid_);
            } else REP(15) {
                volatile LAS unsigned* meta = MISC + 16; moe_meta_fill(p, l, meta, tid_);
                MoeOrder S; S.meta = meta; S.tok = (LAS unsigned*)(lds + LDS_TOK); S.G = G; S.c = blk_; S.npn = 22; S.nwg = (int)meta[16] * 22; S.A0 = (const char*)PB(A_XN, bf16_t); S.atile = 0;
                S.B0 = (const char*)(WB + WE_MGU + (size_t)(l >> 1) * 8 * 5632 * 1024); S.bexp = (size_t)5632 * 1024 * 2; S.btile = (size_t)256 * 1024 * 2;
                S.fill_tok(p, tid_);
                pg8::GemmCfg g{1024, 1024, 1024, 256u}; EpiUp E{PB(A_HID, bf16_t)}; pg8::gemm_phase<EpiUp, MoeOrder, true, true>(lds, g, S, E, tid_);
            }
        }
        SEAM(sb + SS_UP);
        if (IN(sb + SS_DOWN)) { PH_BEGIN
            if (!(l & 1)) {
                pg8::GemmCfg g{FF, FF, FF, 256u}; pg8::StdOrder S; S.init(64, 4, G, blk_, PB(A_HID, bf16_t), WB + WE_FD + (size_t)(l >> 1) * 1024 * 2816, FF, FF);
                EpiRes E{p.out, p.out, MOD + (size_t)l * 8 * 6144 + 5120}; pg8::gemm_phase<EpiRes, pg8::StdOrder, true, false>(lds, g, S, E, tid_);
            } else {
                volatile LAS unsigned* meta = MISC + 16; moe_meta_fill(p, l, meta, tid_);
                MoeOrder S; S.meta = meta; S.tok = (LAS unsigned*)(lds + LDS_TOK); S.G = G; S.c = blk_; S.npn = 4; S.nwg = (int)meta[16] * 4; S.A0 = (const char*)PB(A_HID, bf16_t); S.atile = (size_t)256 * FF * 2;
                S.B0 = (const char*)(WB + WE_MD + (size_t)(l >> 1) * 8 * 1024 * 2816); S.bexp = (size_t)1024 * 2816 * 2; S.btile = (size_t)256 * 2816 * 2;
                pg8::GemmCfg g{FF, FF, FF, 256u}; EpiMoeDown E{p, l}; pg8::gemm_phase<EpiMoeDown, MoeOrder, true, false>(lds, g, S, E, tid_);
            }
        }
        SEAM(sb + SS_DOWN);
    }
    if (IN(ST_FINAL)) { PH_BEGIN ph_final(p, gt, ngt); }
#undef IN
#undef SEAM
#undef WB
#undef MOD
}

#ifndef ONE_LAUNCH
#define ONE_LAUNCH 1
#endif
extern "C" void kernel_launch(void* const* d_in, const int* in_sizes, int n_in, void* d_out, int out_size, void* d_ws, size_t ws_size, hipStream_t stream) {
    if (n_in != 29 || out_size != T_ * D_ || ws_size < WS_END) { fprintf(stderr, "kernel_launch: bad shapes n_in %d out %d ws %zu (need %zu)\n", n_in, out_size, ws_size, (size_t)WS_END); return; }
    Params p{};
    for (int i = 0; i < 29; ++i) p.in[i] = (const float*)d_in[i];
    p.out = (float*)d_out; p.ws = (unsigned char*)d_ws;
    static int grid = 0;
    if (!grid) {
        (void)hipFuncSetAttribute((const void*)mk_fwd, hipFuncAttributeMaxDynamicSharedMemorySize, LDS_BYTES);
        int dev = 0, cus = 0, per_cu = 0; (void)hipGetDevice(&dev); (void)hipDeviceGetAttribute(&cus, hipDeviceAttributeMultiprocessorCount, dev);
        (void)hipOccupancyMaxActiveBlocksPerMultiprocessor(&per_cu, (const void*)mk_fwd, 512, LDS_BYTES);
        grid = cus > 0 ? cus : 256; if (per_cu < 1) fprintf(stderr, "kernel_launch: occupancy query says %d blocks per CU\n", per_cu);
        (void)hipGetLastError();
    }
    (void)hipMemsetAsync((char*)d_ws + WS_CTL, 0, CTL_BYTES, stream);
    if (ONE_LAUNCH) { Args a{}; a.p = p; a.s_lo = 0; a.s_hi = NSTEPS; a.li = 0; a.pad = 1; hipLaunchKernelGGL(mk_fwd, dim3(grid), dim3(512), LDS_BYTES, stream, a); return; }
    for (int s = 0; s < NSTEPS; ++s) { Args a{}; a.p = p; a.s_lo = s; a.s_hi = s + 1; a.li = 0; a.pad = 1; hipLaunchKernelGGL(mk_fwd, dim3(grid), dim3(512), LDS_BYTES, stream, a); }
}
```

```cpp
#include <hip/hip_runtime.h>
#include <cstdio>
#include <cstdint>

constexpr int B_ = 8, S_ = 2048, T_ = B_ * S_, D_ = 1024, L_ = 4, H_ = 8;
constexpr int QKD = 96, VD = 64, FF = 2816, NE = 8, INC = 4640;
constexpr int SP = S_ + 4;
constexpr float EPS = 1e-6f;
constexpr float QSCALE = 0.10206207261596577f * 1.4426950408889634f;

typedef unsigned short bf16_t;
typedef float f32x4 __attribute__((ext_vector_type(4)));
typedef unsigned u32x4 __attribute__((ext_vector_type(4)));
typedef unsigned u32x2 __attribute__((ext_vector_type(2)));

constexpr size_t MiB = 1u << 20;
constexpr size_t WS_CTL = 0, CTL_BYTES = 64 * 1024;
constexpr size_t WS_MOD = 1 * MiB;
constexpr size_t WS_COS = 2 * MiB, WS_SIN = 3 * MiB;
constexpr size_t WS_GB = 4 * MiB;
constexpr size_t WS_LIST = 5 * MiB;
constexpr size_t WS_TW = 6 * MiB;
constexpr size_t WS_SSP = 7 * MiB;
constexpr size_t WS_KRSS = 7 * MiB + 512 * 1024;
constexpr size_t WS_AGG = 8 * MiB;
constexpr size_t WS_WEI = 16 * MiB;
constexpr size_t WS_AR = 392 * MiB;
constexpr size_t A_XN = WS_AR + 0 * MiB;
constexpr size_t A_CQKV = WS_AR + 32 * MiB;
constexpr size_t A_KR = WS_AR + 48 * MiB;
constexpr size_t A_KPE = WS_AR + 50 * MiB;
constexpr size_t A_UP = WS_AR + 52 * MiB;
constexpr size_t A_YG = WS_AR + 86 * MiB;
constexpr size_t A_G = WS_AR + 118 * MiB;
constexpr size_t A_CQN = WS_AR + 182 * MiB;
constexpr size_t A_QR = WS_AR + 198 * MiB;
constexpr size_t A_KVR = WS_AR + 230 * MiB;
constexpr size_t A_LAB = WS_AR + 262 * MiB;
constexpr size_t A_LR = A_LAB + 64 * MiB;
constexpr size_t A_UC = WS_AR + 0 * MiB;
constexpr size_t A_Q = WS_AR + 198 * MiB;
constexpr size_t A_K = WS_AR + 222 * MiB;
constexpr size_t A_V = WS_AR + 246 * MiB;
constexpr size_t A_HLO = WS_AR + 150 * MiB;
constexpr int LDHLO = 1536;
constexpr size_t A_Z = WS_AR + 326 * MiB;
constexpr size_t A_HID = WS_AR + 32 * MiB;
constexpr size_t A_HIDD = WS_AR + 390 * MiB;
constexpr size_t A_YP = A_HIDD;
constexpr size_t A_Y0 = WS_AR + 262 * MiB;
constexpr size_t A_Y1 = WS_AR + 294 * MiB;
constexpr size_t A_X = WS_AR + 358 * MiB;
constexpr size_t WS_END = WS_AR + 478 * MiB;
constexpr int CW_CNT = 8192;
constexpr int CW_LBAR = 10240;
constexpr int CW_BAR = 4096;

struct Params { const float* in[29]; float* out; unsigned char* ws; };

#define PB(off, type) ((type*)(p.ws + (off)))

__device__ __forceinline__ float bf2f(bf16_t v) { return __uint_as_float(((unsigned)v) << 16); }
__device__ __forceinline__ bf16_t f2bf(float f) { unsigned u = __float_as_uint(f); u += 0x7fffu + ((u >> 16) & 1u); return (bf16_t)(u >> 16); }
__device__ __forceinline__ unsigned pk2(float lo, float hi) { return (unsigned)f2bf(lo) | ((unsigned)f2bf(hi) << 16); }
__device__ __forceinline__ unsigned cvt_pk_bf16(float lo, float hi) { unsigned r; asm volatile("v_cvt_pk_bf16_f32 %0, %1, %2" : "=v"(r) : "v"(lo), "v"(hi)); return r; }
__device__ __forceinline__ u32x4 pack8(f32x4 a, f32x4 b) { u32x4 w; w.x = cvt_pk_bf16(a.x, a.y); w.y = cvt_pk_bf16(a.z, a.w); w.z = cvt_pk_bf16(b.x, b.y); w.w = cvt_pk_bf16(b.z, b.w); return w; }
__device__ __forceinline__ f32x4 bf4hi(u32x4 w) { return (f32x4){__uint_as_float(w.z << 16), __uint_as_float(w.z & 0xffff0000u), __uint_as_float(w.w << 16), __uint_as_float(w.w & 0xffff0000u)}; }
__device__ __forceinline__ f32x4 bf4lo(u32x4 w) { return (f32x4){__uint_as_float(w.x << 16), __uint_as_float(w.x & 0xffff0000u), __uint_as_float(w.y << 16), __uint_as_float(w.y & 0xffff0000u)}; }
__device__ __forceinline__ float sigmoidf_(float x) { return __builtin_amdgcn_rcpf(1.0f + __builtin_amdgcn_exp2f(-1.4426950408889634f * x)); }
__device__ __forceinline__ float siluf_(float x) { return x * sigmoidf_(x); }
__device__ __forceinline__ float gelu_tanh(float x) { const float u = 0.7978845608028654f * (x + 0.044715f * x * x * x); return x * sigmoidf_(2.0f * u); }
__device__ __forceinline__ float softplusf_(float x) { return fmaxf(x, 0.f) + log1pf(__expf(-fabsf(x))); }
#define SHX(v, o, lane) __int_as_float(__builtin_amdgcn_ds_bpermute((int)((((lane) ^ (o)) & 63) << 2), __float_as_int(v)))
#define SHIDX(v, idx) __builtin_amdgcn_ds_bpermute((int)((idx) << 2), (int)(v))
__device__ __forceinline__ float wave_sum_unused(float v) {
#pragma unroll
    for (int o = 1; o < 64; o <<= 1) v += __shfl_xor(v, o);
    return v;
}

#define LAS __attribute__((address_space(3)))
__device__ __forceinline__ void ph_mod(const Params& p, LAS float* lds, int blk, int nblk, int tid) {
    const int lane = tid & 63, w = tid >> 6;
    const float* c = p.in[1]; const float* aw = p.in[3]; const float* ab = p.in[4];
    float* mod = PB(WS_MOD, float);
    for (int i = tid; i < B_ * D_; i += 512) lds[i] = siluf_(c[i]);
    __syncthreads();
    LAS float* red = lds + B_ * D_;
    for (int item = blk; item < L_ * 96; item += nblk) {
        const int l = item / 96, n0 = (item % 96) * 64;
        float acc[8];
#pragma unroll
        for (int b = 0; b < 8; ++b) acc[b] = 0.f;
        const float* wp = aw + ((size_t)l * D_ + w * 128) * 6144 + n0 + lane;
#pragma unroll 1
        for (int k0 = 0; k0 < 128; k0 += 64) {
            float wv[64];
#pragma unroll
            for (int k = 0; k < 64; ++k) wv[k] = wp[(size_t)(k0 + k) * 6144];
#pragma unroll
            for (int k = 0; k < 64; ++k)
#pragma unroll
                for (int b = 0; b < 8; ++b) acc[b] += lds[b * D_ + w * 128 + k0 + k] * wv[k];
        }
#pragma unroll
        for (int b = 0; b < 8; ++b) red[(w * 8 + b) * 64 + lane] = acc[b];
        __syncthreads();
        {
            const int b = tid >> 6, n = tid & 63; float s = 0.f;
#pragma unroll
            for (int ww = 0; ww < 8; ++ww) s += red[(ww * 8 + b) * 64 + n];
            mod[((size_t)l * 8 + b) * 6144 + n0 + n] = s + ab[l * 6144 + n0 + n];
        }
        __syncthreads();
    }
}
__device__ __forceinline__ void ph_tables(const Params& p, int gt, int ngt) {
    const int* pos = (const int*)p.in[2];
    float* cs = PB(WS_COS, float); float* sn = PB(WS_SIN, float);
    for (int i = gt; i < T_ * 16; i += ngt) {
        const int t = i >> 4, j = i & 15;
        const float inv = 1.0f / powf(10000.0f, (float)(2 * j) / 32.0f);
        const float ang = (float)pos[t] * inv;
        float sv, cv; sincosf(ang, &sv, &cv); cs[i] = cv; sn[i] = sv;
    }
}
__device__ __forceinline__ void ph_zero_pads(const Params& p, int b0, int nb, int gt, int ngt) {
    bf16_t* up = PB(A_UP, bf16_t);
    for (int i = gt; i < nb * 4 * D_; i += ngt) {
        const int b = b0 + i / (4 * D_), r = (i / D_) & 3, c = i & (D_ - 1);
        const int row = (r < 2) ? r : (S_ + r);
        up[((size_t)b * SP + row) * D_ + c] = 0;
    }
}
__device__ __forceinline__ float wave_sum(float x) {
    x += __int_as_float(__builtin_amdgcn_update_dpp(0, __float_as_int(x), 0xB1, 0xF, 0xF, true));
    x += __int_as_float(__builtin_amdgcn_update_dpp(0, __float_as_int(x), 0x4E, 0xF, 0xF, true));
    x += __int_as_float(__builtin_amdgcn_update_dpp(0, __float_as_int(x), 0x141, 0xF, 0xF, true));
    x += __int_as_float(__builtin_amdgcn_update_dpp(0, __float_as_int(x), 0x140, 0xF, 0xF, true));
    { auto r = __builtin_amdgcn_permlane16_swap(__float_as_uint(x), __float_as_uint(x), false, false); x = __uint_as_float(r[0]) + __uint_as_float(r[1]); }
    { auto r = __builtin_amdgcn_permlane32_swap(__float_as_uint(x), __float_as_uint(x), false, false); x = __uint_as_float(r[0]) + __uint_as_float(r[1]); }
    return x;
}
__device__ __forceinline__ void ph_norm(const Params& p, int l, int sub, int row0, int nrows, int gw, int ngw, int lane, const LAS float* wlds = nullptr  ) {
    constexpr int RB = 4;
    const bool xf32 = (l == 0 && sub == 1); const float* __restrict__ xin = p.in[0]; bf16_t* __restrict__ X = PB(A_X, bf16_t);
    const bool combine = (sub == 1 && l > 0 && ((l - 1) & 1));
    const bool route = (sub == 2 && (l & 1));
    const float* __restrict__ g = p.in[sub == 1 ? 5 : 6] + l * D_;
    const float* __restrict__ mod = PB(WS_MOD, float);
    bf16_t* __restrict__ XN = PB(A_XN, bf16_t);
    const bf16_t* __restrict__ Y0 = PB(A_Y0, bf16_t); const bf16_t* __restrict__ Y1 = PB(A_Y1, bf16_t);
    unsigned* cnt = PB(WS_CTL, unsigned) + CW_CNT + (l >> 1) * 1024;
    int* list = PB(WS_LIST, int); float* tw = PB(WS_TW, float);
    const int step = ngw * RB, rend = row0 + nrows;
    int base = row0 + gw * RB; if (base >= rend) return;
    u32x4 raw[RB][2];
    if (!xf32) {
#pragma unroll
        for (int rr = 0; rr < RB; ++rr)
#pragma unroll
            for (int j = 0; j < 2; ++j) raw[rr][j] = *(const u32x4*)(X + (size_t)(base + rr) * D_ + 8 * lane + 512 * j);
    }
#pragma unroll 1
    for (;;) {
        const int b = base / S_;
        const float* mrow = mod + ((size_t)l * 8 + b) * 6144 + (sub == 1 ? 0 : 3072);
        f32x4 gs[4], sh[4];
#pragma unroll
        for (int q = 0; q < 4; ++q) { const int c0 = 8 * lane + 512 * (q >> 1) + 4 * (q & 1); const f32x4 gg = *(const f32x4*)(g + c0), sc = *(const f32x4*)(mrow + 1024 + c0); sh[q] = *(const f32x4*)(mrow + c0); gs[q] = gg * (sc + 1.0f); }
        f32x4 v[RB][4];
        if (xf32) {
#pragma unroll
            for (int rr = 0; rr < RB; ++rr)
#pragma unroll
                for (int q = 0; q < 4; ++q) v[rr][q] = *(const f32x4*)(xin + (size_t)(base + rr) * D_ + 8 * lane + 512 * (q >> 1) + 4 * (q & 1));
        } else {
#pragma unroll
            for (int rr = 0; rr < RB; ++rr)
#pragma unroll
                for (int j = 0; j < 2; ++j) { v[rr][2 * j] = bf4lo(raw[rr][j]); v[rr][2 * j + 1] = bf4hi(raw[rr][j]); }
        }
        const int nbase = base + step; const bool more = nbase < rend;
        if (more && !xf32) {
#pragma unroll
            for (int rr = 0; rr < RB; ++rr)
#pragma unroll
                for (int j = 0; j < 2; ++j) raw[rr][j] = *(const u32x4*)(X + (size_t)(nbase + rr) * D_ + 8 * lane + 512 * j);
        }
        if (combine) {
            const float* g2 = mod + ((size_t)(l - 1) * 8 + b) * 6144 + 5120;
#pragma unroll
            for (int rr = 0; rr < RB; ++rr)
#pragma unroll
                for (int j = 0; j < 2; ++j) {
                    const size_t o = (size_t)(base + rr) * D_ + 8 * lane + 512 * j;
                    const u32x4 ya = *(const u32x4*)(Y0 + o), yb = *(const u32x4*)(Y1 + o); const f32x4 ga = *(const f32x4*)(g2 + 8 * lane + 512 * j), gb = *(const f32x4*)(g2 + 8 * lane + 512 * j + 4);
                    v[rr][2 * j] = v[rr][2 * j] + ga * (bf4lo(ya) + bf4lo(yb)); v[rr][2 * j + 1] = v[rr][2 * j + 1] + gb * (bf4hi(ya) + bf4hi(yb));
                    *(u32x4*)(X + o) = pack8(v[rr][2 * j], v[rr][2 * j + 1]);
                }
        }
        float ss[RB];
#pragma unroll
        for (int rr = 0; rr < RB; ++rr) { ss[rr] = 0.f;
#pragma unroll
            for (int q = 0; q < 4; ++q) ss[rr] += (v[rr][q].x * v[rr][q].x + v[rr][q].y * v[rr][q].y) + (v[rr][q].z * v[rr][q].z + v[rr][q].w * v[rr][q].w); }
#pragma unroll
        for (int rr = 0; rr < RB; ++rr) ss[rr] = wave_sum(ss[rr]);
#pragma unroll
        for (int rr = 0; rr < RB; ++rr) {
            const float rstd = rsqrtf(ss[rr] * (1.0f / D_) + EPS);
#pragma unroll
            for (int q = 0; q < 4; ++q) v[rr][q] = v[rr][q] * rstd * gs[q] + sh[q];
#pragma unroll
            for (int j = 0; j < 2; ++j) *(u32x4*)(XN + (size_t)(base + rr) * D_ + 8 * lane + 512 * j) = pack8(v[rr][2 * j], v[rr][2 * j + 1]);
        }
        if (route) {
            float lg[RB][8];
#pragma unroll
            for (int rr = 0; rr < RB; ++rr)
#pragma unroll
                for (int e = 0; e < 8; ++e) lg[rr][e] = 0.f;
#pragma unroll
            for (int j = 0; j < 4; ++j)
#pragma unroll
                for (int i = 0; i < 4; ++i) {
                    const LAS f32x4* wp = (const LAS f32x4*)(wlds + ((j * 4 + i) * 64 + lane) * 8); const f32x4 w0 = wp[0], w1 = wp[1];
#pragma unroll
                    for (int rr = 0; rr < RB; ++rr) { const float hv = v[rr][j][i];
                        lg[rr][0] += hv * w0.x; lg[rr][1] += hv * w0.y; lg[rr][2] += hv * w0.z; lg[rr][3] += hv * w0.w;
                        lg[rr][4] += hv * w1.x; lg[rr][5] += hv * w1.y; lg[rr][6] += hv * w1.z; lg[rr][7] += hv * w1.w; }
                }
#pragma unroll
            for (int rr = 0; rr < RB; ++rr)
#pragma unroll
                for (int e = 0; e < 8; ++e) lg[rr][e] = wave_sum(lg[rr][e]);
            int ek[2 * RB]; float wk[2 * RB];
#pragma unroll
            for (int rr = 0; rr < RB; ++rr) {
                int i1 = 0; float v1 = lg[rr][0];
#pragma unroll
                for (int e = 1; e < 8; ++e) if (lg[rr][e] > v1) { v1 = lg[rr][e]; i1 = e; }
                int i2 = -1; float v2 = -3.0e38f;
#pragma unroll
                for (int e = 0; e < 8; ++e) if (e != i1 && lg[rr][e] > v2) { v2 = lg[rr][e]; i2 = e; }
                const float ex = __expf(v2 - v1), w1 = 1.0f / (1.0f + ex);
                ek[2 * rr] = i1; ek[2 * rr + 1] = i2; wk[2 * rr] = w1; wk[2 * rr + 1] = ex * w1;
            }
            unsigned nmine = 0;
#pragma unroll
            for (int k = 0; k < 2 * RB; ++k) nmine += (ek[k] == lane) ? 1u : 0u;
            unsigned bpos = 0;
            if (lane < NE && nmine) bpos = atomicAdd(cnt + 64 * lane, nmine);
            int myent = 0, mye = 0; unsigned mypos = 0; float myw = 0.f;
#pragma unroll
            for (int k = 0; k < 2 * RB; ++k) {
                unsigned rank = 0;
#pragma unroll
                for (int j = 0; j < k; ++j) rank += (ek[j] == ek[k]) ? 1u : 0u;
                const unsigned pos = (unsigned)SHIDX(bpos, ek[k]) + rank;
                if (lane == k) { myent = (base + (k >> 1)) * 2 + (k & 1); mye = ek[k]; mypos = pos; myw = wk[k]; }
            }
            if (lane < 2 * RB) { list[(size_t)mye * T_ + mypos] = myent; tw[myent] = myw; }
        }
        if (!more) break;
        base = nbase;
    }
}
__device__ __forceinline__ void ph_final(const Params& p, int gt, int ngt) {
    const float* __restrict__ mod = PB(WS_MOD, float); const bf16_t* __restrict__ Y0 = PB(A_Y0, bf16_t); const bf16_t* __restrict__ Y1 = PB(A_Y1, bf16_t); const bf16_t* __restrict__ X = PB(A_X, bf16_t);
    constexpr int U = 4, N8 = T_ * D_ / 8;
#pragma unroll 1
    for (int i0 = gt; i0 < N8; i0 += ngt * U) {
        u32x4 xw[U], ya[U], yb[U]; f32x4 g0[U], g1[U];
#pragma unroll
        for (int u = 0; u < U; ++u) { const int i = i0 + u * ngt; if (i < N8) { const int row = i >> 7, c0 = (i & 127) * 8, b = row / S_; const size_t o = (size_t)row * D_ + c0;
            const float* gp = mod + ((size_t)(L_ - 1) * 8 + b) * 6144 + 5120 + c0; g0[u] = *(const f32x4*)gp; g1[u] = *(const f32x4*)(gp + 4);
            xw[u] = *(const u32x4*)(X + o); ya[u] = *(const u32x4*)(Y0 + o); yb[u] = *(const u32x4*)(Y1 + o); } }
#pragma unroll
        for (int u = 0; u < U; ++u) { const int i = i0 + u * ngt; if (i < N8) { const size_t o = (size_t)i * 8;
            *(f32x4*)(p.out + o) = bf4lo(xw[u]) + g0[u] * (bf4lo(ya[u]) + bf4lo(yb[u])); *(f32x4*)(p.out + o + 4) = bf4hi(xw[u]) + g1[u] * (bf4hi(ya[u]) + bf4hi(yb[u])); } }
    }
}
__device__ __forceinline__ void ph_prep2(const Params& p, int l, int gw, int ngw, int lane) {
    constexpr int RB = 2;
    const bf16_t* __restrict__ QR = PB(A_QR, bf16_t); const bf16_t* __restrict__ KVR = PB(A_KVR, bf16_t); const float* __restrict__ KR = PB(A_KPE, float);
    const float* __restrict__ SSP = PB(WS_SSP, float);
    const float* __restrict__ cs = PB(WS_COS, float); const float* __restrict__ sn = PB(WS_SIN, float);
    bf16_t* __restrict__ Q = PB(A_Q, bf16_t); bf16_t* __restrict__ K = PB(A_K, bf16_t); bf16_t* __restrict__ V = PB(A_V, bf16_t);
    const int h = lane >> 3, sub = lane & 7, subq = sub < 6 ? sub : 0, subk = sub < 4 ? sub : 0, subp = (sub == 5) ? 1 : 0;
    float qg[16], kg[16];
#pragma unroll
    for (int i = 0; i < 16; ++i) { qg[i] = sub < 6 ? p.in[12][l * QKD + sub * 16 + i] : 0.f; kg[i] = sub < 6 ? p.in[13][l * QKD + sub * 16 + i] : 0.f; }
    for (int base = gw * RB; base < T_; base += ngw * RB) {
        u32x4 qa[RB][2], ka[RB][2], va[RB]; f32x4 kp[RB][4], cc[RB][4], sc[RB][4], sp[RB][2];
#pragma unroll
        for (int rr = 0; rr < RB; ++rr) { const size_t row = base + rr;
            qa[rr][0] = *(const u32x4*)(QR + row * 1024 + h * 128 + subq * 16); qa[rr][1] = *(const u32x4*)(QR + row * 1024 + h * 128 + subq * 16 + 8);
            ka[rr][0] = *(const u32x4*)(KVR + row * 1024 + h * 128 + subk * 16); ka[rr][1] = *(const u32x4*)(KVR + row * 1024 + h * 128 + subk * 16 + 8);
            va[rr] = *(const u32x4*)(KVR + row * 1024 + h * 128 + 64 + sub * 8);
            sp[rr][0] = *(const f32x4*)(SSP + row * 8); sp[rr][1] = *(const f32x4*)(SSP + row * 8 + 4);
#pragma unroll
            for (int i = 0; i < 4; ++i) { kp[rr][i] = *(const f32x4*)(KR + row * 32 + subp * 16 + 4 * i); cc[rr][i] = *(const f32x4*)(cs + row * 16 + 4 * i); sc[rr][i] = *(const f32x4*)(sn + row * 16 + 4 * i); } }
#pragma unroll
        for (int rr = 0; rr < RB; ++rr) { const int row = base + rr, b = row / S_, s = row % S_;
            const float rq = rsqrtf(((sp[rr][0].x + sp[rr][0].y) + (sp[rr][0].z + sp[rr][0].w)) * (1.0f / 256.0f) + EPS);
            const float rk = rsqrtf(((sp[rr][1].x + sp[rr][1].y) + (sp[rr][1].z + sp[rr][1].w)) * (1.0f / 256.0f) + EPS);
            float c16[16], s16[16], v[16];
#pragma unroll
            for (int i = 0; i < 4; ++i) { c16[4 * i] = cc[rr][i].x; c16[4 * i + 1] = cc[rr][i].y; c16[4 * i + 2] = cc[rr][i].z; c16[4 * i + 3] = cc[rr][i].w;
                s16[4 * i] = sc[rr][i].x; s16[4 * i + 1] = sc[rr][i].y; s16[4 * i + 2] = sc[rr][i].z; s16[4 * i + 3] = sc[rr][i].w; }
#pragma unroll
            for (int i = 0; i < 4; ++i) { v[2 * i] = __uint_as_float(qa[rr][0][i] << 16); v[2 * i + 1] = __uint_as_float(qa[rr][0][i] & 0xffff0000u); v[8 + 2 * i] = __uint_as_float(qa[rr][1][i] << 16); v[9 + 2 * i] = __uint_as_float(qa[rr][1][i] & 0xffff0000u); }
            {
                float o[16], ss = 0.f;
#pragma unroll
                for (int i = 0; i < 16; ++i) { const float x = (sub < 6) ? v[i] * rq : 0.f; const float pr = SHX(x, 1, lane);
                    o[i] = (sub == 4) ? (x * c16[i] - pr * s16[i]) : ((sub == 5) ? (pr * s16[i] + x * c16[i]) : x); ss += o[i] * o[i]; }
                ss += SHX(ss, 1, lane); ss += SHX(ss, 2, lane); ss += SHX(ss, 4, lane);
                const float rstd = rsqrtf(ss * (1.0f / QKD) + EPS) * QSCALE;
                if (sub < 6) {
                    u32x4 w0, w1;
#pragma unroll
                    for (int i = 0; i < 4; ++i) { w0[i] = pk2(o[2 * i] * rstd * qg[2 * i], o[2 * i + 1] * rstd * qg[2 * i + 1]); w1[i] = pk2(o[8 + 2 * i] * rstd * qg[8 + 2 * i], o[9 + 2 * i] * rstd * qg[9 + 2 * i]); }
                    bf16_t* dst = Q + (((size_t)b * H_ + h) * S_ + s) * QKD + sub * 16;
                    *(u32x4*)dst = w0; *(u32x4*)(dst + 8) = w1;
                }
            }
            {
                float kv[16], ss = 0.f;
#pragma unroll
                for (int i = 0; i < 4; ++i) { kv[2 * i] = __uint_as_float(ka[rr][0][i] << 16) * rk; kv[2 * i + 1] = __uint_as_float(ka[rr][0][i] & 0xffff0000u) * rk; kv[8 + 2 * i] = __uint_as_float(ka[rr][1][i] << 16) * rk; kv[9 + 2 * i] = __uint_as_float(ka[rr][1][i] & 0xffff0000u) * rk; }
                if (sub >= 4) {
#pragma unroll
                    for (int i = 0; i < 4; ++i) { kv[4 * i] = kp[rr][i].x; kv[4 * i + 1] = kp[rr][i].y; kv[4 * i + 2] = kp[rr][i].z; kv[4 * i + 3] = kp[rr][i].w; }
                }
#pragma unroll
                for (int i = 0; i < 16; ++i) { kv[i] = (sub < 6) ? kv[i] : 0.f; ss += kv[i] * kv[i]; }
                ss += SHX(ss, 1, lane); ss += SHX(ss, 2, lane); ss += SHX(ss, 4, lane);
                const float rstd = rsqrtf(ss * (1.0f / QKD) + EPS);
                if (sub < 6) {
                    u32x4 w0, w1;
#pragma unroll
                    for (int i = 0; i < 4; ++i) { w0[i] = pk2(kv[2 * i] * rstd * kg[2 * i], kv[2 * i + 1] * rstd * kg[2 * i + 1]); w1[i] = pk2(kv[8 + 2 * i] * rstd * kg[8 + 2 * i], kv[9 + 2 * i] * rstd * kg[9 + 2 * i]); }
                    bf16_t* dst = K + (((size_t)b * H_ + h) * S_ + s) * QKD + sub * 16;
                    *(u32x4*)dst = w0; *(u32x4*)(dst + 8) = w1;
                }
            }
            { u32x4 w;
#pragma unroll
              for (int i = 0; i < 4; ++i) w[i] = pk2(__uint_as_float(va[rr][i] << 16) * rk, __uint_as_float(va[rr][i] & 0xffff0000u) * rk);
              *(u32x4*)(V + (((size_t)b * H_ + h) * S_ + s) * VD + sub * 8) = w; }
        }
    }
}
__device__ __forceinline__ void ph_conv(const Params& p, int l, int gt, int ngt) {
    const bf16_t* __restrict__ UP = PB(A_UP, bf16_t); bf16_t* __restrict__ UC = PB(A_UC, bf16_t);
    const int c0 = (gt & 127) * 8;
    f32x4 cw[4][2], cb[2];
#pragma unroll
    for (int tap = 0; tap < 4; ++tap) { cw[tap][0] = *(const f32x4*)(p.in[15] + ((size_t)l * 4 + tap) * D_ + c0); cw[tap][1] = *(const f32x4*)(p.in[15] + ((size_t)l * 4 + tap) * D_ + c0 + 4); }
    cb[0] = *(const f32x4*)(p.in[16] + (size_t)l * D_ + c0); cb[1] = *(const f32x4*)(p.in[16] + (size_t)l * D_ + c0 + 4);
#pragma unroll 2
    for (int idx = gt; idx < T_ * 128; idx += ngt) {
        const int row = idx >> 7, b = row >> 11, s = row & (S_ - 1);
        const bf16_t* ur = UP + ((size_t)b * SP + s) * D_ + c0;
        u32x4 w[4];
#pragma unroll
        for (int tap = 0; tap < 4; ++tap) w[tap] = *(const u32x4*)(ur + (size_t)tap * D_);
        f32x4 lo = cb[0], hi = cb[1];
#pragma unroll
        for (int tap = 0; tap < 4; ++tap) {
            lo = lo + (f32x4){__uint_as_float(w[tap].x << 16), __uint_as_float(w[tap].x & 0xffff0000u), __uint_as_float(w[tap].y << 16), __uint_as_float(w[tap].y & 0xffff0000u)} * cw[tap][0];
            hi = hi + (f32x4){__uint_as_float(w[tap].z << 16), __uint_as_float(w[tap].z & 0xffff0000u), __uint_as_float(w[tap].w << 16), __uint_as_float(w[tap].w & 0xffff0000u)} * cw[tap][1]; }
        u32x4 o; o.x = pk2(lo.x, lo.y); o.y = pk2(lo.z, lo.w); o.z = pk2(hi.x, hi.y); o.w = pk2(hi.z, hi.w);
        *(u32x4*)(UC + (size_t)row * D_ + c0) = o;
    }
}
__device__ __forceinline__ void conv_slab(const Params& p, int l, int pm, int nb, int tid) {
    const bf16_t* __restrict__ UP = PB(A_UP, bf16_t); bf16_t* __restrict__ UC = PB(A_UC, bf16_t);
    const int c0 = nb * 128 + (tid & 15) * 8, b = pm >> 3, s0 = (pm & 7) * 256;
    f32x4 cw[4][2], cb[2];
#pragma unroll
    for (int tap = 0; tap < 4; ++tap) { cw[tap][0] = *(const f32x4*)(p.in[15] + ((size_t)l * 4 + tap) * D_ + c0); cw[tap][1] = *(const f32x4*)(p.in[15] + ((size_t)l * 4 + tap) * D_ + c0 + 4); }
    cb[0] = *(const f32x4*)(p.in[16] + (size_t)l * D_ + c0); cb[1] = *(const f32x4*)(p.in[16] + (size_t)l * D_ + c0 + 4);
    u32x4 w[8][4];
#pragma unroll
    for (int k = 0; k < 8; ++k) {
        const bf16_t* ur = UP + ((size_t)b * SP + s0 + (tid >> 4) + 32 * k) * D_ + c0;
#pragma unroll
        for (int tap = 0; tap < 4; ++tap) w[k][tap] = *(const u32x4*)(ur + (size_t)tap * D_);
    }
#pragma unroll
    for (int k = 0; k < 8; ++k) {
        const int r = (tid >> 4) + 32 * k;
        f32x4 lo = cb[0], hi = cb[1];
#pragma unroll
        for (int tap = 0; tap < 4; ++tap) { lo = lo + bf4lo(w[k][tap]) * cw[tap][0]; hi = hi + bf4hi(w[k][tap]) * cw[tap][1]; }
        *(u32x4*)(UC + (size_t)(pm * 256 + r) * D_ + c0) = pack8(lo, hi);
    }
}
constexpr int SCH = 32, NCH = S_ / SCH;
__device__ __forceinline__ void ph_scan(const Params& p, int l, LAS unsigned char* lds, int i0, int iend, int istep, int tid) {
    const unsigned* __restrict__ LB = PB(A_LAB, unsigned); const unsigned short* __restrict__ LR = PB(A_LR, unsigned short); const float* __restrict__ SPT = PB(WS_GB, float) + L_ * 4096 + (size_t)l * 2 * D_; const bf16_t* __restrict__ YG = PB(A_YG, bf16_t); bf16_t* __restrict__ HL = PB(A_HLO, bf16_t);
    LAS f32x4* AG = (LAS f32x4*)lds;
    const int lane = tid & 63, wave = tid >> 6, c32 = lane & 31, seg = wave * 2 + (lane >> 5);
#pragma unroll 1
    for (int item = i0; item < iend; item += istep) {
        const int b = item >> 5, ch = (item & 31) * 32 + c32;
        const size_t r0 = (size_t)b * S_ + (size_t)seg * 128;
        const float spf = SPT[ch] * (1.0f / 255.0f), spb = SPT[D_ + ch] * (1.0f / 255.0f);
        f32x4 mine[4];
#pragma unroll 1
        for (int q = 0; q < 4; ++q) {
            unsigned wb[SCH]; unsigned wr[SCH];
#pragma unroll
            for (int t = 0; t < SCH; ++t) { wb[t] = LB[(r0 + q * SCH + t) * D_ + ch]; wr[t] = LR[(r0 + q * SCH + t) * D_ + ch]; }
            float Af = 0.f, Hf = 0.f, Ab = 0.f, Hb = 0.f, Pb = 1.f;
#pragma unroll
            for (int t = 0; t < SCH; ++t) {
                const float laf = (float)(wr[t] & 0xffu) * spf, lab = (float)(wr[t] >> 8) * spb;
                const float af = __expf(laf), ab = __expf(lab);
                float bfv = __uint_as_float(wb[t] << 16), bbv = __uint_as_float(wb[t] & 0xffff0000u);
                if (!(seg == 0 && q == 0 && t == 0)) bfv *= __builtin_amdgcn_sqrtf(fmaxf(1.0f - af * af, 0.f));
                if (!(seg == 15 && q == 3 && t == SCH - 1)) bbv *= __builtin_amdgcn_sqrtf(fmaxf(1.0f - ab * ab, 0.f));
                Hf = af * Hf + bfv; Af += laf;
                Hb += Pb * bbv; Pb *= ab; Ab += lab;
            }
            const f32x4 a = (f32x4){__expf(Af), Hf, __expf(Ab), Hb};
            if (q == 0) mine[0] = a; else if (q == 1) mine[1] = a; else if (q == 2) mine[2] = a; else mine[3] = a;
        }
        { f32x4 sg; sg.x = 1.f; sg.y = 0.f; sg.z = 1.f; sg.w = 0.f;
#pragma unroll
          for (int q = 0; q < 4; ++q) { sg.y = mine[q].x * sg.y + mine[q].y; sg.x *= mine[q].x; }
#pragma unroll
          for (int q = 3; q >= 0; --q) { sg.w = mine[q].z * sg.w + mine[q].w; sg.z *= mine[q].z; }
          AG[seg * 32 + c32] = sg; }
        __syncthreads();
        float hf = 0.f, hbin[4];
        { f32x4 sa[16];
#pragma unroll
          for (int s = 0; s < 16; ++s) sa[s] = AG[s * 32 + c32];
#pragma unroll
          for (int s = 0; s < 15; ++s) if (s < seg) hf = sa[s].x * hf + sa[s].y;
          float hb = 0.f;
#pragma unroll
          for (int s = 15; s >= 1; --s) if (s > seg) hb = sa[s].z * hb + sa[s].w;
          hbin[3] = hb; hb = mine[3].z * hb + mine[3].w; hbin[2] = hb; hb = mine[2].z * hb + mine[2].w; hbin[1] = hb; hb = mine[1].z * hb + mine[1].w; hbin[0] = hb; }
#pragma unroll 1
        for (int q = 0; q < 4; ++q) {
            unsigned wb[SCH]; unsigned wr[SCH]; float hfv[SCH]; bf16_t yg[SCH];
#pragma unroll
            for (int t = 0; t < SCH; ++t) { wb[t] = LB[(r0 + q * SCH + t) * D_ + ch]; wr[t] = LR[(r0 + q * SCH + t) * D_ + ch]; yg[t] = YG[(r0 + q * SCH + t) * D_ + ch]; }
#pragma unroll
            for (int t = 0; t < SCH; ++t) { const float af = __expf((float)(wr[t] & 0xffu) * spf); float bfv = __uint_as_float(wb[t] << 16);
                if (!(seg == 0 && q == 0 && t == 0)) bfv *= __builtin_amdgcn_sqrtf(fmaxf(1.0f - af * af, 0.f));
                hf = af * hf + bfv; hfv[t] = hf; }
            float hb = (q == 0) ? hbin[0] : (q == 1) ? hbin[1] : (q == 2) ? hbin[2] : hbin[3];
#pragma unroll
            for (int t = SCH - 1; t >= 0; --t) {
                const float ab = __expf((float)(wr[t] >> 8) * spb); float bbv = __uint_as_float(wb[t] & 0xffff0000u);
                if (!(seg == 15 && q == 3 && t == SCH - 1)) bbv *= __builtin_amdgcn_sqrtf(fmaxf(1.0f - ab * ab, 0.f));
                hb = ab * hb + bbv;
                HL[(r0 + q * SCH + t) * LDHLO + ch] = f2bf((hfv[t] + hb) * bf2f(yg[t]));
            }
        }
        __syncthreads();
    }
}

typedef short bf16x8 __attribute__((ext_vector_type(8)));
#define LDS_WAIT() asm volatile("s_waitcnt lgkmcnt(0)" ::: "memory")

constexpr size_t WE_WIN = 0;
constexpr size_t WE_WQKV = WE_WIN + (size_t)L_ * 4864 * 1024;
constexpr size_t WE_WG = WE_WQKV + (size_t)L_ * 2048 * 256;
constexpr size_t WE_WCAT = WE_WG + (size_t)L_ * 4096 * 512;
constexpr size_t WE_WOUT = WE_WCAT + (size_t)L_ * 1024 * 1536;
constexpr size_t WE_FGU = WE_WOUT + (size_t)L_ * 1024 * 1024;
constexpr size_t WE_FD = WE_FGU + (size_t)2 * 5632 * 1024;
constexpr size_t WE_MGU = WE_FD + (size_t)2 * 1024 * 2816;
constexpr size_t WE_MD = WE_MGU + (size_t)16 * 5632 * 1024;
constexpr size_t WE_END = WE_MD + (size_t)16 * 1024 * 2816;
static_assert(WS_WEI + WE_END * 2 <= WS_AR, "weights region");
static_assert(CW_BAR + 3456 <= CW_CNT && CW_CNT + 2048 <= CW_LBAR && (size_t)(CW_LBAR + 2048) * 4 <= CTL_BYTES, "control words inside the per-call memset");


namespace pg8 {
constexpr int BM = 256, BK = 64, HALF = 128, HTB = HALF * BK * 2, STAGE_BYTES = 8 * HTB, NXCD = 8, WGM = 8;
__host__ __device__ __forceinline__ int lds_byte(int r, int c) { const int st = (r >> 4) * 2 + (c >> 5), rr = r & 15, cc = c & 31, ob = rr * 64 + cc * 2; return st * 1024 + (ob ^ (((ob >> 9) & 1) << 5)); }
__host__ __device__ __forceinline__ void stage_rc(int b, int& R, int& C) { const int st = b / 1024, sb = b % 1024, swz = sb ^ (((sb >> 9) & 1) << 5); R = (st >> 1) * 16 + swz / 64; C = (st & 1) * 32 + (swz % 64) / 2; }
__host__ __device__ __forceinline__ int perm32(int rho) { const int n = rho >> 4, i = rho & 15; return 8 * (i >> 2) + 4 * n + (i & 3); }

struct Unit { int pm, pn; const char* A; const char* B; int aux; int nt; };
struct GemmCfg { int lda, ldb, K; unsigned apair; };

struct TileOrder {
    int nM, nN, nwg, G, c;
    __device__ __forceinline__ void init(int nM_, int nN_, int G_, int c_) { nM = nM_; nN = nN_; nwg = nM * nN; G = G_; c = c_; }
    __device__ __forceinline__ bool tile(int i, int& pm, int& pn) const {
        const long L = (long)i * G + c; if (L >= nwg) return false;
        int wgid = (int)L; { const int q = nwg / NXCD, r = nwg % NXCD, xcd = wgid % NXCD, off = wgid / NXCD; wgid = (xcd < r ? xcd * (q + 1) : r * (q + 1) + (xcd - r) * q) + off; }
        const int nig = WGM * nN, gid = wgid / nig, fm = gid * WGM, gsz = (nM - fm) < WGM ? (nM - fm) : WGM;
        pm = fm + ((wgid % nig) % gsz); pn = (wgid % nig) / gsz; return true;
    }
};
struct StdOrder {
    TileOrder T; const char* A0; const char* B0; unsigned astep, bstep; int nt;
    __device__ __forceinline__ void init(int nM, int nN, int G, int c, const void* A, const void* B, int lda, int ldb, int K) { T.init(nM, nN, G, c); nt = K / BK; A0 = (const char*)A; B0 = (const char*)B; astep = (unsigned)(BM * lda * 2); bstep = (unsigned)(BM * ldb * 2); }
    __device__ __forceinline__ bool next(int i, Unit& u) const { if (!T.tile(i, u.pm, u.pn)) return false; u.A = A0 + (size_t)u.pm * astep; u.B = B0 + (size_t)u.pn * bstep; u.aux = 0; u.nt = nt; return true; }
    __device__ __forceinline__ unsigned row_off(int, int) const { return 0u; }
};

#define PG8_SA(b, h) (((b) * 2 + (h)) * HTB)
#define PG8_SB(b, h) ((4 + (b) * 2 + (h)) * HTB)
#define PG8_GLDS(gp, lp) __builtin_amdgcn_global_load_lds((const unsigned*)(gp), (LAS unsigned*)(lp), 16, 0, 0)
#define PG8_STAGE_B(bufoff, gbase) do { _Pragma("unroll") for (int _i = 0; _i < 2; ++_i) PG8_GLDS((gbase) + voffB[_i], lds + (bufoff) + ldsw + _i * 8192); } while (0)
#define PG8_STAGE_A(bufoff, gbase, h, nx) do { _Pragma("unroll") for (int _i = 0; _i < 2; ++_i) PG8_GLDS((gbase) + ((GATHER && (nx)) ? vAn[h][_i] : vA[h][_i]), lds + (bufoff) + ldsw + _i * 8192); } while (0)
#define PG8_LDA(dst, b, h) do { _Pragma("unroll") for (int m = 0; m < 4; ++m) _Pragma("unroll") for (int k = 0; k < 2; ++k) dst[m][k] = *(const LAS bf16x8*)(lds + PG8_SA(b, h) + aoff + m * 2048 + k * 1024); } while (0)
#define PG8_LDB(dst, b, h) do { _Pragma("unroll") for (int n = 0; n < 2; ++n) _Pragma("unroll") for (int k = 0; k < 2; ++k) dst[n][k] = *(const LAS bf16x8*)(lds + PG8_SB(b, h) + boff + n * 2048 + k * 1024); } while (0)
#define PG8_MMA(ai, bj, At, Bt) do { __builtin_amdgcn_s_setprio(1); _Pragma("unroll") for (int m = 0; m < 4; ++m) _Pragma("unroll") for (int n = 0; n < 2; ++n) _Pragma("unroll") for (int k = 0; k < 2; ++k) \
        acc[ai][bj][m][n] = __builtin_amdgcn_mfma_f32_16x16x32_bf16(Bt[n][k], At[m][k], acc[ai][bj][m][n], 0, 0, 0); __builtin_amdgcn_s_setprio(0); } while (0)
#define PG8_WAIT_V(n) asm volatile("s_waitcnt vmcnt(" #n ")" ::: "memory")
#define PG8_WAIT_L(n) asm volatile("s_waitcnt lgkmcnt(" #n ")" ::: "memory")
#define PG8_BAR __builtin_amdgcn_s_barrier()
#define PG8_SCHED __builtin_amdgcn_sched_barrier(0)

template <class Epi, class Sched, bool ALIGN_EPI, bool GATHER>
__device__ __forceinline__ void gemm_phase(LAS unsigned char* lds, const GemmCfg g, const Sched& S, const Epi& E, int tid_in) {
    int tid = tid_in; asm volatile("" : "+v"(tid));
    const int wid = __builtin_amdgcn_readfirstlane(tid >> 6), lane = tid & 63, wr = wid >> 2, wc = wid & 3, fr = lane & 15, fq = lane >> 4;
    unsigned voffB[2], vA[2][2], vAn[2][2]; int Rr[2], Cc[2];
#pragma unroll
    for (int i = 0; i < 2; ++i) { int R, C; stage_rc(tid * 16 + i * 8192, R, C); Rr[i] = R; Cc[i] = C; const int Rb = Epi::PERM ? ((R & ~31) + perm32(R & 31)) : R;
        voffB[i] = (unsigned)(Rb * g.ldb + C) * 2u;
#pragma unroll
        for (int h = 0; h < 2; ++h) { vA[h][i] = (unsigned)((h * HALF + R) * g.lda + C) * 2u; vAn[h][i] = vA[h][i]; } }
    const unsigned hstepB = (unsigned)(HALF * g.ldb * 2);
    const unsigned apair = g.apair;
    const unsigned ldsw = (unsigned)wid * 1024u;
    const int aoff = lds_byte(wr * 64 + fr, fq * 8), boff = lds_byte(wc * 32 + fr, fq * 8);
    Unit cur, nxt; int ui = 0;
    if (!S.next(0, cur)) return;
    if constexpr (GATHER) {
#pragma unroll
        for (int i = 0; i < 2; ++i)
#pragma unroll
            for (int h = 0; h < 2; ++h) { vA[h][i] = S.row_off(0, h * HALF + Rr[i]) + (unsigned)Cc[i] * 2u; vAn[h][i] = vA[h][i]; }
    }
    f32x4 acc[2][2][4][2];
#pragma unroll
    for (int a = 0; a < 2; ++a)
#pragma unroll
        for (int b = 0; b < 2; ++b)
#pragma unroll
            for (int m = 0; m < 4; ++m)
#pragma unroll
                for (int n = 0; n < 2; ++n) acc[a][b][m][n] = (f32x4){0.f, 0.f, 0.f, 0.f};
    bf16x8 At[4][2], B0[2][2], B1[2][2];
    const char* cA = cur.A; const char* cB = cur.B;
    PG8_STAGE_B(PG8_SB(0, 0), cB); PG8_STAGE_B(PG8_SB(0, 1), cB + hstepB); PG8_STAGE_A(PG8_SA(0, 0), cA, 0, false); PG8_STAGE_A(PG8_SA(0, 1), cA, 1, false);
    if (wr == 1) PG8_BAR;
    PG8_WAIT_V(2); PG8_BAR;
    PG8_STAGE_B(PG8_SB(1, 0), cB + 128); PG8_STAGE_A(PG8_SA(1, 0), cA + 128, 0, false); PG8_STAGE_B(PG8_SB(1, 1), cB + hstepB + 128);
    PG8_WAIT_V(6); PG8_BAR;
#pragma unroll 1
    for (;;) {
        const bool has_next = S.next(ui + 1, nxt);
        if constexpr (GATHER) { if (has_next) {
#pragma unroll
            for (int i = 0; i < 2; ++i)
#pragma unroll
                for (int h = 0; h < 2; ++h) vAn[h][i] = S.row_off(ui + 1, h * HALF + Rr[i]) + (unsigned)Cc[i] * 2u; } }
        const char* nA = has_next ? nxt.A : cA; const char* nB = has_next ? nxt.B : cB;
        int nt = cur.nt; asm volatile("" : "+s"(nt));
#pragma unroll 1
        for (int t = 0; t < nt; t += 2) {
            const bool last = (t == nt - 2);
            const char* ab = cA + (size_t)(t >> 1) * apair;
            const char* a1 = ab + 128;
            const char* a2 = last ? nA : ab + apair; const char* b2 = last ? nB : cB + (size_t)(t + 2) * 128;
            const char* a3 = a2 + 128; const char* b3 = b2 + 128;
            PG8_LDB(B0, 0, 0); PG8_LDB(B1, 0, 1); PG8_SCHED; PG8_LDA(At, 0, 0); PG8_STAGE_A(PG8_SA(1, 1), a1, 1, false);
            PG8_WAIT_V(8); PG8_WAIT_L(0); PG8_BAR; PG8_MMA(0, 0, At, B0); PG8_MMA(0, 1, At, B1); PG8_BAR; PG8_SCHED;
            PG8_LDA(At, 0, 1); PG8_STAGE_B(PG8_SB(0, 0), b2); PG8_STAGE_B(PG8_SB(0, 1), b2 + hstepB); PG8_STAGE_A(PG8_SA(0, 0), a2, 0, last);
            PG8_WAIT_V(8); PG8_WAIT_L(0); PG8_BAR; PG8_MMA(1, 0, At, B0); PG8_MMA(1, 1, At, B1); PG8_BAR; PG8_SCHED;
            PG8_LDB(B0, 1, 0); PG8_LDB(B1, 1, 1); PG8_SCHED; PG8_LDA(At, 1, 0); PG8_STAGE_A(PG8_SA(0, 1), a2, 1, last);
            PG8_WAIT_V(8); PG8_WAIT_L(0); PG8_BAR; PG8_MMA(0, 0, At, B0); PG8_MMA(0, 1, At, B1); PG8_BAR; PG8_SCHED;
            PG8_LDA(At, 1, 1); PG8_STAGE_B(PG8_SB(1, 0), b3); PG8_STAGE_B(PG8_SB(1, 1), b3 + hstepB); PG8_STAGE_A(PG8_SA(1, 0), a3, 0, last);
            PG8_WAIT_V(8); PG8_WAIT_L(0); PG8_BAR; PG8_MMA(1, 0, At, B0); PG8_MMA(1, 1, At, B1); PG8_BAR; PG8_SCHED;
        }
        if constexpr (ALIGN_EPI) { if (wr == 0) PG8_BAR; }
        E(acc, cur, wr, wc, fr, fq);
        if (!has_next) break;
        if (!(cur.aux & (1 << 30)))
#pragma unroll
        for (int a = 0; a < 2; ++a)
#pragma unroll
            for (int b = 0; b < 2; ++b)
#pragma unroll
                for (int m = 0; m < 4; ++m)
#pragma unroll
                    for (int n = 0; n < 2; ++n) acc[a][b][m][n] = (f32x4){0.f, 0.f, 0.f, 0.f};
        cur = nxt; cA = nA; cB = nB; ++ui;
        if constexpr (GATHER) {
#pragma unroll
            for (int i = 0; i < 2; ++i)
#pragma unroll
                for (int h = 0; h < 2; ++h) vA[h][i] = vAn[h][i]; }
        if constexpr (ALIGN_EPI) { if (wr == 1) PG8_BAR; }
    }
    PG8_WAIT_V(0);
    if constexpr (!ALIGN_EPI) { if (wr == 0) PG8_BAR; }
    PG8_BAR;
}
}
using pg8::Unit;
typedef f32x4 AccT[2][2][4][2];

__device__ __forceinline__ f32x4 sig4(f32x4 v) { f32x4 o; o.x = sigmoidf_(v.x); o.y = sigmoidf_(v.y); o.z = sigmoidf_(v.z); o.w = sigmoidf_(v.w); return o; }
__device__ __forceinline__ f32x4 gelu4(f32x4 v) { f32x4 o; o.x = gelu_tanh(v.x); o.y = gelu_tanh(v.y); o.z = gelu_tanh(v.z); o.w = gelu_tanh(v.w); return o; }
__device__ __forceinline__ f32x4 unpack4(u32x2 w) { return (f32x4){__uint_as_float(w.x << 16), __uint_as_float(w.x & 0xffff0000u), __uint_as_float(w.y << 16), __uint_as_float(w.y & 0xffff0000u)}; }

struct EpiWin { static constexpr bool PERM = true; Params p;
    __device__ __forceinline__ void operator()(AccT& acc, const Unit& u, int wr, int wc, int fr, int fq) const {
        const int pn = u.pn, row0 = u.pm * 256 + wr * 64 + fr, cl = wc * 32 + fq * 8;
        if (pn == 18) {
            if (wc == 0) { float* KPE = PB(A_KPE, float); float* KRSS = PB(WS_KRSS, float); const float* cs = PB(WS_COS, float); const float* sn = PB(WS_SIN, float);
                const int lane = fq * 16 + fr, ci = (fq & 1) * 8;
#pragma unroll
                for (int ai = 0; ai < 2; ++ai)
#pragma unroll
                    for (int m = 0; m < 4; ++m) { const size_t row = row0 + ai * 128 + m * 16; const f32x4 a0 = acc[ai][0][m][0], a1 = acc[ai][0][m][1];
                        f32x4 p0, p1;
#pragma unroll
                        for (int j = 0; j < 4; ++j) { p0[j] = SHX(a0[j], 32, lane); p1[j] = SHX(a1[j], 32, lane); }
                        const f32x4 c0 = *(const f32x4*)(cs + row * 16 + ci), c1 = *(const f32x4*)(cs + row * 16 + ci + 4), s0 = *(const f32x4*)(sn + row * 16 + ci), s1 = *(const f32x4*)(sn + row * 16 + ci + 4);
                        f32x4 o0, o1;
                        if (fq < 2) { o0 = a0 * c0 - p0 * s0; o1 = a1 * c1 - p1 * s1; } else { o0 = p0 * s0 + a0 * c0; o1 = p1 * s1 + a1 * c1; }
                        float ssq = ((a0.x * a0.x + a0.y * a0.y) + (a0.z * a0.z + a0.w * a0.w)) + ((a1.x * a1.x + a1.y * a1.y) + (a1.z * a1.z + a1.w * a1.w));
                        ssq += SHX(ssq, 16, lane); ssq += SHX(ssq, 32, lane);
                        if (fq == 0) KRSS[row] = ssq;
                        *(f32x4*)(KPE + row * 32 + fq * 8) = o0; *(f32x4*)(KPE + row * 32 + fq * 8 + 4) = o1; } }
            return;
        }
        bf16_t* base; int ld, act = 0; bool rmap = false;
        if (pn < 2) { base = PB(A_CQKV, bf16_t) + pn * 256; ld = 512;
            float* SSP = PB(WS_SSP, float);
#pragma unroll
            for (int ai = 0; ai < 2; ++ai)
#pragma unroll
                for (int m = 0; m < 4; ++m) { float ssq = 0.f;
#pragma unroll
                    for (int bj = 0; bj < 2; ++bj)
#pragma unroll
                        for (int n = 0; n < 2; ++n) { const f32x4 x = acc[ai][bj][m][n]; ssq += (x.x * x.x + x.y * x.y) + (x.z * x.z + x.w * x.w); }
                    ssq += SHX(ssq, 16, fq * 16 + fr); ssq += SHX(ssq, 32, fq * 16 + fr);
                    if (fq == 0) SSP[(size_t)(row0 + ai * 128 + m * 16) * 8 + pn * 4 + wc] = ssq; } }
        else if (pn < 6) { base = PB(A_UP, bf16_t) + (pn - 2) * 256; ld = 1024; rmap = true; }
        else if (pn < 10) { base = PB(A_YG, bf16_t) + (pn - 6) * 256; ld = 1024; act = 1; }
        else { base = nullptr; ld = 2048; act = 2; }
#pragma unroll
        for (int ai = 0; ai < 2; ++ai)
#pragma unroll
            for (int m = 0; m < 4; ++m) { const int row = row0 + ai * 128 + m * 16; const size_t rr = rmap ? (size_t)(row + (row >> 11) * 4 + 2) : (size_t)row;
#pragma unroll
                for (int bj = 0; bj < 2; ++bj) { f32x4 v0 = acc[ai][bj][m][0], v1 = acc[ai][bj][m][1];
                    if (act == 2) { v0 = sig4(v0) * 255.0f + 0.5f; v1 = sig4(v1) * 255.0f + 0.5f;
#pragma unroll
                        for (int j = 0; j < 4; ++j) { v0[j] = fmaxf(v0[j], 1.0f); v1[j] = fmaxf(v1[j], 1.0f); }
                        u32x2 q; q.x = (unsigned)v0.x | ((unsigned)v0.y << 8) | ((unsigned)v0.z << 16) | ((unsigned)v0.w << 24); q.y = (unsigned)v1.x | ((unsigned)v1.y << 8) | ((unsigned)v1.z << 16) | ((unsigned)v1.w << 24);
                        *(u32x2*)(PB(A_G, unsigned char) + rr * 2048 + (pn - 10) * 256 + bj * 128 + cl) = q; continue; }
                    if (act == 1) { v0 = gelu4(v0); v1 = gelu4(v1); }
                    *(u32x4*)(base + rr * ld + bj * 128 + cl) = pack8(v0, v1); } }
    } };
struct EpiRes { static constexpr bool PERM = true; const float* xf32; bf16_t* X; const float* gate  ;
    __device__ __forceinline__ void operator()(AccT& acc, const Unit& u, int wr, int wc, int fr, int fq) const {
        const int row0 = u.pm * 256 + wr * 64 + fr, c0 = u.pn * 256 + wc * 32 + fq * 8; const float* gr = gate + (size_t)(u.pm >> 3) * 6144;
        f32x4 gv[2][2];
#pragma unroll
        for (int bj = 0; bj < 2; ++bj)
#pragma unroll
            for (int n = 0; n < 2; ++n) gv[bj][n] = *(const f32x4*)(gr + c0 + bj * 128 + n * 4);
#pragma unroll
        for (int ai = 0; ai < 2; ++ai)
#pragma unroll
            for (int m = 0; m < 4; ++m) { const size_t row = row0 + ai * 128 + m * 16;
#pragma unroll
                for (int bj = 0; bj < 2; ++bj) { const size_t o = row * D_ + c0 + bj * 128; f32x4 x0, x1;
                    if (xf32) { x0 = *(const f32x4*)(xf32 + o); x1 = *(const f32x4*)(xf32 + o + 4); }
                    else { const u32x4 w = *(const u32x4*)(X + o); x0 = unpack4((u32x2){w.x, w.y}); x1 = unpack4((u32x2){w.z, w.w}); }
                    *(u32x4*)(X + o) = pack8(x0 + gv[bj][0] * acc[ai][bj][m][0], x1 + gv[bj][1] * acc[ai][bj][m][1]); } }
    } };
struct EpiUp { static constexpr bool PERM = true; bf16_t* HID;
    __device__ __forceinline__ void operator()(AccT& acc, const Unit& u, int wr, int wc, int fr, int fq) const {
        const int row0 = u.pm * 256 + wr * 64 + fr, c0 = u.pn * 128 + wc * 32 + fq * 8;
#pragma unroll
        for (int ai = 0; ai < 2; ++ai)
#pragma unroll
            for (int m = 0; m < 4; ++m) { const size_t row = row0 + ai * 128 + m * 16; f32x4 h0, h1;
                { const f32x4 a = acc[ai][0][m][0], b = acc[ai][1][m][0]; h0 = (f32x4){siluf_(a.x) * b.x, siluf_(a.y) * b.y, siluf_(a.z) * b.z, siluf_(a.w) * b.w}; }
                { const f32x4 a = acc[ai][0][m][1], b = acc[ai][1][m][1]; h1 = (f32x4){siluf_(a.x) * b.x, siluf_(a.y) * b.y, siluf_(a.z) * b.z, siluf_(a.w) * b.w}; }
                *(u32x4*)(HID + row * FF + c0) = pack8(h0, h1); }
    } };
struct EpiGates { static constexpr bool PERM = false; Params p; int l;
    __device__ __forceinline__ void operator()(AccT& acc, const Unit& u, int wr, int wc, int fr, int fq) const {
        const int pn = u.pn, ch0 = (pn >> 1) * 128 + (pn & 1) * 64 + 16 * wc + 4 * fq;
        const float* GB = PB(WS_GB, float) + (size_t)l * 4096 + pn * 256 + 32 * wc + 4 * fq;
        const float* SPT = PB(WS_GB, float) + L_ * 4096 + (size_t)l * 2 * D_ + ch0;
        const bf16_t* UC = PB(A_UC, bf16_t); unsigned* LB = PB(A_LAB, unsigned); unsigned short* LR = PB(A_LR, unsigned short);
        const int rowb = u.pm * 256 + wr * 64 + fr;
        f32x4 bias[2][2];
#pragma unroll
        for (int dir = 0; dir < 2; ++dir) { bias[dir][0] = *(const f32x4*)(GB + 128 * dir); bias[dir][1] = *(const f32x4*)(GB + 128 * dir + 16); }
        u32x2 ur[2][4];
#pragma unroll
        for (int ai = 0; ai < 2; ++ai)
#pragma unroll
            for (int m = 0; m < 4; ++m) ur[ai][m] = *(const u32x2*)(UC + (size_t)(rowb + ai * 128 + m * 16) * D_ + ch0);
#pragma unroll
        for (int ai = 0; ai < 2; ++ai) {
#pragma unroll
            for (int m = 0; m < 4; ++m) { const int row = rowb + ai * 128 + m * 16;
                const f32x4 uc = unpack4(ur[ai][m]);
                float bv[2][4]; unsigned rq[2][4];
#pragma unroll
                for (int dir = 0; dir < 2; ++dir) { const f32x4 xr = acc[ai][dir][m][0] + bias[dir][0], xi = acc[ai][dir][m][1] + bias[dir][1];
#pragma unroll
                    for (int j = 0; j < 4; ++j) { const float r = __builtin_amdgcn_rcpf(1.0f + __builtin_amdgcn_exp2f(xr[j])), ig = __builtin_amdgcn_rcpf(1.0f + __builtin_amdgcn_exp2f(xi[j])); rq[dir][j] = (unsigned)(r * 255.0f + 0.5f); bv[dir][j] = ig * uc[j]; } }
                const size_t eo = (size_t)row * D_ + ch0;
                *(u32x4*)(LB + eo) = (u32x4){cvt_pk_bf16(bv[0][0], bv[1][0]), cvt_pk_bf16(bv[0][1], bv[1][1]), cvt_pk_bf16(bv[0][2], bv[1][2]), cvt_pk_bf16(bv[0][3], bv[1][3])};
                *(u32x2*)(LR + eo) = (u32x2){rq[0][0] | (rq[1][0] << 8) | (rq[0][1] << 16) | (rq[1][1] << 24), rq[0][2] | (rq[1][2] << 8) | (rq[0][3] << 16) | (rq[1][3] << 24)}; }
            asm volatile("" ::: "memory");
        }
    } };
struct QkvOrder {
    pg8::TileOrder T; const char* A0; const char* B0;
    __device__ __forceinline__ void init(int G, int c, const void* cqkv, const void* w) { T.init(64, 8, G, c); A0 = (const char*)cqkv; B0 = (const char*)w; }
    __device__ __forceinline__ bool next(int i, Unit& u) const { if (!T.tile(i, u.pm, u.pn)) return false;
        u.A = A0 + (size_t)u.pm * (256 * 512 * 2) + ((u.pn >> 2) ? 512 : 0); u.B = B0 + (size_t)u.pn * (256 * 256 * 2); u.aux = 0; u.nt = 4; return true; }
    __device__ __forceinline__ unsigned row_off(int, int) const { return 0u; }
};
struct EpiQkv { static constexpr bool PERM = true; bf16_t* QR; bf16_t* KVR;
    __device__ __forceinline__ void operator()(AccT& acc, const Unit& u, int wr, int wc, int fr, int fq) const {
        bf16_t* O = (u.pn >> 2) ? KVR : QR; const int row0 = u.pm * 256 + wr * 64 + fr, c0 = (u.pn & 3) * 256 + wc * 32 + fq * 8;
#pragma unroll
        for (int ai = 0; ai < 2; ++ai)
#pragma unroll
            for (int m = 0; m < 4; ++m) { bf16_t* rp = O + (size_t)(row0 + ai * 128 + m * 16) * 1024 + c0;
#pragma unroll
                for (int bj = 0; bj < 2; ++bj) *(u32x4*)(rp + bj * 128) = pack8(acc[ai][bj][m][0], acc[ai][bj][m][1]); }
    } };
struct EpiQkvF { static constexpr bool PERM = true; Params p; int l; LAS float* P;
    __device__ __forceinline__ void operator()(AccT& acc, const Unit& u, int wr, int wc, int fr, int fq) const {
        const int lane = fq * 16 + fr; const bool isq = u.pn < 4; const int h0 = (u.pn & 3) * 2, b = u.pm >> 3;
        const int rowb = u.pm * 256 + wr * 64 + fr, rloc = wr * 64 + fr;
        const float* SSP = PB(WS_SSP, float) + (isq ? 0 : 4);
#pragma unroll
        for (int ai = 0; ai < 2; ++ai)
#pragma unroll
            for (int m = 0; m < 4; ++m) { const f32x4 sp = *(const f32x4*)(SSP + (size_t)(rowb + ai * 128 + m * 16) * 8); const float rl = rsqrtf(((sp.x + sp.y) + (sp.z + sp.w)) * (1.0f / 256.0f) + EPS);
#pragma unroll
                for (int bj = 0; bj < 2; ++bj) { acc[ai][bj][m][0] = acc[ai][bj][m][0] * rl; acc[ai][bj][m][1] = acc[ai][bj][m][1] * rl; } }
        const bool contrib = isq ? (wc < 3) : (wc < 2);
#pragma unroll
        for (int ai = 0; ai < 2; ++ai)
#pragma unroll
            for (int m = 0; m < 4; ++m)
#pragma unroll
                for (int bj = 0; bj < 2; ++bj) { const f32x4 x0 = acc[ai][bj][m][0], x1 = acc[ai][bj][m][1];
                    float ssq = ((x0.x * x0.x + x0.y * x0.y) + (x0.z * x0.z + x0.w * x0.w)) + ((x1.x * x1.x + x1.y * x1.y) + (x1.z * x1.z + x1.w * x1.w));
                    ssq += SHX(ssq, 16, lane); ssq += SHX(ssq, 32, lane);
                    if (fq == 0) P[((ai * 128 + rloc + m * 16) * 2 + bj) * 4 + wc] = contrib ? ssq : 0.f; }
        asm volatile("s_waitcnt lgkmcnt(0)" ::: "memory"); __builtin_amdgcn_s_barrier(); asm volatile("" ::: "memory");
        if (isq && wc == 2) { const float* cs = PB(WS_COS, float); const float* sn = PB(WS_SIN, float); const int ci = (fq & 1) * 8;
#pragma unroll
            for (int ai = 0; ai < 2; ++ai)
#pragma unroll
                for (int m = 0; m < 4; ++m) { const size_t row = rowb + ai * 128 + m * 16;
                    const f32x4 c0 = *(const f32x4*)(cs + row * 16 + ci), c1 = *(const f32x4*)(cs + row * 16 + ci + 4), s0 = *(const f32x4*)(sn + row * 16 + ci), s1 = *(const f32x4*)(sn + row * 16 + ci + 4);
#pragma unroll
                    for (int bj = 0; bj < 2; ++bj) { const f32x4 a0 = acc[ai][bj][m][0], a1 = acc[ai][bj][m][1]; f32x4 p0, p1;
#pragma unroll
                        for (int j = 0; j < 4; ++j) { p0[j] = SHX(a0[j], 32, lane); p1[j] = SHX(a1[j], 32, lane); }
                        if (fq < 2) { acc[ai][bj][m][0] = a0 * c0 - p0 * s0; acc[ai][bj][m][1] = a1 * c1 - p1 * s1; } else { acc[ai][bj][m][0] = p0 * s0 + a0 * c0; acc[ai][bj][m][1] = p1 * s1 + a1 * c1; } } } }
        const float* hg = (isq ? p.in[12] : p.in[13]) + l * QKD;
        const int gd = (wc < 2 || isq) ? (32 * wc + 8 * fq) : (64 + 8 * fq);
        f32x4 g0 = (f32x4){0.f, 0.f, 0.f, 0.f}, g1 = g0;
        if (wc < 3) { g0 = *(const f32x4*)(hg + gd); g1 = *(const f32x4*)(hg + gd + 4); }
        const float* KRSS = PB(WS_KRSS, float); const float* KPE = PB(A_KPE, float);
        bf16_t* Q = PB(A_Q, bf16_t); bf16_t* K = PB(A_K, bf16_t); bf16_t* V = PB(A_V, bf16_t);
#pragma unroll
        for (int ai = 0; ai < 2; ++ai)
#pragma unroll
            for (int m = 0; m < 4; ++m) { const int row = rowb + ai * 128 + m * 16, sq = row & (S_ - 1);
                const float krs = isq ? 0.f : KRSS[row];
                f32x4 kp0 = (f32x4){0.f, 0.f, 0.f, 0.f}, kp1 = kp0;
                if (!isq && wc == 2) { kp0 = *(const f32x4*)(KPE + (size_t)row * 32 + fq * 8); kp1 = *(const f32x4*)(KPE + (size_t)row * 32 + fq * 8 + 4); }
#pragma unroll
                for (int bj = 0; bj < 2; ++bj) { const f32x4 pt = *(const LAS f32x4*)(P + ((ai * 128 + rloc + m * 16) * 2 + bj) * 4);
                    const float tot = ((pt.x + pt.y) + (pt.z + pt.w)) + krs; const float rstd = rsqrtf(tot * (1.0f / QKD) + EPS) * (isq ? QSCALE : 1.0f);
                    const size_t hs = ((size_t)(b * H_ + h0 + bj) * S_ + sq);
                    if (isq) { if (wc < 3) *(u32x4*)(Q + hs * QKD + gd) = pack8(acc[ai][bj][m][0] * rstd * g0, acc[ai][bj][m][1] * rstd * g1); }
                    else {
                        if (wc < 2) *(u32x4*)(K + hs * QKD + gd) = pack8(acc[ai][bj][m][0] * rstd * g0, acc[ai][bj][m][1] * rstd * g1);
                        else { if (wc == 2) *(u32x4*)(K + hs * QKD + gd) = pack8(kp0 * rstd * g0, kp1 * rstd * g1);
                               *(u32x4*)(V + hs * VD + 32 * (wc - 2) + 8 * fq) = pack8(acc[ai][bj][m][0], acc[ai][bj][m][1]); } } } }
    } };
struct ZcatOrder {
    pg8::TileOrder T; const char* A0; const char* B0;
    __device__ __forceinline__ void init(int G, int c, const void* hlo, const void* w) { T.init(64, 4, G, c); A0 = (const char*)hlo; B0 = (const char*)w; }
    __device__ __forceinline__ bool next(int i, Unit& u) const { if (!T.tile(i >> 1, u.pm, u.pn)) return false; const int seg = i & 1;
        u.A = A0 + (size_t)u.pm * (256 * LDHLO * 2) + seg * 2048; u.B = B0 + (size_t)u.pn * (256 * 1536 * 2) + seg * 2048; u.aux = seg ? 1 : ((1 << 30)); u.nt = seg ? 8 : 16; return true; }
    __device__ __forceinline__ unsigned row_off(int, int) const { return 0u; }
};
struct EpiZcat { static constexpr bool PERM = true; Params p;
    __device__ __forceinline__ void operator()(AccT& acc, const Unit& u, int wr, int wc, int fr, int fq) const {
        const int row0 = u.pm * 256 + wr * 64 + fr, c0 = u.pn * 256 + wc * 32 + fq * 8; const unsigned char* G = PB(A_G, unsigned char); bf16_t* Z = PB(A_Z, bf16_t);
        const bool fin = (u.aux & 1) != 0;
#pragma unroll
        for (int ai = 0; ai < 2; ++ai)
#pragma unroll
            for (int m = 0; m < 4; ++m) { const size_t row = row0 + ai * 128 + m * 16;
#pragma unroll
                for (int bj = 0; bj < 2; ++bj) { const int c = c0 + bj * 128; const u32x2 gmw = *(const u32x2*)(G + row * 2048 + 1024 + c);
                    const f32x4 gm0 = (f32x4){(float)(gmw.x & 0xffu), (float)((gmw.x >> 8) & 0xffu), (float)((gmw.x >> 16) & 0xffu), (float)(gmw.x >> 24)}, gm1 = (f32x4){(float)(gmw.y & 0xffu), (float)((gmw.y >> 8) & 0xffu), (float)((gmw.y >> 16) & 0xffu), (float)(gmw.y >> 24)};
                    if (fin) { *(u32x4*)(Z + row * D_ + c) = pack8(acc[ai][bj][m][0] * gm0 * (1.0f / 255.0f), acc[ai][bj][m][1] * gm1 * (1.0f / 255.0f)); }
                    else { const u32x2 glw = *(const u32x2*)(G + row * 2048 + c);
                        const f32x4 gl0 = (f32x4){(float)(glw.x & 0xffu), (float)((glw.x >> 8) & 0xffu), (float)((glw.x >> 16) & 0xffu), (float)(glw.x >> 24)}, gl1 = (f32x4){(float)(glw.y & 0xffu), (float)((glw.y >> 8) & 0xffu), (float)((glw.y >> 16) & 0xffu), (float)(glw.y >> 24)};
                        f32x4 r0, r1;
#pragma unroll
                        for (int j = 0; j < 4; ++j) { r0[j] = gl0[j] * __builtin_amdgcn_rcpf(fmaxf(gm0[j], 1.0f)); r1[j] = gl1[j] * __builtin_amdgcn_rcpf(fmaxf(gm1[j], 1.0f)); }
                        acc[ai][bj][m][0] = acc[ai][bj][m][0] * r0; acc[ai][bj][m][1] = acc[ai][bj][m][1] * r1; } } }
    } };
struct GatesOrder {
    pg8::TileOrder T; const char* UPb; const char* B0;
    int Gp, cp, Qn, pmb;
    __device__ __forceinline__ void init(int Gp_, int cp_, int Qn_, int pmb_, const void* uc, const void* wg) { Gp = Gp_; cp = cp_; Qn = Qn_; pmb = pmb_; UPb = (const char*)uc; B0 = (const char*)wg; }
    __device__ __forceinline__ bool next(int i, Unit& u) const { const int q = (i >> 1) * Gp + cp; if (q >= Qn) return false; u.pm = pmb + (q >> 3); u.pn = (q & 7) * 2 + (i & 1);
        u.A = UPb + ((size_t)u.pm * 256 * D_ + (u.pn >> 1) * 128) * 2; u.B = B0 + (size_t)u.pn * 256 * 128 * 2; u.aux = 0; u.nt = 2; return true; }
    __device__ __forceinline__ unsigned row_off(int, int) const { return 0u; }
};

__device__ __forceinline__ int moe_meta(const Params& p, int l, int lane) {
    const unsigned* cnt = PB(WS_CTL, unsigned) + CW_CNT + (l >> 1) * 1024;
    int mv = 0; unsigned tb = 0;
#pragma unroll
    for (int e = 0; e < NE; ++e) { const unsigned c = cnt[64 * e]; mv = (lane == e) ? (int)c : mv; mv = (lane == 8 + e) ? (int)tb : mv; tb += (c + 255u) >> 8; }
    mv = (lane == 16) ? (int)tb : mv;
    return mv;
}
__device__ __forceinline__ int xcd_remap(int L, int nwg) { const int q = nwg / 8, r = nwg % 8, xcd = L % 8, off = L / 8; return (xcd < r ? xcd * (q + 1) : r * (q + 1) + (xcd - r) * q) + off; }
struct MoeOrder {
    int metav; LAS unsigned* tok; int G, c, npn, nwg, nt; const char* A0; const char* B0; unsigned atile, bexp, btile;
    int nfull, St, sb;
    __device__ __forceinline__ bool next(int i, Unit& u) const {
        const int L = i * G + c; int h = -1, su = 0, rt, pn;
        if (St > 0) {
            if (L < nfull) { const int wgid = xcd_remap(L, nfull); rt = wgid / npn; pn = wgid - rt * npn; if (rt >= sb) rt += St; }
            else { const int q = G - 1 - c; if (L >= nfull + G || q >= 16 * St) return false; su = q >> 2; h = q & 3; rt = sb + (su >> 2); pn = su & 3; }
        } else { if (L >= nwg) return false; const int wgid = xcd_remap(L, nwg); rt = wgid / npn; pn = wgid - rt * npn; }
        int e = 0;
#pragma unroll
        for (int k = 1; k < NE; ++k) e += (rt >= __builtin_amdgcn_readlane(metav, 8 + k)) ? 1 : 0;
        const int j = rt - __builtin_amdgcn_readlane(metav, 8 + e);
        u.pm = rt; u.pn = pn; u.aux = e | (j << 4); u.nt = nt; u.A = A0 + (size_t)rt * atile; u.B = B0 + (size_t)e * bexp + (size_t)pn * btile;
        if (h >= 0) { const int k0 = h < 2 ? 12 * h : 4 + 10 * h; u.nt = h < 2 ? 12 : 10; u.A += k0 * 128; u.B += k0 * 128; u.aux |= (1 << 20) | (h << 21) | (su << 23); }
        return true;
    }
    __device__ __forceinline__ unsigned row_off(int i, int r) const { return tok[i * 256 + r]; }
    __device__ __forceinline__ void fill_tok(const Params& p, int tid) const {
        const int* list = PB(WS_LIST, int);
        const int* lp[8]; bool ok[8];
#pragma unroll
        for (int k = 0; k < 8; ++k) { const int idx = tid + 512 * k, i = idx >> 8, r = idx & 255, L = i * G + c; ok[k] = false; lp[k] = list;
            if (L < nwg) { const int wgid = xcd_remap(L, nwg), rt = wgid / npn; int e = 0;
#pragma unroll
                for (int kk = 1; kk < NE; ++kk) e += (rt >= __builtin_amdgcn_readlane(metav, 8 + kk)) ? 1 : 0;
                const int pos = (rt - SHIDX(metav, 8 + e)) * 256 + r; if (pos < SHIDX(metav, e)) { ok[k] = true; lp[k] = list + (size_t)e * T_ + pos; } } }
        int ent[8];
#pragma unroll
        for (int k = 0; k < 8; ++k) ent[k] = *lp[k];
#pragma unroll
        for (int k = 0; k < 8; ++k) tok[tid + 512 * k] = ok[k] ? (unsigned)(ent[k] >> 1) * (unsigned)(D_ * 2) : 0u;
        __syncthreads();
    }
};
struct EpiMoeDown { static constexpr bool PERM = true; Params p; int l;
    __device__ __forceinline__ void operator()(AccT& acc, const Unit& u, int wr, int wc, int fr, int fq) const {
        if (u.aux & (1 << 20)) {
            const int h = (u.aux >> 21) & 3, su = (u.aux >> 23) & 63, tid = (wr * 4 + wc) * 64 + fq * 16 + fr;
            float* slab = PB(A_YP, float) + (size_t)su * (4 * 65536) + (size_t)tid * 4;
#pragma unroll
            for (int ai = 0; ai < 2; ++ai)
#pragma unroll
                for (int bj = 0; bj < 2; ++bj)
#pragma unroll
                    for (int m = 0; m < 4; ++m)
#pragma unroll
                        for (int n = 0; n < 2; ++n) *(f32x4*)(slab + h * 65536 + (((ai * 2 + bj) * 4 + m) * 2 + n) * 2048) = acc[ai][bj][m][n];
            asm volatile("s_waitcnt vmcnt(0)" ::: "memory");
            __syncthreads();
            if (tid == 0) { unsigned* tk = PB(WS_CTL, unsigned) + CW_CNT + (l >> 1) * 1024 + 512 + su;
                __builtin_amdgcn_fence(__ATOMIC_RELEASE, "agent"); asm volatile("s_waitcnt vmcnt(0)" ::: "memory");
                (void)__hip_atomic_fetch_add(tk, 1u, __ATOMIC_RELAXED, __HIP_MEMORY_SCOPE_AGENT);
                unsigned sp = 0; while (__hip_atomic_load(tk, __ATOMIC_RELAXED, __HIP_MEMORY_SCOPE_AGENT) < 4u && ++sp < (1u << 22)) __builtin_amdgcn_s_sleep(1);
                __builtin_amdgcn_fence(__ATOMIC_ACQUIRE, "agent"); asm volatile("s_waitcnt vmcnt(0)" ::: "memory"); }
            __syncthreads();
            const int e = u.aux & 15, j = (u.aux >> 4) & 0xFFFF, ai = h >> 1, bj = h & 1; const int cnt = (int)(PB(WS_CTL, unsigned) + CW_CNT + (l >> 1) * 1024)[64 * e];
            const int* list = PB(WS_LIST, int) + (size_t)e * T_; const float* tw = PB(WS_TW, float); const int c0 = u.pn * 256 + bj * 128 + wc * 32 + fq * 8;
            const float* q = slab + h * 16384;
#pragma unroll
            for (int m = 0; m < 4; ++m) { f32x4 r[2];
#pragma unroll
                for (int n = 0; n < 2; ++n) { const float* qq = q + (m * 2 + n) * 2048;
                    const f32x4 p0 = *(const f32x4*)qq, p1 = *(const f32x4*)(qq + 65536), p2 = *(const f32x4*)(qq + 2 * 65536), p3 = *(const f32x4*)(qq + 3 * 65536);
                    r[n] = ((p0 + p1) + p2) + p3; }
                const int pos = j * 256 + ai * 128 + wr * 64 + m * 16 + fr;
                if (pos < cnt) { const int ent = list[pos]; const float w = tw[ent]; bf16_t* Y = ((ent & 1) ? PB(A_Y1, bf16_t) : PB(A_Y0, bf16_t)) + (size_t)(ent >> 1) * D_ + c0;
                    *(u32x4*)Y = pack8(r[0] * w, r[1] * w); } }
            return;
        }
        const int e = u.aux & 15, j = (u.aux >> 4) & 0xFFFF; const int cnt = (int)(PB(WS_CTL, unsigned) + CW_CNT + (l >> 1) * 1024)[64 * e];
        const int* list = PB(WS_LIST, int) + (size_t)e * T_; const float* tw = PB(WS_TW, float); const int c0 = u.pn * 256 + wc * 32 + fq * 8;
#pragma unroll
        for (int ai = 0; ai < 2; ++ai)
#pragma unroll
            for (int m = 0; m < 4; ++m) { const int pos = j * 256 + ai * 128 + wr * 64 + m * 16 + fr;
                if (pos < cnt) { const int ent = list[pos]; const float w = tw[ent]; bf16_t* Y = ((ent & 1) ? PB(A_Y1, bf16_t) : PB(A_Y0, bf16_t)) + (size_t)(ent >> 1) * D_ + c0;
#pragma unroll
                    for (int bj = 0; bj < 2; ++bj) *(u32x4*)(Y + bj * 128) = pack8(acc[ai][bj][m][0] * w, acc[ai][bj][m][1] * w); } }
    } };

namespace att {
typedef short s16x4 __attribute__((ext_vector_type(4)));
typedef float f32x16 __attribute__((ext_vector_type(16)));
constexpr int KVBLK = 64, SHM_V = KVBLK * VD * 2  , SHM_K = KVBLK * 256  , LDS_ATT = 2 * SHM_V + 2 * SHM_K + 8 * 64 * 4;
#define KSWZ(row, colB) ((row) * 256 + ((colB) ^ (((row) & 7) << 4)))
#define SBAR() __builtin_amdgcn_sched_barrier(0)
__device__ __forceinline__ int crow(int r, int hi) { return (r & 3) + 8 * (r >> 2) + 4 * hi; }
__device__ __forceinline__ void partialSM(f32x16& p0, f32x16& p1) {
#pragma unroll
    for (int r = 0; r < 16; ++r) p0[r] = __builtin_amdgcn_exp2f(p0[r]);
}
__device__ __forceinline__ void finishSM(f32x16& p0, f32x16& p1, float& l_reg, bf16x8& pa0, bf16x8& pa1, bf16x8& pa2, bf16x8& pa3) {
#pragma unroll
    for (int r = 0; r < 16; ++r) p1[r] = __builtin_amdgcn_exp2f(p1[r]);
    float ps = 0;
#pragma unroll
    for (int r = 0; r < 16; ++r) ps += p0[r];
#pragma unroll
    for (int r = 0; r < 16; ++r) ps += p1[r];
    { auto rr = __builtin_amdgcn_permlane32_swap(__float_as_uint(ps), __float_as_uint(ps), false, false); ps = __uint_as_float(rr[0]) + __uint_as_float(rr[1]); }
    l_reg += ps;
#define PK4(P, BASE, OUT) do { unsigned a0 = cvt_pk_bf16(P[BASE + 0], P[BASE + 1]), a1 = cvt_pk_bf16(P[BASE + 2], P[BASE + 3]);   \
    unsigned b0 = cvt_pk_bf16(P[BASE + 4], P[BASE + 5]), b1 = cvt_pk_bf16(P[BASE + 6], P[BASE + 7]);                              \
    auto r0 = __builtin_amdgcn_permlane32_swap(a0, b0, false, false); auto r1 = __builtin_amdgcn_permlane32_swap(a1, b1, false, false); \
    u32x4 w = {r0[0], r1[0], r0[1], r1[1]}; OUT = *reinterpret_cast<bf16x8*>(&w); } while (0)
    PK4(p0, 0, pa0); PK4(p0, 8, pa1); PK4(p1, 0, pa2); PK4(p1, 8, pa3);
#undef PK4
}
__device__ __forceinline__ void qkt(f32x16& p0, f32x16& p1, const LAS char* Ks, const bf16x8* qr, int r32, int hi) {
    p0 = f32x16{}; p1 = f32x16{};
#pragma unroll
    for (int d0 = 0; d0 < 6; ++d0) { const int cb = (d0 * 16 + hi * 8) * 2;
        const bf16x8 b0 = *(const LAS bf16x8*)(Ks + KSWZ(r32, cb));
        const bf16x8 b1 = *(const LAS bf16x8*)(Ks + KSWZ(32 + r32, cb));
        p0 = __builtin_amdgcn_mfma_f32_32x32x16_bf16(b0, qr[d0], p0, 0, 0, 0);
        p1 = __builtin_amdgcn_mfma_f32_32x32x16_bf16(b1, qr[d0], p1, 0, 0, 0); }
}
__device__ __forceinline__ int v_st(int k, int c) { const int kk = (k & ~0xC) | ((k & 4) << 1) | ((k & 8) >> 1); return ((kk >> 3) * 2 + (c >> 5)) * 512 + ((kk & 7) * 32 + (c & 31)) * 2; }
__device__ __forceinline__ int v_rd_base(int lane) { return ((lane & 3) << 3) | (((lane >> 2) & 3) << 6) | (((lane >> 4) & 1) << 5) | (((lane >> 5) & 1) << 8); }
constexpr int v_rd_off(int d0, int ks, int half) { return d0 * 512 + ks * 2048 + half * 1024; }
template <int OFF> __device__ __forceinline__ s16x4 tr_read(int vb) { s16x4 r; asm volatile("ds_read_b64_tr_b16 %0, %1 offset:%2" : "=&v"(r) : "v"(vb), "i"(OFF) : "memory"); return r; }
template <int D0> __device__ __forceinline__ void pv_one(f32x16& od, int vb, bf16x8 pa0, bf16x8 pa1, bf16x8 pa2, bf16x8 pa3) {
    const s16x4 l0 = tr_read<v_rd_off(D0, 0, 0)>(vb), h0 = tr_read<v_rd_off(D0, 0, 1)>(vb), l1 = tr_read<v_rd_off(D0, 1, 0)>(vb), h1 = tr_read<v_rd_off(D0, 1, 1)>(vb);
    const s16x4 l2 = tr_read<v_rd_off(D0, 2, 0)>(vb), h2 = tr_read<v_rd_off(D0, 2, 1)>(vb), l3 = tr_read<v_rd_off(D0, 3, 0)>(vb), h3 = tr_read<v_rd_off(D0, 3, 1)>(vb);
    asm volatile("s_waitcnt lgkmcnt(0)" ::: "memory"); SBAR();
#define PKV(L, H) (bf16x8){L[0], L[1], L[2], L[3], H[0], H[1], H[2], H[3]}
    od = __builtin_amdgcn_mfma_f32_32x32x16_bf16(pa0, PKV(l0, h0), od, 0, 0, 0);
    od = __builtin_amdgcn_mfma_f32_32x32x16_bf16(pa1, PKV(l1, h1), od, 0, 0, 0);
    od = __builtin_amdgcn_mfma_f32_32x32x16_bf16(pa2, PKV(l2, h2), od, 0, 0, 0);
    od = __builtin_amdgcn_mfma_f32_32x32x16_bf16(pa3, PKV(l3, h3), od, 0, 0, 0);
#undef PKV
}
__device__ __forceinline__ void pv_d0(f32x16* o, int vb, bf16x8 pa0, bf16x8 pa1, bf16x8 pa2, bf16x8 pa3) { pv_one<0>(o[0], vb, pa0, pa1, pa2, pa3); pv_one<1>(o[1], vb, pa0, pa1, pa2, pa3); }

__device__ __forceinline__ void attn_unit(const bf16_t* __restrict__ Qb, const bf16_t* __restrict__ Kh, const bf16_t* __restrict__ Vh, bf16_t* __restrict__ Ob, int seq, LAS char* lds, int tid) {
    const int wid = tid >> 6, lane = tid & 63, r32 = lane & 31, hi = lane >> 5;
    LAS char* V_lds = lds; LAS char* K_lds = lds + 2 * SHM_V;
    LAS float* ws = (LAS float*)(lds + 2 * SHM_V + 2 * SHM_K) + wid * 64; LAS float* li_l = ws;
    float l_reg = 0; f32x16 o[2] = {}; bf16x8 qr[6];
    const bf16_t* Qw = Qb + (size_t)(wid * 32 + r32) * QKD + hi * 8;
#pragma unroll
    for (int d0 = 0; d0 < 6; ++d0) qr[d0] = *(const bf16x8*)(Qw + d0 * 16);
    const int vrow = tid >> 3, vch = tid & 7, vst = v_st(vrow, vch * 8);
    const int k0row = tid / 12, k0ch = tid % 12; const bool k1ok = tid < 256; const int id1 = k1ok ? tid + 512 : tid, k1row = id1 / 12, k1ch = id1 % 12;
    const int kst0 = KSWZ(k0row, k0ch * 16), kst1 = KSWZ(k1row, k1ch * 16);
    const int vb0 = (int)(uintptr_t)V_lds + v_rd_base(lane);
    struct { bf16x8 v, k0, k1; } sr_[2];
    const unsigned vgo = (unsigned)(vrow * VD + vch * 8) * 2u, kgo0 = (unsigned)(k0row * QKD + k0ch * 8) * 2u, kgo1 = (unsigned)(k1row * QKD + k1ch * 8) * 2u;
#define SLOAD(i, kk0) do { const char* vt_ = (const char*)Vh + (size_t)(kk0) * (VD * 2); const char* kt_ = (const char*)Kh + (size_t)(kk0) * (QKD * 2); \
    sr_[i].v = *(const bf16x8*)(vt_ + vgo); sr_[i].k0 = *(const bf16x8*)(kt_ + kgo0); sr_[i].k1 = *(const bf16x8*)(kt_ + kgo1); } while (0)
#define SWRITE(b, i) do { *(LAS bf16x8*)(V_lds + (b) * SHM_V + vst) = sr_[i].v; *(LAS bf16x8*)(K_lds + (b) * SHM_K + kst0) = sr_[i].k0; if (k1ok) *(LAS bf16x8*)(K_lds + (b) * SHM_K + kst1) = sr_[i].k1; } while (0)
#define SWAIT() asm volatile("s_waitcnt vmcnt(3)" ::: "memory")
    f32x16 pA0, pA1, pB0, pB1; bf16x8 pa0, pa1, pa2, pa3; const int NT = seq / KVBLK;
    constexpr int SE = 0, SO = 1;
    SLOAD(SE, 0); asm volatile("s_waitcnt vmcnt(0)" ::: "memory"); SWRITE(0, SE); __syncthreads();
    qkt(pA0, pA1, K_lds, qr, r32, hi); partialSM(pA0, pA1);
    SLOAD(SO, KVBLK); if (2 < NT) SLOAD(SE, 2 * KVBLK);
    SWAIT(); SWRITE(1, SO); __syncthreads();
#pragma unroll 1
    for (int j = 1; j + 1 < NT; j += 2) {
        SBAR(); qkt(pB0, pB1, K_lds + SHM_K, qr, r32, hi);
        finishSM(pA0, pA1, l_reg, pa0, pa1, pa2, pa3); SBAR();
        SLOAD(SO, (j + 2) * KVBLK); SBAR();
        pv_d0(o, vb0, pa0, pa1, pa2, pa3); partialSM(pB0, pB1);
        __syncthreads(); SWAIT(); SWRITE(0, SE);
        __syncthreads();
        SBAR(); qkt(pA0, pA1, K_lds, qr, r32, hi);
        finishSM(pB0, pB1, l_reg, pa0, pa1, pa2, pa3); SBAR();
        if (j + 3 < NT) SLOAD(SE, (j + 3) * KVBLK); SBAR();
        pv_d0(o, vb0 + SHM_V, pa0, pa1, pa2, pa3); partialSM(pA0, pA1);
        __syncthreads(); SWAIT(); SWRITE(1, SO);
        __syncthreads();
    }
    SBAR(); qkt(pB0, pB1, K_lds + SHM_K, qr, r32, hi);
    finishSM(pA0, pA1, l_reg, pa0, pa1, pa2, pa3); SBAR();
    pv_d0(o, vb0, pa0, pa1, pa2, pa3); partialSM(pB0, pB1);
    __syncthreads();
    finishSM(pB0, pB1, l_reg, pa0, pa1, pa2, pa3); SBAR();
    pv_d0(o, vb0 + SHM_V, pa0, pa1, pa2, pa3);
    if (hi == 0) li_l[r32] = l_reg; asm volatile("s_waitcnt lgkmcnt(0)" ::: "memory");
    bf16_t* Ow = Ob + (size_t)(wid * 32) * LDHLO;
#pragma unroll
    for (int r = 0; r < 16; ++r) { const int orow = crow(r, hi); const float rl = __builtin_amdgcn_rcpf(li_l[orow]);
#pragma unroll
        for (int d0 = 0; d0 < 2; ++d0) Ow[(size_t)orow * LDHLO + d0 * 32 + r32] = f2bf(o[d0][r] * rl); }
    __syncthreads();
#undef SLOAD
#undef SWRITE
#undef SWAIT
#undef RESC
}
#undef KSWZ
#undef SBAR
}
__device__ __forceinline__ void ph_attn(const Params& p, LAS unsigned char* lds, int blk, int G, int tid, int loc, int xi, int lr) {
    const bf16_t* Q = PB(A_Q, bf16_t); const bf16_t* K = PB(A_K, bf16_t); const bf16_t* V = PB(A_V, bf16_t); bf16_t* O = PB(A_HLO, bf16_t) + 1024;
#pragma unroll 1
    for (int i = 0;; ++i) {
        int bh, qb;
        if (loc) { const int uu = i * 32 + lr; if (uu >= 64) break; bh = xi * 8 + (uu >> 3); qb = uu & 7; }
        else { const int L = i * G + blk; if (L >= B_ * H_ * 8) break;
            if (G == 256) { const int x = blk & 7, y = blk >> 3; bh = i * 32 + x * 4 + (y >> 3); qb = y & 7; } else { bh = L >> 3; qb = L & 7; } }
        const int b = bh >> 3, h = bh & 7;
        att::attn_unit(Q + ((size_t)bh * S_ + qb * 256) * QKD, K + (size_t)bh * S_ * QKD, V + (size_t)bh * S_ * VD, O + ((size_t)b * S_ + qb * 256) * LDHLO + h * VD, S_, (LAS char*)lds, tid);
    }
}

struct CvItem { const float* src; size_t ldw; const float* ksc; bf16_t* dst; int k0, Kd; float mul; };
__device__ __forceinline__ void tr_load(const CvItem& d, int lane, f32x4 (&v)[16]) {
    const int r = lane >> 4;
#pragma unroll
    for (int i = 0; i < 16; ++i) v[i] = d.src ? *(const f32x4*)(d.src + (size_t)(d.k0 + 4 * i + r) * d.ldw) : (f32x4){0.f, 0.f, 0.f, 0.f};
}
__device__ __forceinline__ void tr_emit(const f32x4 (&v)[16], const CvItem& d, LAS float* scr, int lane) {
    const int r = lane >> 4, c4 = lane & 15;
    float ks[16];
#pragma unroll
    for (int i = 0; i < 16; ++i) ks[i] = d.ksc ? d.ksc[4 * i + r] : 1.0f;
#pragma unroll
    for (int i = 0; i < 16; ++i) { const int kk = 4 * i + r; const f32x4 x = v[i] * (ks[i] * d.mul); LAS float* q = scr + kk * 65 + 4 * c4; q[0] = x.x; q[1] = x.y; q[2] = x.z; q[3] = x.w; }
    LDS_WAIT(); asm volatile("" ::: "memory");
    const int c = lane & 7;
#pragma unroll
    for (int j = 0; j < 8; ++j) { const int n = (lane >> 3) + 8 * j; const LAS float* sp = scr + (8 * c) * 65 + n;
        u32x4 o; o.x = pk2(sp[0 * 65], sp[1 * 65]); o.y = pk2(sp[2 * 65], sp[3 * 65]); o.z = pk2(sp[4 * 65], sp[5 * 65]); o.w = pk2(sp[6 * 65], sp[7 * 65]);
        *(u32x4*)(d.dst + (size_t)n * d.Kd + 8 * c) = o; }
    LDS_WAIT(); asm volatile("" ::: "memory");
}
constexpr int CV_NL = L_ * 2112, CV_ND = 2 * 2112, CV_MOE = 8 * 2112;
__device__ __forceinline__ void cv_decode(const Params& p, int it, int c4, CvItem& o) {
    bf16_t* WB = PB(WS_WEI, bf16_t);
    constexpr int PER_L = 2112, N_L = L_ * PER_L, PER_F = 2112, N_D = 2 * PER_F;
    const float* src = nullptr; size_t ldw = 0; int k0 = 0; const float* ksc = nullptr; bf16_t* dst = nullptr; int Kd = 0; float mul = 1.0f;
    if (it < N_L) {
        const int l = it / PER_L; int r = it % PER_L;
        if (r < 1216) { const int kb = r & 15, nd0 = (r >> 4) * 64, nd = nd0 + c4; const int sc = nd < 512 ? nd : (nd < 4608 ? nd + 32 : (nd < 4640 ? 512 + nd - 4608 : -1));
            if (sc >= 0) src = p.in[7] + (size_t)l * D_ * INC + sc; ldw = INC; k0 = kb * 64; Kd = 1024; dst = WB + WE_WIN + ((size_t)l * 4864 + nd0) * 1024 + k0; }
        else if ((r -= 1216) < 64) { const int kb = r & 3, nd0 = (r >> 2) * 64, nd = nd0 + c4, h = nd >> 7, d = nd & 127;
            if (d < 96) src = p.in[10] + (size_t)l * 256 * 768 + h * 96 + d; ldw = 768; k0 = kb * 64; Kd = 256; ksc = p.in[8] + l * 256 + k0; dst = WB + WE_WQKV + ((size_t)l * 2048 + nd0) * 256 + k0; }
        else if ((r -= 64) < 64) { const int kb = r & 3, nd0 = (r >> 2) * 64;
            src = p.in[11] + (size_t)l * 256 * 1024 + nd0 + c4; ldw = 1024; k0 = kb * 64; Kd = 256; ksc = p.in[9] + l * 256 + k0; dst = WB + WE_WQKV + ((size_t)l * 2048 + 1024 + nd0) * 256 + k0; }
        else if ((r -= 64) < 128) { const int kh = r & 1, b4 = (r >> 1) & 3, pn = r >> 3, nbk = pn >> 1, hc = pn & 1, c = b4 * 64 + c4, dir = c >> 7, wc = (c >> 5) & 3, gate = (c >> 4) & 1, e = hc * 64 + 16 * wc + (c & 15);
            src = p.in[17] + ((((size_t)l * 2 + dir) * 2 + gate) * NE + nbk) * 128 * 128 + e; ldw = 128; k0 = kh * 64; Kd = 128; mul = -1.4426950408889634f;
            dst = WB + WE_WG + ((size_t)l * 4096 + pn * 256 + b4 * 64) * 128 + k0; }
        else if ((r -= 128) < 256) { const int kb = r & 15, nd0 = (r >> 4) * 64;
            src = p.in[20] + (size_t)l * D_ * D_ + nd0 + c4; ldw = 1024; k0 = kb * 64; Kd = 1536; dst = WB + WE_WCAT + ((size_t)l * 1024 + nd0) * 1536 + k0; }
        else if ((r -= 256) < 128) { const int kb = r & 7, nd0 = (r >> 3) * 64;
            src = p.in[14] + (size_t)l * 512 * D_ + nd0 + c4; ldw = 1024; k0 = kb * 64; Kd = 1536; dst = WB + WE_WCAT + ((size_t)l * 1024 + nd0) * 1536 + 1024 + k0; }
        else { r -= 128; const int kb = r & 15, nd0 = (r >> 4) * 64;
            src = p.in[21] + (size_t)l * D_ * D_ + nd0 + c4; ldw = 1024; k0 = kb * 64; Kd = 1024; dst = WB + WE_WOUT + ((size_t)l * 1024 + nd0) * 1024 + k0; }
    } else {
        const bool moe = it >= N_L + N_D; int r = moe ? it - N_L - N_D : it - N_L; const int ie = r / PER_F; r %= PER_F;
        const float* Wg = (moe ? p.in[26] : p.in[22]) + (size_t)ie * D_ * FF; const float* Wu = (moe ? p.in[27] : p.in[23]) + (size_t)ie * D_ * FF; const float* Wd = (moe ? p.in[28] : p.in[24]) + (size_t)ie * FF * D_;
        bf16_t* GU = WB + (moe ? WE_MGU : WE_FGU) + (size_t)ie * 5632 * 1024; bf16_t* DN = WB + (moe ? WE_MD : WE_FD) + (size_t)ie * 1024 * 2816;
        if (r < 1408) { const int kb = r & 15, nd0 = (r >> 4) * 64, nd = nd0 + c4, pn = nd >> 8, rr = nd & 255;
            src = (rr < 128 ? Wg : Wu) + pn * 128 + (rr & 127); ldw = FF; k0 = kb * 64; Kd = 1024; dst = GU + (size_t)nd0 * 1024 + k0; }
        else { r -= 1408; const int kb = r % 44, nd0 = (r / 44) * 64;
            src = Wd + nd0 + c4; ldw = 1024; k0 = kb * 64; Kd = 2816; dst = DN + (size_t)nd0 * 2816 + k0; }
    }
    o.src = src; o.ldw = ldw; o.ksc = ksc; o.dst = dst; o.k0 = k0; o.Kd = Kd; o.mul = mul;
}
__device__ __forceinline__ void p0_weights(const Params& p, LAS float* scr, int lo, int hi, int widx, int nw, int lane) {
    const int c4 = (lane & 15) * 4;
    int it = lo + widx; if (it >= hi) return;
    CvItem cur; cv_decode(p, it, c4, cur);
    f32x4 v[16]; tr_load(cur, lane, v);
#pragma unroll 1
    for (;;) {
        const int nx = it + nw; const bool more = nx < hi; CvItem nxt = cur; f32x4 w[16];
#pragma unroll
        for (int i = 0; i < 16; ++i) w[i] = v[i];
        if (more) { cv_decode(p, nx, c4, nxt); tr_load(nxt, lane, w); }
        tr_emit(v, cur, scr, lane);
        if (!more) break;
#pragma unroll
        for (int i = 0; i < 16; ++i) v[i] = w[i];
        cur = nxt; it = nx;
    }
}
__device__ __forceinline__ void p0_gbias(const Params& p, int gt, int ngt) {
    float* GB = PB(WS_GB, float);
    for (int idx = gt; idx < L_ * 4096; idx += ngt) {
        const int l = idx >> 12, pn = (idx >> 8) & 15, c = idx & 255, dir = c >> 7, wc = (c >> 5) & 3, n = (c >> 4) & 1, fq = (c >> 2) & 3, j = c & 3;
        const int nbk = pn >> 1, e = (pn & 1) * 64 + 16 * wc + 4 * fq + j, ch = nbk * 128 + e;
        (void)e; GB[idx] = -1.4426950408889634f * p.in[18][(((size_t)l * 2 + dir) * 2 + n) * D_ + ch];
    }
    float* SPT = PB(WS_GB, float) + L_ * 4096;
    for (int idx = gt; idx < L_ * 2 * D_; idx += ngt) SPT[idx] = -8.0f * softplusf_(p.in[19][idx]);
}

#define XB_TMO      128
#define XB_XCNT(j)  (256  + 64 * (j))
#define XB_XSUB(j)  (1280 + 64 * (j))
#define XB_XGEN(j)  (2304 + 64 * (j))
#define XB_TOP      3328
#define XB_TOPGEN   3392
#define XCD_BAR_WORDS 3456
#define XB_SPIN_CAP (1u << 18)
__device__ __forceinline__ unsigned xb_ld(unsigned* p)              { return __hip_atomic_load(p, __ATOMIC_RELAXED, __HIP_MEMORY_SCOPE_AGENT); }
__device__ __forceinline__ unsigned xb_add(unsigned* p, unsigned v) { return __hip_atomic_fetch_add(p, v, __ATOMIC_RELAXED, __HIP_MEMORY_SCOPE_AGENT); }
__device__ __forceinline__ unsigned xb_xcc_id() { return (unsigned)__builtin_amdgcn_s_getreg((3 << 11) | 20) & 0xFu; }
#define XB_SPIN(cond, bar) do { unsigned _sp = 0; while (cond) { __builtin_amdgcn_s_sleep(1); \
    if ((++_sp & 255u) == 0u) { if (xb_ld(&(bar)[XB_TMO])) break; if (_sp > XB_SPIN_CAP) { atomicAdd(&(bar)[XB_TMO], 1u); break; } } } } while (0)
struct XcdBarrier { unsigned* bar; unsigned x; volatile LAS unsigned* st; };
__device__ __forceinline__ XcdBarrier xcd_barrier_post(unsigned* bar, volatile LAS unsigned* st) {
    XcdBarrier b; b.bar = bar; b.x = xb_xcc_id(); b.st = st;
    if (threadIdx.x == 0) st[2] = xb_add(&bar[XB_XCNT(b.x)], 1u);
    return b;
}
__device__ __forceinline__ void xcd_barrier_complete(unsigned* bar, unsigned x, unsigned& nloc, unsigned& nx) {
    const unsigned G = gridDim.x * gridDim.y * gridDim.z;
    unsigned sum, cnt, mine, sp = 0u;
    for (;;) {
        sum = 0u; cnt = 0u; mine = 0u;
#pragma unroll
        for (unsigned j = 0; j < 16; ++j) { const unsigned c = xb_ld(&bar[XB_XCNT(j)]); sum += c; cnt += (c > 0u) ? 1u : 0u; }
        mine = xb_ld(&bar[XB_XCNT(x)]);
        if (sum == G) break;
        __builtin_amdgcn_s_sleep(1);
        if ((++sp & 255u) == 0u) { if (xb_ld(&bar[XB_TMO])) break; if (sp > XB_SPIN_CAP) { atomicAdd(&bar[XB_TMO], 1u); break; } }
    }
    nloc = mine > 0u ? mine : 1u; nx = cnt > 0u ? cnt : 1u;
}
__device__ __forceinline__ void xcd_barrier(const XcdBarrier& b) {
    asm volatile("s_waitcnt vmcnt(0)" ::: "memory");
    __syncthreads();
    if (threadIdx.x == 0) {
        unsigned* bar = b.bar; asm volatile("" : "+s"(bar));
        __builtin_amdgcn_s_waitcnt(0);
        unsigned nloc = b.st[0], nx = b.st[1];
        if (nloc == 0u) { xcd_barrier_complete(bar, b.x, nloc, nx); b.st[0] = nloc; b.st[1] = nx; }
        const unsigned old = xb_add(&bar[XB_XSUB(b.x)], 1u);
        const unsigned gen = old / nloc;
        if (old + 1u == (gen + 1u) * nloc) {
            __builtin_amdgcn_fence(__ATOMIC_RELEASE, "agent");
            asm volatile("s_waitcnt vmcnt(0)" ::: "memory");
            const unsigned og = xb_add(&bar[XB_TOP], 1u);
            const unsigned tg = og / nx;
            if (og + 1u == (tg + 1u) * nx) xb_add(&bar[XB_TOPGEN], 1u);
            else XB_SPIN(xb_ld(&bar[XB_TOPGEN]) == tg, bar);
            __builtin_amdgcn_fence(__ATOMIC_ACQUIRE, "agent");
            xb_add(&bar[XB_XGEN(b.x)], 1u);
            asm volatile("s_waitcnt vmcnt(0)" ::: "memory");
        } else {
            XB_SPIN(xb_ld(&bar[XB_XGEN(b.x)]) == gen, bar);
            __builtin_amdgcn_fence(__ATOMIC_ACQUIRE, "agent");
            asm volatile("s_waitcnt vmcnt(0)" ::: "memory");
        }
    }
    __syncthreads();
}

__device__ __forceinline__ void xcd_local_barrier(unsigned* ctl, unsigned* gbar, unsigned xi, unsigned nloc) {
    asm volatile("s_waitcnt vmcnt(0)" ::: "memory");
    __syncthreads();
    if (threadIdx.x == 0) {
        unsigned* sub = ctl + CW_LBAR + 64 * xi; unsigned* gen = ctl + CW_LBAR + 1024 + 64 * xi; asm volatile("" : "+s"(sub), "+s"(gen));
        asm volatile("buffer_inv sc1" ::: "memory");
        const unsigned old = xb_add(sub, 1u), g = old / nloc;
        if (old + 1u == (g + 1u) * nloc) (void)xb_add(gen, 1u);
        else XB_SPIN(xb_ld(gen) == g, gbar);
        asm volatile("s_waitcnt vmcnt(0)" ::: "memory");
    }
    __syncthreads();
}

constexpr int RING_BYTES = 131072, LDS_TOK = RING_BYTES, LDS_MISC = RING_BYTES + 16384, LDS_BYTES = LDS_MISC + 1024;
constexpr int NPL = 14;
enum { SS_NORM1 = 0, SS_WIN, SS_PREP1, SS_QG, SS_KVG, SS_GATES, SS_PREP2, SS_ATTN, SS_Z1, SS_Z, SS_RES, SS_NORM2, SS_UP, SS_DOWN };
constexpr int ST_FINAL = 1 + L_ * NPL, NSTEPS = ST_FINAL + 1;
struct Args { Params p; int s_lo, s_hi, li, pad; };
typedef const Args __attribute__((address_space(4)))* KArgsP;
#if defined(__HIP_DEVICE_COMPILE__)
#define KP() ({ KArgsP _k = (KArgsP)__builtin_amdgcn_kernarg_segment_ptr(); asm volatile("" : "+s"(_k)); _k->p; })
#else
#define KP() (a.p)
#endif

__global__ void __launch_bounds__(512, 2) mk_fwd(Args a) {
    extern __shared__ __attribute__((aligned(16))) unsigned char lds_raw[];
    LAS unsigned char* lds = (LAS unsigned char*)lds_raw;
    const int tid = threadIdx.x;
    const int wave_s = __builtin_amdgcn_readfirstlane(tid >> 6);
#define PH_BEGIN const Params p = KP(); unsigned ones_ = ~0u; asm volatile("" : "+s"(ones_)); int tid_ = wave_s * 64 + (int)__builtin_amdgcn_mbcnt_hi(ones_, __builtin_amdgcn_mbcnt_lo(ones_, 0u)); asm volatile("" : "+v"(tid_)); const int loc_ = __builtin_amdgcn_readfirstlane((int)MISC[12]), xi_ = __builtin_amdgcn_readfirstlane((int)MISC[11]), lr_ = __builtin_amdgcn_readfirstlane((int)MISC[10]); int blk_ = loc_ ? lr_ * 8 + xi_ : (int)blockIdx.x, G = gridDim.x; asm volatile("" : "+s"(blk_), "+s"(G)); \
    const int lane = tid_ & 63, wave = __builtin_amdgcn_readfirstlane(tid_ >> 6), gw = (loc_ ? lr_ : blk_) * 8 + wave, ngw = loc_ ? 256 : G * 8, row0_ = loc_ ? xi_ * S_ : 0, nrows_ = loc_ ? S_ : T_, gt = blk_ * 512 + tid_, ngt = G * 512; (void)lane; (void)gw; (void)ngw; (void)gt; (void)ngt; (void)row0_; (void)nrows_;
    unsigned misc_base_ = LDS_MISC; asm volatile("" : "+s"(misc_base_));
    volatile LAS unsigned* MISC = (volatile LAS unsigned*)(lds + misc_base_);
    for (int u = tid; u < 256; u += 512) MISC[u] = 0u;
    __syncthreads();
    XcdBarrier bar; { const Params p = KP(); bar.bar = PB(WS_CTL, unsigned) + CW_BAR + a.li * XCD_BAR_WORDS; bar.x = 0; bar.st = nullptr;
    if (a.s_hi - a.s_lo > 1) bar = xcd_barrier_post(PB(WS_CTL, unsigned) + CW_BAR + a.li * XCD_BAR_WORDS, MISC + 8); }
#ifndef PROBE_REPEAT
#define PROBE_REPEAT 0
#endif
#define REP(bit) for (int rep_ = 0; rep_ < 1 + ((PROBE_REPEAT >> (bit)) & 1); ++rep_)
#ifndef PROBE_SEL
#define PROBE_SEL (-1)
#endif
#define T0C (wave_s == 0 && __builtin_amdgcn_mbcnt_hi(~0u, __builtin_amdgcn_mbcnt_lo(~0u, 0u)) == 0u)
#define PT0 if (PROBE_SEL >= 0 && T0C) { MISC[63] = (unsigned)__builtin_amdgcn_s_memrealtime(); }
#define PT1(k) do { if (PROBE_SEL >= 0 && T0C) { MISC[64 + (k)] += (unsigned)__builtin_amdgcn_s_memrealtime() - MISC[63]; } } while (0)
#define IN(s) (a.s_lo <= (s) && (s) < a.s_hi)
#define SEAM(s) do { if (IN(s) && IN((s) + 1)) { PT0 xcd_barrier(bar); PT1(16); } } while (0)
#define SEAML(s) do { if (IN(s) && IN((s) + 1)) { PT0 if (__builtin_amdgcn_readfirstlane((int)MISC[12])) { const Params p = KP(); xcd_local_barrier(PB(WS_CTL, unsigned), bar.bar, (unsigned)__builtin_amdgcn_readfirstlane((int)MISC[11]), 32u); } else xcd_barrier(bar); PT1(16); } } while (0)
#define WB PB(WS_WEI, bf16_t)
#define MOD PB(WS_MOD, float)
    if (IN(0)) REP(14) { PH_BEGIN PT0
        p0_weights(p, (LAS float*)(lds + wave * 16640), 0, (G == 256) ? (CV_NL + CV_ND) : (CV_NL + CV_ND + 2 * CV_MOE), gw, ngw, lane);
        if (G == 256) { p0_weights(p, (LAS float*)(lds + wave * 16640), CV_NL + CV_ND + 7680, CV_NL + CV_ND + CV_MOE, gw, ngw, lane);
                        p0_weights(p, (LAS float*)(lds + wave * 16640), CV_NL + CV_ND + CV_MOE + 10240, CV_NL + CV_ND + 2 * CV_MOE, gw, ngw, lane); }
        __syncthreads();
        ph_mod(p, (LAS float*)lds, blk_, G, tid_);
        ph_tables(p, gt, ngt);
        p0_gbias(p, gt, ngt); PT1(14);
    }
    SEAM(0);
    if (IN(0) && IN(1)) {
        if (tid == 0) { unsigned npop = 0, ok = (gridDim.x == 256u) ? 1u : 0u, xi = 0;
            for (unsigned j = 0; j < 16; ++j) { const unsigned c = xb_ld(&bar.bar[XB_XCNT(j)]); if (c) { ++npop; if (c != 32u) ok = 0u; if (j < bar.x) ++xi; } }
            MISC[11] = xi; MISC[12] = (ok && npop == 8u) ? 1u : 0u; }
        __syncthreads();
    }
    for (int l = 0; l < L_; ++l) {
        const int sb = 1 + l * NPL;
        if (IN(sb + SS_NORM1)) { PH_BEGIN PT0 if (loc_) ph_zero_pads(p, xi_, 1, lr_ * 512 + tid_, 32 * 512); else ph_zero_pads(p, 0, B_, gt, ngt);
            ph_norm(p, l, 1, row0_, nrows_, gw, ngw, lane); PT1(SS_NORM1); }
        SEAML(sb + SS_NORM1);
        if (IN(sb + SS_WIN)) REP(SS_WIN) { PH_BEGIN PT0
            pg8::GemmCfg g{1024, 1024, 1024, 256u}; pg8::StdOrder S; S.init(64, 19, G, blk_, PB(A_XN, bf16_t), WB + WE_WIN + (size_t)l * 4864 * 1024, 1024, 1024, 1024);
            EpiWin E{p}; pg8::gemm_phase<EpiWin, pg8::StdOrder, true, false>(lds, g, S, E, tid_);
            if (G == 256 && blk_ >= 192 && l < 3) { const int base = CV_NL + CV_ND + (l ? CV_MOE : 0) + (l == 2 ? 2560 : 0); p0_weights(p, (LAS float*)(lds + wave * 16640), base, base + 2560, (blk_ - 192) * 8 + wave, 512, lane); }
            PT1(SS_WIN);
        }
        SEAML(sb + SS_WIN);
        if (IN(sb + SS_QG)) REP(SS_QG) { PH_BEGIN PT0
            pg8::GemmCfg g{512, 256, 256, 256u}; QkvOrder S; S.init(G, blk_, PB(A_CQKV, bf16_t), WB + WE_WQKV + (size_t)l * 2048 * 256);
            { const int Gp = loc_ ? 32 : G, cp = loc_ ? lr_ : blk_, Qn = loc_ ? 64 : 512, pmb = loc_ ? xi_ * 8 : 0;
              for (int q = cp; q < Qn; q += Gp) conv_slab(p, l, pmb + (q >> 3), q & 7, tid_); }
            EpiQkvF E{p, l, (LAS float*)(lds + LDS_TOK)}; pg8::gemm_phase<EpiQkvF, QkvOrder, true, false>(lds, g, S, E, tid_); PT1(SS_QG);
            asm volatile("s_waitcnt vmcnt(0)" ::: "memory"); __syncthreads();
            { PT0 pg8::GemmCfg g2{1024, 128, 128, 256u}; GatesOrder S2; S2.init(loc_ ? 32 : G, loc_ ? lr_ : blk_, loc_ ? 64 : 512, loc_ ? xi_ * 8 : 0, PB(A_UC, bf16_t), WB + WE_WG + (size_t)l * 4096 * 128);
              EpiGates E2{p, l}; pg8::gemm_phase<EpiGates, GatesOrder, true, false>(lds, g2, S2, E2, tid_); PT1(SS_GATES); }
        }
        SEAML(sb + SS_GATES);
        if (IN(sb + SS_ATTN)) { PH_BEGIN { PT0
            if (a.pad & 1) REP(SS_ATTN) ph_attn(p, lds, blk_, G, tid_, loc_, xi_, lr_);
            PT1(SS_ATTN); } PT0
            REP(16) { if (loc_) ph_scan(p, l, lds, xi_ * 32 + lr_, xi_ * 32 + lr_ + 1, 1, tid_); else ph_scan(p, l, lds, blk_, B_ * 32, G, tid_); } PT1(17); }
        SEAML(sb + SS_ATTN);
        if (IN(sb + SS_Z)) REP(SS_Z) { PH_BEGIN PT0
            pg8::GemmCfg g{LDHLO, 1536, 1536, 256u}; ZcatOrder S; S.init(G, blk_, PB(A_HLO, bf16_t), WB + WE_WCAT + (size_t)l * 1024 * 1536);
            EpiZcat E{p}; pg8::gemm_phase<EpiZcat, ZcatOrder, true, false>(lds, g, S, E, tid_); PT1(SS_Z);
        }
        SEAML(sb + SS_Z);
        if (IN(sb + SS_RES)) { PH_BEGIN PT0
            pg8::GemmCfg g{1024, 1024, 1024, 256u}; pg8::StdOrder S; S.init(64, 4, G, blk_, PB(A_Z, bf16_t), WB + WE_WOUT + (size_t)l * 1024 * 1024, 1024, 1024, 1024);
            EpiRes E{l == 0 ? p.in[0] : nullptr, PB(A_X, bf16_t), MOD + (size_t)l * 8 * 6144 + 2048}; pg8::gemm_phase<EpiRes, pg8::StdOrder, true, false>(lds, g, S, E, tid_); PT1(SS_RES);
        }
        SEAML(sb + SS_RES);
        if (IN(sb + SS_NORM2)) { PH_BEGIN PT0
            if (l & 1) { LAS float* wl = (LAS float*)lds; const float* wrp = p.in[25] + (size_t)(l >> 1) * D_ * NE;
                for (int idx = tid_; idx < D_ * NE; idx += 512) { const int k = idx >> 3, e = idx & 7; wl[(((k >> 9) * 8 + (k & 7)) * 64 + ((k & 511) >> 3)) * 8 + e] = wrp[idx]; }
                __syncthreads(); }
            ph_norm(p, l, 2, row0_, nrows_, gw, ngw, lane, (const LAS float*)lds); PT1(SS_NORM2); }
        if (l & 1) SEAM(sb + SS_NORM2); else SEAML(sb + SS_NORM2);
        if (IN(sb + SS_UP)) { PH_BEGIN PT0
            if (!(l & 1)) REP(SS_UP) {
                pg8::GemmCfg g{1024, 1024, 1024, 256u}; pg8::StdOrder S; S.init(64, 22, G, blk_, PB(A_XN, bf16_t), WB + WE_FGU + (size_t)(l >> 1) * 5632 * 1024, 1024, 1024, 1024);
                EpiUp E{PB(A_HIDD, bf16_t)}; pg8::gemm_phase<EpiUp, pg8::StdOrder, true, false>(lds, g, S, E, tid_);
                if (G == 256 && blk_ >= 128) { const int base = CV_NL + CV_ND + (l >> 1) * CV_MOE + (l ? 5120 : 2560); p0_weights(p, (LAS float*)(lds + wave * 16640), base, base + 5120, (blk_ - 128) * 8 + wave, 1024, lane); }
                PT1(SS_UP);
            } else REP(15) {
                MoeOrder S; S.metav = moe_meta(p, l, lane); S.tok = (LAS unsigned*)(lds + LDS_TOK); S.G = G; S.c = blk_; S.nt = 16; S.npn = 22; S.nwg = __builtin_amdgcn_readlane(S.metav, 16) * 22; S.A0 = (const char*)PB(A_XN, bf16_t); S.atile = 0; S.nfull = 0; S.St = 0; S.sb = 0;
                S.B0 = (const char*)(WB + WE_MGU + (size_t)(l >> 1) * 8 * 5632 * 1024); S.bexp = 5632u * 1024u * 2u; S.btile = 256u * 1024u * 2u;
                S.fill_tok(p, tid_);
                pg8::GemmCfg g{1024, 1024, 1024, 256u}; EpiUp E{PB(A_HID, bf16_t)}; pg8::gemm_phase<EpiUp, MoeOrder, true, true>(lds, g, S, E, tid_); PT1(15);
            }
        }
        if (l & 1) SEAM(sb + SS_UP); else SEAML(sb + SS_UP);
        if (IN(sb + SS_DOWN)) { PH_BEGIN PT0
            if (!(l & 1)) {
                pg8::GemmCfg g{FF, FF, FF, 256u}; pg8::StdOrder S; S.init(64, 4, G, blk_, PB(A_HIDD, bf16_t), WB + WE_FD + (size_t)(l >> 1) * 1024 * 2816, FF, FF, FF);
                EpiRes E{nullptr, PB(A_X, bf16_t), MOD + (size_t)l * 8 * 6144 + 5120}; pg8::gemm_phase<EpiRes, pg8::StdOrder, true, false>(lds, g, S, E, tid_); PT1(SS_DOWN);
            } else {
                MoeOrder S; S.metav = moe_meta(p, l, lane); S.tok = (LAS unsigned*)(lds + LDS_TOK); S.G = G; S.c = blk_; S.nt = 44; S.npn = 4; S.nwg = __builtin_amdgcn_readlane(S.metav, 16) * 4; S.A0 = (const char*)PB(A_HID, bf16_t); S.atile = 256u * FF * 2u;
                { int tbp = 0, best = 1 << 30, sbv = 0;
#pragma unroll
                  for (int e = 0; e < NE; ++e) { const int tbn = __builtin_amdgcn_readlane(S.metav, e == NE - 1 ? 16 : 9 + e), ne = tbn - tbp; if (ne < best) { best = ne; sbv = tbp; } tbp = tbn; }
                  S.St = (best > 0 && 16 * best <= G) ? best : 0; S.sb = sbv; S.nfull = S.nwg - 4 * S.St; }
                S.B0 = (const char*)(WB + WE_MD + (size_t)(l >> 1) * 8 * 1024 * 2816); S.bexp = 1024u * 2816u * 2u; S.btile = 256u * 2816u * 2u;
                pg8::GemmCfg g{FF, FF, FF, 256u}; EpiMoeDown E{p, l}; pg8::gemm_phase<EpiMoeDown, MoeOrder, true, false>(lds, g, S, E, tid_); PT1(18);
            }
        }
        if (l & 1) SEAM(sb + SS_DOWN); else SEAML(sb + SS_DOWN);
    }
    if (IN(ST_FINAL)) { PH_BEGIN PT0 ph_final(p, gt, ngt); PT1(19); }
    if (PROBE_SEL >= 0 && blockIdx.x == 0 && T0C) {
        const unsigned long long tend = __builtin_amdgcn_s_memrealtime() + 8ull * (unsigned long long)MISC[64 + PROBE_SEL];
        while (__builtin_amdgcn_s_memrealtime() < tend) __builtin_amdgcn_s_sleep(8);
    }
#undef IN
#undef SEAM
#undef WB
#undef MOD
}

#ifndef ONE_LAUNCH
#define ONE_LAUNCH 1
#endif
extern "C" void kernel_launch(void* const* d_in, const int* in_sizes, int n_in, void* d_out, int out_size, void* d_ws, size_t ws_size, hipStream_t stream) {
    if (n_in != 29 || out_size != T_ * D_ || ws_size < WS_END) { fprintf(stderr, "kernel_launch: bad shapes n_in %d out %d ws %zu (need %zu)\n", n_in, out_size, ws_size, (size_t)WS_END); return; }
    Params p{};
    for (int i = 0; i < 29; ++i) p.in[i] = (const float*)d_in[i];
    p.out = (float*)d_out; p.ws = (unsigned char*)d_ws;
    static int grid = 0;
    if (!grid) {
        (void)hipFuncSetAttribute((const void*)mk_fwd, hipFuncAttributeMaxDynamicSharedMemorySize, LDS_BYTES);
        int dev = 0, cus = 0, per_cu = 0; (void)hipGetDevice(&dev); (void)hipDeviceGetAttribute(&cus, hipDeviceAttributeMultiprocessorCount, dev);
        (void)hipOccupancyMaxActiveBlocksPerMultiprocessor(&per_cu, (const void*)mk_fwd, 512, LDS_BYTES);
        grid = cus > 0 ? cus : 256; if (per_cu < 1) fprintf(stderr, "kernel_launch: occupancy query says %d blocks per CU\n", per_cu);
        (void)hipGetLastError();
    }
    (void)hipMemsetAsync((char*)d_ws + WS_CTL, 0, CTL_BYTES, stream);
    if (ONE_LAUNCH) { Args a{}; a.p = p; a.s_lo = 0; a.s_hi = NSTEPS; a.li = 0; a.pad = 1; hipLaunchKernelGGL(mk_fwd, dim3(grid), dim3(512), LDS_BYTES, stream, a); return; }
    for (int s = 0; s < NSTEPS; ++s) { Args a{}; a.p = p; a.s_lo = s; a.s_hi = s + 1; a.li = 0; a.pad = 1; hipLaunchKernelGGL(mk_fwd, dim3(grid), dim3(512), LDS_BYTES, stream, a); }
}
```

```cpp
#include <hip/hip_runtime.h>
#include <cstdio>
#include <cstdint>

constexpr int B_ = 8, S_ = 2048, T_ = B_ * S_, D_ = 1024, L_ = 4, H_ = 8;
constexpr int QKD = 96, VD = 64, FF = 2816, NE = 8, INC = 4640;
constexpr int SP = S_ + 4;
constexpr float EPS = 1e-6f;
constexpr float QSCALE = 0.10206207261596577f * 1.4426950408889634f;

typedef unsigned short bf16_t;
typedef float f32x4 __attribute__((ext_vector_type(4)));
typedef unsigned u32x4 __attribute__((ext_vector_type(4)));
typedef unsigned u32x2 __attribute__((ext_vector_type(2)));

constexpr size_t MiB = 1u << 20;
constexpr size_t WS_CTL = 0, CTL_BYTES = 64 * 1024;
constexpr size_t WS_MOD = 1 * MiB;
constexpr size_t WS_COS = 2 * MiB, WS_SIN = 3 * MiB;
constexpr size_t WS_GB = 4 * MiB;
constexpr size_t WS_LIST = 5 * MiB;
constexpr size_t WS_TW = 6 * MiB;
constexpr size_t WS_SSP = 7 * MiB;
constexpr size_t WS_KRSS = 7 * MiB + 512 * 1024;
constexpr size_t WS_AGG = 8 * MiB;
constexpr size_t WS_WEI = 16 * MiB;
constexpr size_t WS_AR = 392 * MiB;
constexpr size_t A_XN = WS_AR + 0 * MiB;
constexpr size_t A_CQKV = WS_AR + 32 * MiB;
constexpr size_t A_KR = WS_AR + 48 * MiB;
constexpr size_t A_KPE = WS_AR + 50 * MiB;
constexpr size_t A_UP = WS_AR + 52 * MiB;
constexpr size_t A_YG = WS_AR + 86 * MiB;
constexpr size_t A_G = WS_AR + 118 * MiB;
constexpr size_t A_CQN = WS_AR + 182 * MiB;
constexpr size_t A_QR = WS_AR + 198 * MiB;
constexpr size_t A_KVR = WS_AR + 230 * MiB;
constexpr size_t A_LAB = WS_AR + 262 * MiB;
constexpr size_t A_LR = A_LAB + 64 * MiB;
constexpr size_t A_UC = WS_AR + 0 * MiB;
constexpr size_t A_Q = WS_AR + 198 * MiB;
constexpr size_t A_K = WS_AR + 222 * MiB;
constexpr size_t A_V = WS_AR + 246 * MiB;
constexpr size_t A_HLO = WS_AR + 150 * MiB;
constexpr int LDHLO = 1536;
constexpr size_t A_Z = WS_AR + 326 * MiB;
constexpr size_t A_HID = WS_AR + 32 * MiB;
constexpr size_t A_HIDD = WS_AR + 390 * MiB;
constexpr size_t A_YP = A_HIDD;
constexpr size_t A_Y0 = WS_AR + 262 * MiB;
constexpr size_t A_Y1 = WS_AR + 294 * MiB;
constexpr size_t A_X = WS_AR + 358 * MiB;
constexpr size_t WS_END = WS_AR + 478 * MiB;
constexpr int CW_CNT = 8192;
constexpr int CW_LBAR = 10240;
constexpr int CW_BAR = 4096;

struct Params { const float* in[29]; float* out; unsigned char* ws; };

#define PB(off, type) ((type*)(p.ws + (off)))

__device__ __forceinline__ float bf2f(bf16_t v) { return __uint_as_float(((unsigned)v) << 16); }
__device__ __forceinline__ bf16_t f2bf(float f) { unsigned u = __float_as_uint(f); u += 0x7fffu + ((u >> 16) & 1u); return (bf16_t)(u >> 16); }
__device__ __forceinline__ unsigned pk2(float lo, float hi) { return (unsigned)f2bf(lo) | ((unsigned)f2bf(hi) << 16); }
__device__ __forceinline__ unsigned cvt_pk_bf16(float lo, float hi) { unsigned r; asm volatile("v_cvt_pk_bf16_f32 %0, %1, %2" : "=v"(r) : "v"(lo), "v"(hi)); return r; }
__device__ __forceinline__ u32x4 pack8(f32x4 a, f32x4 b) { u32x4 w; w.x = cvt_pk_bf16(a.x, a.y); w.y = cvt_pk_bf16(a.z, a.w); w.z = cvt_pk_bf16(b.x, b.y); w.w = cvt_pk_bf16(b.z, b.w); return w; }
__device__ __forceinline__ f32x4 bf4hi(u32x4 w) { return (f32x4){__uint_as_float(w.z << 16), __uint_as_float(w.z & 0xffff0000u), __uint_as_float(w.w << 16), __uint_as_float(w.w & 0xffff0000u)}; }
__device__ __forceinline__ f32x4 bf4lo(u32x4 w) { return (f32x4){__uint_as_float(w.x << 16), __uint_as_float(w.x & 0xffff0000u), __uint_as_float(w.y << 16), __uint_as_float(w.y & 0xffff0000u)}; }
__device__ __forceinline__ float sigmoidf_(float x) { return __builtin_amdgcn_rcpf(1.0f + __builtin_amdgcn_exp2f(-1.4426950408889634f * x)); }
__device__ __forceinline__ float siluf_(float x) { return x * sigmoidf_(x); }
__device__ __forceinline__ float gelu_tanh(float x) { const float u = 0.7978845608028654f * (x + 0.044715f * x * x * x); return x * sigmoidf_(2.0f * u); }
__device__ __forceinline__ float softplusf_(float x) { return fmaxf(x, 0.f) + log1pf(__expf(-fabsf(x))); }
#define SHX(v, o, lane) __int_as_float(__builtin_amdgcn_ds_bpermute((int)((((lane) ^ (o)) & 63) << 2), __float_as_int(v)))
#define SHIDX(v, idx) __builtin_amdgcn_ds_bpermute((int)((idx) << 2), (int)(v))
__device__ __forceinline__ float wave_sum_unused(float v) {
#pragma unroll
    for (int o = 1; o < 64; o <<= 1) v += __shfl_xor(v, o);
    return v;
}

#define LAS __attribute__((address_space(3)))
__device__ __forceinline__ void ph_mod(const Params& p, LAS float* lds, int blk, int nblk, int tid) {
    const int lane = tid & 63, w = tid >> 6;
    const float* c = p.in[1]; const float* aw = p.in[3]; const float* ab = p.in[4];
    float* mod = PB(WS_MOD, float);
    for (int i = tid; i < B_ * D_; i += 512) lds[i] = siluf_(c[i]);
    __syncthreads();
    LAS float* red = lds + B_ * D_;
    for (int item = blk; item < L_ * 96; item += nblk) {
        const int l = item / 96, n0 = (item % 96) * 64;
        float acc[8];
#pragma unroll
        for (int b = 0; b < 8; ++b) acc[b] = 0.f;
        const float* wp = aw + ((size_t)l * D_ + w * 128) * 6144 + n0 + lane;
#pragma unroll 1
        for (int k0 = 0; k0 < 128; k0 += 64) {
            float wv[64];
#pragma unroll
            for (int k = 0; k < 64; ++k) wv[k] = wp[(size_t)(k0 + k) * 6144];
#pragma unroll
            for (int k = 0; k < 64; ++k)
#pragma unroll
                for (int b = 0; b < 8; ++b) acc[b] += lds[b * D_ + w * 128 + k0 + k] * wv[k];
        }
#pragma unroll
        for (int b = 0; b < 8; ++b) red[(w * 8 + b) * 64 + lane] = acc[b];
        __syncthreads();
        {
            const int b = tid >> 6, n = tid & 63; float s = 0.f;
#pragma unroll
            for (int ww = 0; ww < 8; ++ww) s += red[(ww * 8 + b) * 64 + n];
            mod[((size_t)l * 8 + b) * 6144 + n0 + n] = s + ab[l * 6144 + n0 + n];
        }
        __syncthreads();
    }
}
__device__ __forceinline__ void ph_tables(const Params& p, int gt, int ngt) {
    const int* pos = (const int*)p.in[2];
    float* cs = PB(WS_COS, float); float* sn = PB(WS_SIN, float);
    for (int i = gt; i < T_ * 16; i += ngt) {
        const int t = i >> 4, j = i & 15;
        const float inv = 1.0f / powf(10000.0f, (float)(2 * j) / 32.0f);
        const float ang = (float)pos[t] * inv;
        float sv, cv; sincosf(ang, &sv, &cv); cs[i] = cv; sn[i] = sv;
    }
}
__device__ __forceinline__ void ph_zero_pads(const Params& p, int b0, int nb, int gt, int ngt) {
    bf16_t* up = PB(A_UP, bf16_t);
    for (int i = gt; i < nb * 4 * D_; i += ngt) {
        const int b = b0 + i / (4 * D_), r = (i / D_) & 3, c = i & (D_ - 1);
        const int row = (r < 2) ? r : (S_ + r);
        up[((size_t)b * SP + row) * D_ + c] = 0;
    }
}
__device__ __forceinline__ float wave_sum(float x) {
    x += __int_as_float(__builtin_amdgcn_update_dpp(0, __float_as_int(x), 0xB1, 0xF, 0xF, true));
    x += __int_as_float(__builtin_amdgcn_update_dpp(0, __float_as_int(x), 0x4E, 0xF, 0xF, true));
    x += __int_as_float(__builtin_amdgcn_update_dpp(0, __float_as_int(x), 0x141, 0xF, 0xF, true));
    x += __int_as_float(__builtin_amdgcn_update_dpp(0, __float_as_int(x), 0x140, 0xF, 0xF, true));
    { auto r = __builtin_amdgcn_permlane16_swap(__float_as_uint(x), __float_as_uint(x), false, false); x = __uint_as_float(r[0]) + __uint_as_float(r[1]); }
    { auto r = __builtin_amdgcn_permlane32_swap(__float_as_uint(x), __float_as_uint(x), false, false); x = __uint_as_float(r[0]) + __uint_as_float(r[1]); }
    return x;
}
__device__ __forceinline__ void ph_norm(const Params& p, int l, int sub, int row0, int nrows, int gw, int ngw, int lane, const LAS float* wlds = nullptr  ) {
    constexpr int RB = 4;
    const bool xf32 = (l == 0 && sub == 1); const float* __restrict__ xin = p.in[0]; bf16_t* __restrict__ X = PB(A_X, bf16_t);
    const bool combine = (sub == 1 && l > 0 && ((l - 1) & 1));
    const bool route = (sub == 2 && (l & 1));
    const float* __restrict__ g = p.in[sub == 1 ? 5 : 6] + l * D_;
    const float* __restrict__ mod = PB(WS_MOD, float);
    bf16_t* __restrict__ XN = PB(A_XN, bf16_t);
    const bf16_t* __restrict__ Y0 = PB(A_Y0, bf16_t); const bf16_t* __restrict__ Y1 = PB(A_Y1, bf16_t);
    unsigned* cnt = PB(WS_CTL, unsigned) + CW_CNT + (l >> 1) * 1024;
    int* list = PB(WS_LIST, int); float* tw = PB(WS_TW, float);
    const int step = ngw * RB, rend = row0 + nrows;
    int base = row0 + gw * RB; if (base >= rend) return;
    u32x4 raw[RB][2];
    if (!xf32) {
#pragma unroll
        for (int rr = 0; rr < RB; ++rr)
#pragma unroll
            for (int j = 0; j < 2; ++j) raw[rr][j] = *(const u32x4*)(X + (size_t)(base + rr) * D_ + 8 * lane + 512 * j);
    }
#pragma unroll 1
    for (;;) {
        const int b = base / S_;
        const float* mrow = mod + ((size_t)l * 8 + b) * 6144 + (sub == 1 ? 0 : 3072);
        f32x4 gs[4], sh[4];
#pragma unroll
        for (int q = 0; q < 4; ++q) { const int c0 = 8 * lane + 512 * (q >> 1) + 4 * (q & 1); const f32x4 gg = *(const f32x4*)(g + c0), sc = *(const f32x4*)(mrow + 1024 + c0); sh[q] = *(const f32x4*)(mrow + c0); gs[q] = gg * (sc + 1.0f); }
        f32x4 v[RB][4];
        if (xf32) {
#pragma unroll
            for (int rr = 0; rr < RB; ++rr)
#pragma unroll
                for (int q = 0; q < 4; ++q) v[rr][q] = *(const f32x4*)(xin + (size_t)(base + rr) * D_ + 8 * lane + 512 * (q >> 1) + 4 * (q & 1));
        } else {
#pragma unroll
            for (int rr = 0; rr < RB; ++rr)
#pragma unroll
                for (int j = 0; j < 2; ++j) { v[rr][2 * j] = bf4lo(raw[rr][j]); v[rr][2 * j + 1] = bf4hi(raw[rr][j]); }
        }
        const int nbase = base + step; const bool more = nbase < rend;
        if (more && !xf32) {
#pragma unroll
            for (int rr = 0; rr < RB; ++rr)
#pragma unroll
                for (int j = 0; j < 2; ++j) raw[rr][j] = *(const u32x4*)(X + (size_t)(nbase + rr) * D_ + 8 * lane + 512 * j);
        }
        if (combine) {
            const float* g2 = mod + ((size_t)(l - 1) * 8 + b) * 6144 + 5120;
#pragma unroll
            for (int rr = 0; rr < RB; ++rr)
#pragma unroll
                for (int j = 0; j < 2; ++j) {
                    const size_t o = (size_t)(base + rr) * D_ + 8 * lane + 512 * j;
                    const u32x4 ya = *(const u32x4*)(Y0 + o), yb = *(const u32x4*)(Y1 + o); const f32x4 ga = *(const f32x4*)(g2 + 8 * lane + 512 * j), gb = *(const f32x4*)(g2 + 8 * lane + 512 * j + 4);
                    v[rr][2 * j] = v[rr][2 * j] + ga * (bf4lo(ya) + bf4lo(yb)); v[rr][2 * j + 1] = v[rr][2 * j + 1] + gb * (bf4hi(ya) + bf4hi(yb));
                    *(u32x4*)(X + o) = pack8(v[rr][2 * j], v[rr][2 * j + 1]);
                }
        }
        float ss[RB];
#pragma unroll
        for (int rr = 0; rr < RB; ++rr) { ss[rr] = 0.f;
#pragma unroll
            for (int q = 0; q < 4; ++q) ss[rr] += (v[rr][q].x * v[rr][q].x + v[rr][q].y * v[rr][q].y) + (v[rr][q].z * v[rr][q].z + v[rr][q].w * v[rr][q].w); }
#pragma unroll
        for (int rr = 0; rr < RB; ++rr) ss[rr] = wave_sum(ss[rr]);
#pragma unroll
        for (int rr = 0; rr < RB; ++rr) {
            const float rstd = rsqrtf(ss[rr] * (1.0f / D_) + EPS);
#pragma unroll
            for (int q = 0; q < 4; ++q) v[rr][q] = v[rr][q] * rstd * gs[q] + sh[q];
#pragma unroll
            for (int j = 0; j < 2; ++j) *(u32x4*)(XN + (size_t)(base + rr) * D_ + 8 * lane + 512 * j) = pack8(v[rr][2 * j], v[rr][2 * j + 1]);
        }
        if (route) {
            float lg[RB][8];
#pragma unroll
            for (int rr = 0; rr < RB; ++rr)
#pragma unroll
                for (int e = 0; e < 8; ++e) lg[rr][e] = 0.f;
#pragma unroll
            for (int j = 0; j < 4; ++j)
#pragma unroll
                for (int i = 0; i < 4; ++i) {
                    const LAS f32x4* wp = (const LAS f32x4*)(wlds + ((j * 4 + i) * 64 + lane) * 8); const f32x4 w0 = wp[0], w1 = wp[1];
#pragma unroll
                    for (int rr = 0; rr < RB; ++rr) { const float hv = v[rr][j][i];
                        lg[rr][0] += hv * w0.x; lg[rr][1] += hv * w0.y; lg[rr][2] += hv * w0.z; lg[rr][3] += hv * w0.w;
                        lg[rr][4] += hv * w1.x; lg[rr][5] += hv * w1.y; lg[rr][6] += hv * w1.z; lg[rr][7] += hv * w1.w; }
                }
#pragma unroll
            for (int rr = 0; rr < RB; ++rr)
#pragma unroll
                for (int e = 0; e < 8; ++e) lg[rr][e] = wave_sum(lg[rr][e]);
            int ek[2 * RB]; float wk[2 * RB];
#pragma unroll
            for (int rr = 0; rr < RB; ++rr) {
                int i1 = 0; float v1 = lg[rr][0];
#pragma unroll
                for (int e = 1; e < 8; ++e) if (lg[rr][e] > v1) { v1 = lg[rr][e]; i1 = e; }
                int i2 = -1; float v2 = -3.0e38f;
#pragma unroll
                for (int e = 0; e < 8; ++e) if (e != i1 && lg[rr][e] > v2) { v2 = lg[rr][e]; i2 = e; }
                const float ex = __expf(v2 - v1), w1 = 1.0f / (1.0f + ex);
                ek[2 * rr] = i1; ek[2 * rr + 1] = i2; wk[2 * rr] = w1; wk[2 * rr + 1] = ex * w1;
            }
            unsigned nmine = 0;
#pragma unroll
            for (int k = 0; k < 2 * RB; ++k) nmine += (ek[k] == lane) ? 1u : 0u;
            unsigned bpos = 0;
            if (lane < NE && nmine) bpos = atomicAdd(cnt + 64 * lane, nmine);
            int myent = 0, mye = 0; unsigned mypos = 0; float myw = 0.f;
#pragma unroll
            for (int k = 0; k < 2 * RB; ++k) {
                unsigned rank = 0;
#pragma unroll
                for (int j = 0; j < k; ++j) rank += (ek[j] == ek[k]) ? 1u : 0u;
                const unsigned pos = (unsigned)SHIDX(bpos, ek[k]) + rank;
                if (lane == k) { myent = (base + (k >> 1)) * 2 + (k & 1); mye = ek[k]; mypos = pos; myw = wk[k]; }
            }
            if (lane < 2 * RB) { list[(size_t)mye * T_ + mypos] = myent; tw[myent] = myw; }
        }
        if (!more) break;
        base = nbase;
    }
}
__device__ __forceinline__ void ph_final(const Params& p, int gt, int ngt) {
    const float* __restrict__ mod = PB(WS_MOD, float); const bf16_t* __restrict__ Y0 = PB(A_Y0, bf16_t); const bf16_t* __restrict__ Y1 = PB(A_Y1, bf16_t); const bf16_t* __restrict__ X = PB(A_X, bf16_t);
    constexpr int U = 4, N8 = T_ * D_ / 8;
#pragma unroll 1
    for (int i0 = gt; i0 < N8; i0 += ngt * U) {
        u32x4 xw[U], ya[U], yb[U]; f32x4 g0[U], g1[U];
#pragma unroll
        for (int u = 0; u < U; ++u) { const int i = i0 + u * ngt; if (i < N8) { const int row = i >> 7, c0 = (i & 127) * 8, b = row / S_; const size_t o = (size_t)row * D_ + c0;
            const float* gp = mod + ((size_t)(L_ - 1) * 8 + b) * 6144 + 5120 + c0; g0[u] = *(const f32x4*)gp; g1[u] = *(const f32x4*)(gp + 4);
            xw[u] = *(const u32x4*)(X + o); ya[u] = *(const u32x4*)(Y0 + o); yb[u] = *(const u32x4*)(Y1 + o); } }
#pragma unroll
        for (int u = 0; u < U; ++u) { const int i = i0 + u * ngt; if (i < N8) { const size_t o = (size_t)i * 8;
            *(f32x4*)(p.out + o) = bf4lo(xw[u]) + g0[u] * (bf4lo(ya[u]) + bf4lo(yb[u])); *(f32x4*)(p.out + o + 4) = bf4hi(xw[u]) + g1[u] * (bf4hi(ya[u]) + bf4hi(yb[u])); } }
    }
}
__device__ __forceinline__ void ph_prep2(const Params& p, int l, int gw, int ngw, int lane) {
    constexpr int RB = 2;
    const bf16_t* __restrict__ QR = PB(A_QR, bf16_t); const bf16_t* __restrict__ KVR = PB(A_KVR, bf16_t); const float* __restrict__ KR = PB(A_KPE, float);
    const float* __restrict__ SSP = PB(WS_SSP, float);
    const float* __restrict__ cs = PB(WS_COS, float); const float* __restrict__ sn = PB(WS_SIN, float);
    bf16_t* __restrict__ Q = PB(A_Q, bf16_t); bf16_t* __restrict__ K = PB(A_K, bf16_t); bf16_t* __restrict__ V = PB(A_V, bf16_t);
    const int h = lane >> 3, sub = lane & 7, subq = sub < 6 ? sub : 0, subk = sub < 4 ? sub : 0, subp = (sub == 5) ? 1 : 0;
    float qg[16], kg[16];
#pragma unroll
    for (int i = 0; i < 16; ++i) { qg[i] = sub < 6 ? p.in[12][l * QKD + sub * 16 + i] : 0.f; kg[i] = sub < 6 ? p.in[13][l * QKD + sub * 16 + i] : 0.f; }
    for (int base = gw * RB; base < T_; base += ngw * RB) {
        u32x4 qa[RB][2], ka[RB][2], va[RB]; f32x4 kp[RB][4], cc[RB][4], sc[RB][4], sp[RB][2];
#pragma unroll
        for (int rr = 0; rr < RB; ++rr) { const size_t row = base + rr;
            qa[rr][0] = *(const u32x4*)(QR + row * 1024 + h * 128 + subq * 16); qa[rr][1] = *(const u32x4*)(QR + row * 1024 + h * 128 + subq * 16 + 8);
            ka[rr][0] = *(const u32x4*)(KVR + row * 1024 + h * 128 + subk * 16); ka[rr][1] = *(const u32x4*)(KVR + row * 1024 + h * 128 + subk * 16 + 8);
            va[rr] = *(const u32x4*)(KVR + row * 1024 + h * 128 + 64 + sub * 8);
            sp[rr][0] = *(const f32x4*)(SSP + row * 8); sp[rr][1] = *(const f32x4*)(SSP + row * 8 + 4);
#pragma unroll
            for (int i = 0; i < 4; ++i) { kp[rr][i] = *(const f32x4*)(KR + row * 32 + subp * 16 + 4 * i); cc[rr][i] = *(const f32x4*)(cs + row * 16 + 4 * i); sc[rr][i] = *(const f32x4*)(sn + row * 16 + 4 * i); } }
#pragma unroll
        for (int rr = 0; rr < RB; ++rr) { const int row = base + rr, b = row / S_, s = row % S_;
            const float rq = rsqrtf(((sp[rr][0].x + sp[rr][0].y) + (sp[rr][0].z + sp[rr][0].w)) * (1.0f / 256.0f) + EPS);
            const float rk = rsqrtf(((sp[rr][1].x + sp[rr][1].y) + (sp[rr][1].z + sp[rr][1].w)) * (1.0f / 256.0f) + EPS);
            float c16[16], s16[16], v[16];
#pragma unroll
            for (int i = 0; i < 4; ++i) { c16[4 * i] = cc[rr][i].x; c16[4 * i + 1] = cc[rr][i].y; c16[4 * i + 2] = cc[rr][i].z; c16[4 * i + 3] = cc[rr][i].w;
                s16[4 * i] = sc[rr][i].x; s16[4 * i + 1] = sc[rr][i].y; s16[4 * i + 2] = sc[rr][i].z; s16[4 * i + 3] = sc[rr][i].w; }
#pragma unroll
            for (int i = 0; i < 4; ++i) { v[2 * i] = __uint_as_float(qa[rr][0][i] << 16); v[2 * i + 1] = __uint_as_float(qa[rr][0][i] & 0xffff0000u); v[8 + 2 * i] = __uint_as_float(qa[rr][1][i] << 16); v[9 + 2 * i] = __uint_as_float(qa[rr][1][i] & 0xffff0000u); }
            {
                float o[16], ss = 0.f;
#pragma unroll
                for (int i = 0; i < 16; ++i) { const float x = (sub < 6) ? v[i] * rq : 0.f; const float pr = SHX(x, 1, lane);
                    o[i] = (sub == 4) ? (x * c16[i] - pr * s16[i]) : ((sub == 5) ? (pr * s16[i] + x * c16[i]) : x); ss += o[i] * o[i]; }
                ss += SHX(ss, 1, lane); ss += SHX(ss, 2, lane); ss += SHX(ss, 4, lane);
                const float rstd = rsqrtf(ss * (1.0f / QKD) + EPS) * QSCALE;
                if (sub < 6) {
                    u32x4 w0, w1;
#pragma unroll
                    for (int i = 0; i < 4; ++i) { w0[i] = pk2(o[2 * i] * rstd * qg[2 * i], o[2 * i + 1] * rstd * qg[2 * i + 1]); w1[i] = pk2(o[8 + 2 * i] * rstd * qg[8 + 2 * i], o[9 + 2 * i] * rstd * qg[9 + 2 * i]); }
                    bf16_t* dst = Q + (((size_t)b * H_ + h) * S_ + s) * QKD + sub * 16;
                    *(u32x4*)dst = w0; *(u32x4*)(dst + 8) = w1;
                }
            }
            {
                float kv[16], ss = 0.f;
#pragma unroll
                for (int i = 0; i < 4; ++i) { kv[2 * i] = __uint_as_float(ka[rr][0][i] << 16) * rk; kv[2 * i + 1] = __uint_as_float(ka[rr][0][i] & 0xffff0000u) * rk; kv[8 + 2 * i] = __uint_as_float(ka[rr][1][i] << 16) * rk; kv[9 + 2 * i] = __uint_as_float(ka[rr][1][i] & 0xffff0000u) * rk; }
                if (sub >= 4) {
#pragma unroll
                    for (int i = 0; i < 4; ++i) { kv[4 * i] = kp[rr][i].x; kv[4 * i + 1] = kp[rr][i].y; kv[4 * i + 2] = kp[rr][i].z; kv[4 * i + 3] = kp[rr][i].w; }
                }
#pragma unroll
                for (int i = 0; i < 16; ++i) { kv[i] = (sub < 6) ? kv[i] : 0.f; ss += kv[i] * kv[i]; }
                ss += SHX(ss, 1, lane); ss += SHX(ss, 2, lane); ss += SHX(ss, 4, lane);
                const float rstd = rsqrtf(ss * (1.0f / QKD) + EPS);
                if (sub < 6) {
                    u32x4 w0, w1;
#pragma unroll
                    for (int i = 0; i < 4; ++i) { w0[i] = pk2(kv[2 * i] * rstd * kg[2 * i], kv[2 * i + 1] * rstd * kg[2 * i + 1]); w1[i] = pk2(kv[8 + 2 * i] * rstd * kg[8 + 2 * i], kv[9 + 2 * i] * rstd * kg[9 + 2 * i]); }
                    bf16_t* dst = K + (((size_t)b * H_ + h) * S_ + s) * QKD + sub * 16;
                    *(u32x4*)dst = w0; *(u32x4*)(dst + 8) = w1;
                }
            }
            { u32x4 w;
#pragma unroll
              for (int i = 0; i < 4; ++i) w[i] = pk2(__uint_as_float(va[rr][i] << 16) * rk, __uint_as_float(va[rr][i] & 0xffff0000u) * rk);
              *(u32x4*)(V + (((size_t)b * H_ + h) * S_ + s) * VD + sub * 8) = w; }
        }
    }
}
__device__ __forceinline__ void ph_conv(const Params& p, int l, int gt, int ngt) {
    const bf16_t* __restrict__ UP = PB(A_UP, bf16_t); bf16_t* __restrict__ UC = PB(A_UC, bf16_t);
    const int c0 = (gt & 127) * 8;
    f32x4 cw[4][2], cb[2];
#pragma unroll
    for (int tap = 0; tap < 4; ++tap) { cw[tap][0] = *(const f32x4*)(p.in[15] + ((size_t)l * 4 + tap) * D_ + c0); cw[tap][1] = *(const f32x4*)(p.in[15] + ((size_t)l * 4 + tap) * D_ + c0 + 4); }
    cb[0] = *(const f32x4*)(p.in[16] + (size_t)l * D_ + c0); cb[1] = *(const f32x4*)(p.in[16] + (size_t)l * D_ + c0 + 4);
#pragma unroll 2
    for (int idx = gt; idx < T_ * 128; idx += ngt) {
        const int row = idx >> 7, b = row >> 11, s = row & (S_ - 1);
        const bf16_t* ur = UP + ((size_t)b * SP + s) * D_ + c0;
        u32x4 w[4];
#pragma unroll
        for (int tap = 0; tap < 4; ++tap) w[tap] = *(const u32x4*)(ur + (size_t)tap * D_);
        f32x4 lo = cb[0], hi = cb[1];
#pragma unroll
        for (int tap = 0; tap < 4; ++tap) {
            lo = lo + (f32x4){__uint_as_float(w[tap].x << 16), __uint_as_float(w[tap].x & 0xffff0000u), __uint_as_float(w[tap].y << 16), __uint_as_float(w[tap].y & 0xffff0000u)} * cw[tap][0];
            hi = hi + (f32x4){__uint_as_float(w[tap].z << 16), __uint_as_float(w[tap].z & 0xffff0000u), __uint_as_float(w[tap].w << 16), __uint_as_float(w[tap].w & 0xffff0000u)} * cw[tap][1]; }
        u32x4 o; o.x = pk2(lo.x, lo.y); o.y = pk2(lo.z, lo.w); o.z = pk2(hi.x, hi.y); o.w = pk2(hi.z, hi.w);
        *(u32x4*)(UC + (size_t)row * D_ + c0) = o;
    }
}
__device__ __forceinline__ void conv_slab(const Params& p, int l, int pm, int nb, int tid) {
    const bf16_t* __restrict__ UP = PB(A_UP, bf16_t); bf16_t* __restrict__ UC = PB(A_UC, bf16_t);
    const int c0 = nb * 128 + (tid & 15) * 8, b = pm >> 3, s0 = (pm & 7) * 256;
    f32x4 cw[4][2], cb[2];
#pragma unroll
    for (int tap = 0; tap < 4; ++tap) { cw[tap][0] = *(const f32x4*)(p.in[15] + ((size_t)l * 4 + tap) * D_ + c0); cw[tap][1] = *(const f32x4*)(p.in[15] + ((size_t)l * 4 + tap) * D_ + c0 + 4); }
    cb[0] = *(const f32x4*)(p.in[16] + (size_t)l * D_ + c0); cb[1] = *(const f32x4*)(p.in[16] + (size_t)l * D_ + c0 + 4);
    u32x4 w[8][4];
#pragma unroll
    for (int k = 0; k < 8; ++k) {
        const bf16_t* ur = UP + ((size_t)b * SP + s0 + (tid >> 4) + 32 * k) * D_ + c0;
#pragma unroll
        for (int tap = 0; tap < 4; ++tap) w[k][tap] = *(const u32x4*)(ur + (size_t)tap * D_);
    }
#pragma unroll
    for (int k = 0; k < 8; ++k) {
        const int r = (tid >> 4) + 32 * k;
        f32x4 lo = cb[0], hi = cb[1];
#pragma unroll
        for (int tap = 0; tap < 4; ++tap) { lo = lo + bf4lo(w[k][tap]) * cw[tap][0]; hi = hi + bf4hi(w[k][tap]) * cw[tap][1]; }
        *(u32x4*)(UC + (size_t)(pm * 256 + r) * D_ + c0) = pack8(lo, hi);
    }
}
constexpr int SCH = 32, NCH = S_ / SCH;
__device__ __forceinline__ void ph_scan(const Params& p, int l, LAS unsigned char* lds, int i0, int iend, int istep, int tid) {
    const unsigned* __restrict__ LB = PB(A_LAB, unsigned); const unsigned short* __restrict__ LR = PB(A_LR, unsigned short); const float* __restrict__ SPT = PB(WS_GB, float) + L_ * 4096 + (size_t)l * 2 * D_; const bf16_t* __restrict__ YG = PB(A_YG, bf16_t); bf16_t* __restrict__ HL = PB(A_HLO, bf16_t);
    LAS f32x4* AG = (LAS f32x4*)lds;
    const int lane = tid & 63, wave = tid >> 6, c32 = lane & 31, seg = wave * 2 + (lane >> 5);
#pragma unroll 1
    for (int item = i0; item < iend; item += istep) {
        const int b = item >> 5, ch = (item & 31) * 32 + c32;
        const size_t r0 = (size_t)b * S_ + (size_t)seg * 128;
        const float spf = SPT[ch] * (1.0f / 255.0f), spb = SPT[D_ + ch] * (1.0f / 255.0f);
        f32x4 mine[4];
#pragma unroll 1
        for (int q = 0; q < 4; ++q) {
            unsigned wb[SCH]; unsigned wr[SCH];
#pragma unroll
            for (int t = 0; t < SCH; ++t) { wb[t] = LB[(r0 + q * SCH + t) * D_ + ch]; wr[t] = LR[(r0 + q * SCH + t) * D_ + ch]; }
            float Af = 0.f, Hf = 0.f, Ab = 0.f, Hb = 0.f, Pb = 1.f;
#pragma unroll
            for (int t = 0; t < SCH; ++t) {
                const float laf = (float)(wr[t] & 0xffu) * spf, lab = (float)(wr[t] >> 8) * spb;
                const float af = __expf(laf), ab = __expf(lab);
                float bfv = __uint_as_float(wb[t] << 16), bbv = __uint_as_float(wb[t] & 0xffff0000u);
                if (!(seg == 0 && q == 0 && t == 0)) bfv *= __builtin_amdgcn_sqrtf(fmaxf(1.0f - af * af, 0.f));
                if (!(seg == 15 && q == 3 && t == SCH - 1)) bbv *= __builtin_amdgcn_sqrtf(fmaxf(1.0f - ab * ab, 0.f));
                Hf = af * Hf + bfv; Af += laf;
                Hb += Pb * bbv; Pb *= ab; Ab += lab;
            }
            const f32x4 a = (f32x4){__expf(Af), Hf, __expf(Ab), Hb};
            AG[(seg * 4 + q) * 32 + c32] = a;
            if (q == 0) mine[0] = a; else if (q == 1) mine[1] = a; else if (q == 2) mine[2] = a; else mine[3] = a;
        }
        __syncthreads();
        float hf = 0.f, hbin[4];
        for (int cc = 0; cc < seg * 4; ++cc) { const f32x4 a = AG[cc * 32 + c32]; hf = a.x * hf + a.y; }
        { float hb = 0.f;
          for (int cc = NCH - 1; cc >= seg * 4 + 4; --cc) { const f32x4 a = AG[cc * 32 + c32]; hb = a.z * hb + a.w; }
          hbin[3] = hb; hb = mine[3].z * hb + mine[3].w; hbin[2] = hb; hb = mine[2].z * hb + mine[2].w; hbin[1] = hb; hb = mine[1].z * hb + mine[1].w; hbin[0] = hb; }
#pragma unroll 1
        for (int q = 0; q < 4; ++q) {
            unsigned wb[SCH]; unsigned wr[SCH]; float hfv[SCH]; bf16_t yg[SCH];
#pragma unroll
            for (int t = 0; t < SCH; ++t) { wb[t] = LB[(r0 + q * SCH + t) * D_ + ch]; wr[t] = LR[(r0 + q * SCH + t) * D_ + ch]; yg[t] = YG[(r0 + q * SCH + t) * D_ + ch]; }
#pragma unroll
            for (int t = 0; t < SCH; ++t) { const float af = __expf((float)(wr[t] & 0xffu) * spf); float bfv = __uint_as_float(wb[t] << 16);
                if (!(seg == 0 && q == 0 && t == 0)) bfv *= __builtin_amdgcn_sqrtf(fmaxf(1.0f - af * af, 0.f));
                hf = af * hf + bfv; hfv[t] = hf; }
            float hb = (q == 0) ? hbin[0] : (q == 1) ? hbin[1] : (q == 2) ? hbin[2] : hbin[3];
#pragma unroll
            for (int t = SCH - 1; t >= 0; --t) {
                const float ab = __expf((float)(wr[t] >> 8) * spb); float bbv = __uint_as_float(wb[t] & 0xffff0000u);
                if (!(seg == 15 && q == 3 && t == SCH - 1)) bbv *= __builtin_amdgcn_sqrtf(fmaxf(1.0f - ab * ab, 0.f));
                hb = ab * hb + bbv;
                HL[(r0 + q * SCH + t) * LDHLO + ch] = f2bf((hfv[t] + hb) * bf2f(yg[t]));
            }
        }
        __syncthreads();
    }
}

typedef short bf16x8 __attribute__((ext_vector_type(8)));
#define LDS_WAIT() asm volatile("s_waitcnt lgkmcnt(0)" ::: "memory")

constexpr size_t WE_WIN = 0;
constexpr size_t WE_WQKV = WE_WIN + (size_t)L_ * 4864 * 1024;
constexpr size_t WE_WG = WE_WQKV + (size_t)L_ * 2048 * 256;
constexpr size_t WE_WCAT = WE_WG + (size_t)L_ * 4096 * 512;
constexpr size_t WE_WOUT = WE_WCAT + (size_t)L_ * 1024 * 1536;
constexpr size_t WE_FGU = WE_WOUT + (size_t)L_ * 1024 * 1024;
constexpr size_t WE_FD = WE_FGU + (size_t)2 * 5632 * 1024;
constexpr size_t WE_MGU = WE_FD + (size_t)2 * 1024 * 2816;
constexpr size_t WE_MD = WE_MGU + (size_t)16 * 5632 * 1024;
constexpr size_t WE_END = WE_MD + (size_t)16 * 1024 * 2816;
static_assert(WS_WEI + WE_END * 2 <= WS_AR, "weights region");
static_assert(CW_BAR + 3456 <= CW_CNT && CW_CNT + 2048 <= CW_LBAR && (size_t)(CW_LBAR + 2048) * 4 <= CTL_BYTES, "control words inside the per-call memset");


namespace pg8 {
constexpr int BM = 256, BK = 64, HALF = 128, HTB = HALF * BK * 2, STAGE_BYTES = 8 * HTB, NXCD = 8, WGM = 8;
__host__ __device__ __forceinline__ int lds_byte(int r, int c) { const int st = (r >> 4) * 2 + (c >> 5), rr = r & 15, cc = c & 31, ob = rr * 64 + cc * 2; return st * 1024 + (ob ^ (((ob >> 9) & 1) << 5)); }
__host__ __device__ __forceinline__ void stage_rc(int b, int& R, int& C) { const int st = b / 1024, sb = b % 1024, swz = sb ^ (((sb >> 9) & 1) << 5); R = (st >> 1) * 16 + swz / 64; C = (st & 1) * 32 + (swz % 64) / 2; }
__host__ __device__ __forceinline__ int perm32(int rho) { const int n = rho >> 4, i = rho & 15; return 8 * (i >> 2) + 4 * n + (i & 3); }

struct Unit { int pm, pn; const char* A; const char* B; int aux; int nt; };
struct GemmCfg { int lda, ldb, K; unsigned apair; };

struct TileOrder {
    int nM, nN, nwg, G, c;
    __device__ __forceinline__ void init(int nM_, int nN_, int G_, int c_) { nM = nM_; nN = nN_; nwg = nM * nN; G = G_; c = c_; }
    __device__ __forceinline__ bool tile(int i, int& pm, int& pn) const {
        const long L = (long)i * G + c; if (L >= nwg) return false;
        int wgid = (int)L; { const int q = nwg / NXCD, r = nwg % NXCD, xcd = wgid % NXCD, off = wgid / NXCD; wgid = (xcd < r ? xcd * (q + 1) : r * (q + 1) + (xcd - r) * q) + off; }
        const int nig = WGM * nN, gid = wgid / nig, fm = gid * WGM, gsz = (nM - fm) < WGM ? (nM - fm) : WGM;
        pm = fm + ((wgid % nig) % gsz); pn = (wgid % nig) / gsz; return true;
    }
};
struct StdOrder {
    TileOrder T; const char* A0; const char* B0; unsigned astep, bstep; int nt;
    __device__ __forceinline__ void init(int nM, int nN, int G, int c, const void* A, const void* B, int lda, int ldb, int K) { T.init(nM, nN, G, c); nt = K / BK; A0 = (const char*)A; B0 = (const char*)B; astep = (unsigned)(BM * lda * 2); bstep = (unsigned)(BM * ldb * 2); }
    __device__ __forceinline__ bool next(int i, Unit& u) const { if (!T.tile(i, u.pm, u.pn)) return false; u.A = A0 + (size_t)u.pm * astep; u.B = B0 + (size_t)u.pn * bstep; u.aux = 0; u.nt = nt; return true; }
    __device__ __forceinline__ unsigned row_off(int, int) const { return 0u; }
};

#define PG8_SA(b, h) (((b) * 2 + (h)) * HTB)
#define PG8_SB(b, h) ((4 + (b) * 2 + (h)) * HTB)
#define PG8_GLDS(gp, lp) __builtin_amdgcn_global_load_lds((const unsigned*)(gp), (LAS unsigned*)(lp), 16, 0, 0)
#define PG8_STAGE_B(bufoff, gbase) do { _Pragma("unroll") for (int _i = 0; _i < 2; ++_i) PG8_GLDS((gbase) + voffB[_i], lds + (bufoff) + ldsw + _i * 8192); } while (0)
#define PG8_STAGE_A(bufoff, gbase, h, nx) do { _Pragma("unroll") for (int _i = 0; _i < 2; ++_i) PG8_GLDS((gbase) + ((GATHER && (nx)) ? vAn[h][_i] : vA[h][_i]), lds + (bufoff) + ldsw + _i * 8192); } while (0)
#define PG8_LDA(dst, b, h) do { _Pragma("unroll") for (int m = 0; m < 4; ++m) _Pragma("unroll") for (int k = 0; k < 2; ++k) dst[m][k] = *(const LAS bf16x8*)(lds + PG8_SA(b, h) + aoff + m * 2048 + k * 1024); } while (0)
#define PG8_LDB(dst, b, h) do { _Pragma("unroll") for (int n = 0; n < 2; ++n) _Pragma("unroll") for (int k = 0; k < 2; ++k) dst[n][k] = *(const LAS bf16x8*)(lds + PG8_SB(b, h) + boff + n * 2048 + k * 1024); } while (0)
#define PG8_MMA(ai, bj, At, Bt) do { __builtin_amdgcn_s_setprio(1); _Pragma("unroll") for (int m = 0; m < 4; ++m) _Pragma("unroll") for (int n = 0; n < 2; ++n) _Pragma("unroll") for (int k = 0; k < 2; ++k) \
        acc[ai][bj][m][n] = __builtin_amdgcn_mfma_f32_16x16x32_bf16(Bt[n][k], At[m][k], acc[ai][bj][m][n], 0, 0, 0); __builtin_amdgcn_s_setprio(0); } while (0)
#define PG8_WAIT_V(n) asm volatile("s_waitcnt vmcnt(" #n ")" ::: "memory")
#define PG8_WAIT_L(n) asm volatile("s_waitcnt lgkmcnt(" #n ")" ::: "memory")
#define PG8_BAR __builtin_amdgcn_s_barrier()
#define PG8_SCHED __builtin_amdgcn_sched_barrier(0)

template <class Epi, class Sched, bool ALIGN_EPI, bool GATHER>
__device__ __forceinline__ void gemm_phase(LAS unsigned char* lds, const GemmCfg g, const Sched& S, const Epi& E, int tid_in) {
    int tid = tid_in; asm volatile("" : "+v"(tid));
    const int wid = __builtin_amdgcn_readfirstlane(tid >> 6), lane = tid & 63, wr = wid >> 2, wc = wid & 3, fr = lane & 15, fq = lane >> 4;
    unsigned voffB[2], vA[2][2], vAn[2][2]; int Rr[2], Cc[2];
#pragma unroll
    for (int i = 0; i < 2; ++i) { int R, C; stage_rc(tid * 16 + i * 8192, R, C); Rr[i] = R; Cc[i] = C; const int Rb = Epi::PERM ? ((R & ~31) + perm32(R & 31)) : R;
        voffB[i] = (unsigned)(Rb * g.ldb + C) * 2u;
#pragma unroll
        for (int h = 0; h < 2; ++h) { vA[h][i] = (unsigned)((h * HALF + R) * g.lda + C) * 2u; vAn[h][i] = vA[h][i]; } }
    const unsigned hstepB = (unsigned)(HALF * g.ldb * 2);
    const unsigned apair = g.apair;
    const unsigned ldsw = (unsigned)wid * 1024u;
    const int aoff = lds_byte(wr * 64 + fr, fq * 8), boff = lds_byte(wc * 32 + fr, fq * 8);
    Unit cur, nxt; int ui = 0;
    if (!S.next(0, cur)) return;
    if constexpr (GATHER) {
#pragma unroll
        for (int i = 0; i < 2; ++i)
#pragma unroll
            for (int h = 0; h < 2; ++h) { vA[h][i] = S.row_off(0, h * HALF + Rr[i]) + (unsigned)Cc[i] * 2u; vAn[h][i] = vA[h][i]; }
    }
    f32x4 acc[2][2][4][2];
#pragma unroll
    for (int a = 0; a < 2; ++a)
#pragma unroll
        for (int b = 0; b < 2; ++b)
#pragma unroll
            for (int m = 0; m < 4; ++m)
#pragma unroll
                for (int n = 0; n < 2; ++n) acc[a][b][m][n] = (f32x4){0.f, 0.f, 0.f, 0.f};
    bf16x8 At[4][2], B0[2][2], B1[2][2];
    const char* cA = cur.A; const char* cB = cur.B;
    PG8_STAGE_B(PG8_SB(0, 0), cB); PG8_STAGE_B(PG8_SB(0, 1), cB + hstepB); PG8_STAGE_A(PG8_SA(0, 0), cA, 0, false); PG8_STAGE_A(PG8_SA(0, 1), cA, 1, false);
    if (wr == 1) PG8_BAR;
    PG8_WAIT_V(2); PG8_BAR;
    PG8_STAGE_B(PG8_SB(1, 0), cB + 128); PG8_STAGE_A(PG8_SA(1, 0), cA + 128, 0, false); PG8_STAGE_B(PG8_SB(1, 1), cB + hstepB + 128);
    PG8_WAIT_V(6); PG8_BAR;
#pragma unroll 1
    for (;;) {
        const bool has_next = S.next(ui + 1, nxt);
        if constexpr (GATHER) { if (has_next) {
#pragma unroll
            for (int i = 0; i < 2; ++i)
#pragma unroll
                for (int h = 0; h < 2; ++h) vAn[h][i] = S.row_off(ui + 1, h * HALF + Rr[i]) + (unsigned)Cc[i] * 2u; } }
        const char* nA = has_next ? nxt.A : cA; const char* nB = has_next ? nxt.B : cB;
        int nt = cur.nt; asm volatile("" : "+s"(nt));
#pragma unroll 1
        for (int t = 0; t < nt; t += 2) {
            const bool last = (t == nt - 2);
            const char* ab = cA + (size_t)(t >> 1) * apair;
            const char* a1 = ab + 128;
            const char* a2 = last ? nA : ab + apair; const char* b2 = last ? nB : cB + (size_t)(t + 2) * 128;
            const char* a3 = a2 + 128; const char* b3 = b2 + 128;
            PG8_LDB(B0, 0, 0); PG8_LDB(B1, 0, 1); PG8_SCHED; PG8_LDA(At, 0, 0); PG8_STAGE_A(PG8_SA(1, 1), a1, 1, false);
            PG8_WAIT_V(8); PG8_WAIT_L(0); PG8_BAR; PG8_MMA(0, 0, At, B0); PG8_MMA(0, 1, At, B1); PG8_BAR; PG8_SCHED;
            PG8_LDA(At, 0, 1); PG8_STAGE_B(PG8_SB(0, 0), b2); PG8_STAGE_B(PG8_SB(0, 1), b2 + hstepB); PG8_STAGE_A(PG8_SA(0, 0), a2, 0, last);
            PG8_WAIT_V(8); PG8_WAIT_L(0); PG8_BAR; PG8_MMA(1, 0, At, B0); PG8_MMA(1, 1, At, B1); PG8_BAR; PG8_SCHED;
            PG8_LDB(B0, 1, 0); PG8_LDB(B1, 1, 1); PG8_SCHED; PG8_LDA(At, 1, 0); PG8_STAGE_A(PG8_SA(0, 1), a2, 1, last);
            PG8_WAIT_V(8); PG8_WAIT_L(0); PG8_BAR; PG8_MMA(0, 0, At, B0); PG8_MMA(0, 1, At, B1); PG8_BAR; PG8_SCHED;
            PG8_LDA(At, 1, 1); PG8_STAGE_B(PG8_SB(1, 0), b3); PG8_STAGE_B(PG8_SB(1, 1), b3 + hstepB); PG8_STAGE_A(PG8_SA(1, 0), a3, 0, last);
            PG8_WAIT_V(8); PG8_WAIT_L(0); PG8_BAR; PG8_MMA(1, 0, At, B0); PG8_MMA(1, 1, At, B1); PG8_BAR; PG8_SCHED;
        }
        if constexpr (ALIGN_EPI) { if (wr == 0) PG8_BAR; }
        E(acc, cur, wr, wc, fr, fq);
        if (!has_next) break;
        if (!(cur.aux & (1 << 30)))
#pragma unroll
        for (int a = 0; a < 2; ++a)
#pragma unroll
            for (int b = 0; b < 2; ++b)
#pragma unroll
                for (int m = 0; m < 4; ++m)
#pragma unroll
                    for (int n = 0; n < 2; ++n) acc[a][b][m][n] = (f32x4){0.f, 0.f, 0.f, 0.f};
        cur = nxt; cA = nA; cB = nB; ++ui;
        if constexpr (GATHER) {
#pragma unroll
            for (int i = 0; i < 2; ++i)
#pragma unroll
                for (int h = 0; h < 2; ++h) vA[h][i] = vAn[h][i]; }
        if constexpr (ALIGN_EPI) { if (wr == 1) PG8_BAR; }
    }
    PG8_WAIT_V(0);
    if constexpr (!ALIGN_EPI) { if (wr == 0) PG8_BAR; }
    PG8_BAR;
}
}
using pg8::Unit;
typedef f32x4 AccT[2][2][4][2];

__device__ __forceinline__ f32x4 sig4(f32x4 v) { f32x4 o; o.x = sigmoidf_(v.x); o.y = sigmoidf_(v.y); o.z = sigmoidf_(v.z); o.w = sigmoidf_(v.w); return o; }
__device__ __forceinline__ f32x4 gelu4(f32x4 v) { f32x4 o; o.x = gelu_tanh(v.x); o.y = gelu_tanh(v.y); o.z = gelu_tanh(v.z); o.w = gelu_tanh(v.w); return o; }
__device__ __forceinline__ f32x4 unpack4(u32x2 w) { return (f32x4){__uint_as_float(w.x << 16), __uint_as_float(w.x & 0xffff0000u), __uint_as_float(w.y << 16), __uint_as_float(w.y & 0xffff0000u)}; }

struct EpiWin { static constexpr bool PERM = true; Params p;
    __device__ __forceinline__ void operator()(AccT& acc, const Unit& u, int wr, int wc, int fr, int fq) const {
        const int pn = u.pn, row0 = u.pm * 256 + wr * 64 + fr, cl = wc * 32 + fq * 8;
        if (pn == 18) {
            if (wc == 0) { float* KPE = PB(A_KPE, float); float* KRSS = PB(WS_KRSS, float); const float* cs = PB(WS_COS, float); const float* sn = PB(WS_SIN, float);
                const int lane = fq * 16 + fr, ci = (fq & 1) * 8;
#pragma unroll
                for (int ai = 0; ai < 2; ++ai) {
                    f32x4 cst[4][4];
#pragma unroll
                    for (int m = 0; m < 4; ++m) { const size_t row = row0 + ai * 128 + m * 16;
                        cst[m][0] = *(const f32x4*)(cs + row * 16 + ci); cst[m][1] = *(const f32x4*)(cs + row * 16 + ci + 4); cst[m][2] = *(const f32x4*)(sn + row * 16 + ci); cst[m][3] = *(const f32x4*)(sn + row * 16 + ci + 4); }
#pragma unroll
                    for (int m = 0; m < 4; ++m) { const size_t row = row0 + ai * 128 + m * 16; const f32x4 a0 = acc[ai][0][m][0], a1 = acc[ai][0][m][1];
                        f32x4 p0, p1;
#pragma unroll
                        for (int j = 0; j < 4; ++j) { p0[j] = SHX(a0[j], 32, lane); p1[j] = SHX(a1[j], 32, lane); }
                        const f32x4 c0 = cst[m][0], c1 = cst[m][1], s0 = cst[m][2], s1 = cst[m][3];
                        f32x4 o0, o1;
                        if (fq < 2) { o0 = a0 * c0 - p0 * s0; o1 = a1 * c1 - p1 * s1; } else { o0 = p0 * s0 + a0 * c0; o1 = p1 * s1 + a1 * c1; }
                        float ssq = ((a0.x * a0.x + a0.y * a0.y) + (a0.z * a0.z + a0.w * a0.w)) + ((a1.x * a1.x + a1.y * a1.y) + (a1.z * a1.z + a1.w * a1.w));
                        ssq += SHX(ssq, 16, lane); ssq += SHX(ssq, 32, lane);
                        if (fq == 0) KRSS[row] = ssq;
                        *(f32x4*)(KPE + row * 32 + fq * 8) = o0; *(f32x4*)(KPE + row * 32 + fq * 8 + 4) = o1; } } }
            return;
        }
        bf16_t* base; int ld, act = 0; bool rmap = false;
        if (pn < 2) { base = PB(A_CQKV, bf16_t) + pn * 256; ld = 512;
            float* SSP = PB(WS_SSP, float);
#pragma unroll
            for (int ai = 0; ai < 2; ++ai)
#pragma unroll
                for (int m = 0; m < 4; ++m) { float ssq = 0.f;
#pragma unroll
                    for (int bj = 0; bj < 2; ++bj)
#pragma unroll
                        for (int n = 0; n < 2; ++n) { const f32x4 x = acc[ai][bj][m][n]; ssq += (x.x * x.x + x.y * x.y) + (x.z * x.z + x.w * x.w); }
                    ssq += SHX(ssq, 16, fq * 16 + fr); ssq += SHX(ssq, 32, fq * 16 + fr);
                    if (fq == 0) SSP[(size_t)(row0 + ai * 128 + m * 16) * 8 + pn * 4 + wc] = ssq; } }
        else if (pn < 6) { base = PB(A_UP, bf16_t) + (pn - 2) * 256; ld = 1024; rmap = true; }
        else if (pn < 10) { base = PB(A_YG, bf16_t) + (pn - 6) * 256; ld = 1024; act = 1; }
        else { base = nullptr; ld = 2048; act = 2; }
#pragma unroll
        for (int ai = 0; ai < 2; ++ai)
#pragma unroll
            for (int m = 0; m < 4; ++m) { const int row = row0 + ai * 128 + m * 16; const size_t rr = rmap ? (size_t)(row + (row >> 11) * 4 + 2) : (size_t)row;
#pragma unroll
                for (int bj = 0; bj < 2; ++bj) { f32x4 v0 = acc[ai][bj][m][0], v1 = acc[ai][bj][m][1];
                    if (act == 2) { v0 = sig4(v0) * 255.0f + 0.5f; v1 = sig4(v1) * 255.0f + 0.5f;
#pragma unroll
                        for (int j = 0; j < 4; ++j) { v0[j] = fmaxf(v0[j], 1.0f); v1[j] = fmaxf(v1[j], 1.0f); }
                        u32x2 q; q.x = (unsigned)v0.x | ((unsigned)v0.y << 8) | ((unsigned)v0.z << 16) | ((unsigned)v0.w << 24); q.y = (unsigned)v1.x | ((unsigned)v1.y << 8) | ((unsigned)v1.z << 16) | ((unsigned)v1.w << 24);
                        *(u32x2*)(PB(A_G, unsigned char) + rr * 2048 + (pn - 10) * 256 + bj * 128 + cl) = q; continue; }
                    if (act == 1) { v0 = gelu4(v0); v1 = gelu4(v1); }
                    *(u32x4*)(base + rr * ld + bj * 128 + cl) = pack8(v0, v1); } }
    } };
struct EpiRes { static constexpr bool PERM = true; const float* xf32; bf16_t* X; const float* gate  ;
    __device__ __forceinline__ void operator()(AccT& acc, const Unit& u, int wr, int wc, int fr, int fq) const {
        const int row0 = u.pm * 256 + wr * 64 + fr, c0 = u.pn * 256 + wc * 32 + fq * 8; const float* gr = gate + (size_t)(u.pm >> 3) * 6144;
        f32x4 gv[2][2];
#pragma unroll
        for (int bj = 0; bj < 2; ++bj)
#pragma unroll
            for (int n = 0; n < 2; ++n) gv[bj][n] = *(const f32x4*)(gr + c0 + bj * 128 + n * 4);
#pragma unroll
        for (int ai = 0; ai < 2; ++ai)
#pragma unroll
            for (int m = 0; m < 4; ++m) { const size_t row = row0 + ai * 128 + m * 16;
#pragma unroll
                for (int bj = 0; bj < 2; ++bj) { const size_t o = row * D_ + c0 + bj * 128; f32x4 x0, x1;
                    if (xf32) { x0 = *(const f32x4*)(xf32 + o); x1 = *(const f32x4*)(xf32 + o + 4); }
                    else { const u32x4 w = *(const u32x4*)(X + o); x0 = unpack4((u32x2){w.x, w.y}); x1 = unpack4((u32x2){w.z, w.w}); }
                    *(u32x4*)(X + o) = pack8(x0 + gv[bj][0] * acc[ai][bj][m][0], x1 + gv[bj][1] * acc[ai][bj][m][1]); } }
    } };
struct EpiUp { static constexpr bool PERM = true; bf16_t* HID;
    __device__ __forceinline__ void operator()(AccT& acc, const Unit& u, int wr, int wc, int fr, int fq) const {
        const int row0 = u.pm * 256 + wr * 64 + fr, c0 = u.pn * 128 + wc * 32 + fq * 8;
#pragma unroll
        for (int ai = 0; ai < 2; ++ai)
#pragma unroll
            for (int m = 0; m < 4; ++m) { const size_t row = row0 + ai * 128 + m * 16; f32x4 h0, h1;
                { const f32x4 a = acc[ai][0][m][0], b = acc[ai][1][m][0]; h0 = (f32x4){siluf_(a.x) * b.x, siluf_(a.y) * b.y, siluf_(a.z) * b.z, siluf_(a.w) * b.w}; }
                { const f32x4 a = acc[ai][0][m][1], b = acc[ai][1][m][1]; h1 = (f32x4){siluf_(a.x) * b.x, siluf_(a.y) * b.y, siluf_(a.z) * b.z, siluf_(a.w) * b.w}; }
                *(u32x4*)(HID + row * FF + c0) = pack8(h0, h1); }
    } };
struct EpiGates { static constexpr bool PERM = false; Params p; int l;
    __device__ __forceinline__ void operator()(AccT& acc, const Unit& u, int wr, int wc, int fr, int fq) const {
        const int pn = u.pn, ch0 = (pn >> 1) * 128 + (pn & 1) * 64 + 16 * wc + 4 * fq;
        const float* GB = PB(WS_GB, float) + (size_t)l * 4096 + pn * 256 + 32 * wc + 4 * fq;
        const float* SPT = PB(WS_GB, float) + L_ * 4096 + (size_t)l * 2 * D_ + ch0;
        const bf16_t* UC = PB(A_UC, bf16_t); unsigned* LB = PB(A_LAB, unsigned); unsigned short* LR = PB(A_LR, unsigned short);
        const int rowb = u.pm * 256 + wr * 64 + fr;
        f32x4 bias[2][2];
#pragma unroll
        for (int dir = 0; dir < 2; ++dir) { bias[dir][0] = *(const f32x4*)(GB + 128 * dir); bias[dir][1] = *(const f32x4*)(GB + 128 * dir + 16); }
        u32x2 ur[2][4];
#pragma unroll
        for (int ai = 0; ai < 2; ++ai)
#pragma unroll
            for (int m = 0; m < 4; ++m) ur[ai][m] = *(const u32x2*)(UC + (size_t)(rowb + ai * 128 + m * 16) * D_ + ch0);
#pragma unroll
        for (int ai = 0; ai < 2; ++ai) {
#pragma unroll
            for (int m = 0; m < 4; ++m) { const int row = rowb + ai * 128 + m * 16;
                const f32x4 uc = unpack4(ur[ai][m]);
                float bv[2][4]; unsigned rq[2][4];
#pragma unroll
                for (int dir = 0; dir < 2; ++dir) { const f32x4 xr = acc[ai][dir][m][0] + bias[dir][0], xi = acc[ai][dir][m][1] + bias[dir][1];
#pragma unroll
                    for (int j = 0; j < 4; ++j) { const float r = __builtin_amdgcn_rcpf(1.0f + __builtin_amdgcn_exp2f(xr[j])), ig = __builtin_amdgcn_rcpf(1.0f + __builtin_amdgcn_exp2f(xi[j])); rq[dir][j] = (unsigned)(r * 255.0f + 0.5f); bv[dir][j] = ig * uc[j]; } }
                const size_t eo = (size_t)row * D_ + ch0;
                *(u32x4*)(LB + eo) = (u32x4){cvt_pk_bf16(bv[0][0], bv[1][0]), cvt_pk_bf16(bv[0][1], bv[1][1]), cvt_pk_bf16(bv[0][2], bv[1][2]), cvt_pk_bf16(bv[0][3], bv[1][3])};
                *(u32x2*)(LR + eo) = (u32x2){rq[0][0] | (rq[1][0] << 8) | (rq[0][1] << 16) | (rq[1][1] << 24), rq[0][2] | (rq[1][2] << 8) | (rq[0][3] << 16) | (rq[1][3] << 24)}; }
            asm volatile("" ::: "memory");
        }
    } };
struct QkvOrder {
    pg8::TileOrder T; const char* A0; const char* B0;
    __device__ __forceinline__ void init(int G, int c, const void* cqkv, const void* w) { T.init(64, 8, G, c); A0 = (const char*)cqkv; B0 = (const char*)w; }
    __device__ __forceinline__ bool next(int i, Unit& u) const { if (!T.tile(i, u.pm, u.pn)) return false;
        u.A = A0 + (size_t)u.pm * (256 * 512 * 2) + ((u.pn >> 2) ? 512 : 0); u.B = B0 + (size_t)u.pn * (256 * 256 * 2); u.aux = 0; u.nt = 4; return true; }
    __device__ __forceinline__ unsigned row_off(int, int) const { return 0u; }
};
struct EpiQkv { static constexpr bool PERM = true; bf16_t* QR; bf16_t* KVR;
    __device__ __forceinline__ void operator()(AccT& acc, const Unit& u, int wr, int wc, int fr, int fq) const {
        bf16_t* O = (u.pn >> 2) ? KVR : QR; const int row0 = u.pm * 256 + wr * 64 + fr, c0 = (u.pn & 3) * 256 + wc * 32 + fq * 8;
#pragma unroll
        for (int ai = 0; ai < 2; ++ai)
#pragma unroll
            for (int m = 0; m < 4; ++m) { bf16_t* rp = O + (size_t)(row0 + ai * 128 + m * 16) * 1024 + c0;
#pragma unroll
                for (int bj = 0; bj < 2; ++bj) *(u32x4*)(rp + bj * 128) = pack8(acc[ai][bj][m][0], acc[ai][bj][m][1]); }
    } };
struct EpiQkvF { static constexpr bool PERM = true; Params p; int l; LAS float* P;
    __device__ __forceinline__ void operator()(AccT& acc, const Unit& u, int wr, int wc, int fr, int fq) const {
        const int lane = fq * 16 + fr; const bool isq = u.pn < 4; const int h0 = (u.pn & 3) * 2, b = u.pm >> 3;
        const int rowb = u.pm * 256 + wr * 64 + fr, rloc = wr * 64 + fr;
        const float* SSP = PB(WS_SSP, float) + (isq ? 0 : 4);
#pragma unroll
        for (int ai = 0; ai < 2; ++ai)
#pragma unroll
            for (int m = 0; m < 4; ++m) { const f32x4 sp = *(const f32x4*)(SSP + (size_t)(rowb + ai * 128 + m * 16) * 8); const float rl = rsqrtf(((sp.x + sp.y) + (sp.z + sp.w)) * (1.0f / 256.0f) + EPS);
#pragma unroll
                for (int bj = 0; bj < 2; ++bj) { acc[ai][bj][m][0] = acc[ai][bj][m][0] * rl; acc[ai][bj][m][1] = acc[ai][bj][m][1] * rl; } }
        const bool contrib = isq ? (wc < 3) : (wc < 2);
#pragma unroll
        for (int ai = 0; ai < 2; ++ai)
#pragma unroll
            for (int m = 0; m < 4; ++m)
#pragma unroll
                for (int bj = 0; bj < 2; ++bj) { const f32x4 x0 = acc[ai][bj][m][0], x1 = acc[ai][bj][m][1];
                    float ssq = ((x0.x * x0.x + x0.y * x0.y) + (x0.z * x0.z + x0.w * x0.w)) + ((x1.x * x1.x + x1.y * x1.y) + (x1.z * x1.z + x1.w * x1.w));
                    ssq += SHX(ssq, 16, lane); ssq += SHX(ssq, 32, lane);
                    if (fq == 0) P[((ai * 128 + rloc + m * 16) * 2 + bj) * 4 + wc] = contrib ? ssq : 0.f; }
        asm volatile("s_waitcnt lgkmcnt(0)" ::: "memory"); __builtin_amdgcn_s_barrier(); asm volatile("" ::: "memory");
        const float* hg = (isq ? p.in[12] : p.in[13]) + l * QKD;
        const int gd = (wc < 2 || isq) ? (32 * wc + 8 * fq) : (64 + 8 * fq);
        f32x4 g0 = (f32x4){0.f, 0.f, 0.f, 0.f}, g1 = g0;
        if (wc < 3) { g0 = *(const f32x4*)(hg + gd); g1 = *(const f32x4*)(hg + gd + 4); }
        const float* KRSS = PB(WS_KRSS, float); const float* KPE = PB(A_KPE, float);
        bf16_t* Q = PB(A_Q, bf16_t); bf16_t* K = PB(A_K, bf16_t); bf16_t* V = PB(A_V, bf16_t);
#pragma unroll
        for (int ai = 0; ai < 2; ++ai)
#pragma unroll
            for (int m = 0; m < 4; ++m) { const int row = rowb + ai * 128 + m * 16, sq = row & (S_ - 1);
                const float krs = isq ? 0.f : KRSS[row];
                f32x4 kp0 = (f32x4){0.f, 0.f, 0.f, 0.f}, kp1 = kp0;
                if (!isq && wc == 2) { kp0 = *(const f32x4*)(KPE + (size_t)row * 32 + fq * 8); kp1 = *(const f32x4*)(KPE + (size_t)row * 32 + fq * 8 + 4); }
#pragma unroll
                for (int bj = 0; bj < 2; ++bj) { const f32x4 pt = *(const LAS f32x4*)(P + ((ai * 128 + rloc + m * 16) * 2 + bj) * 4);
                    const float tot = ((pt.x + pt.y) + (pt.z + pt.w)) + krs; const float rstd = rsqrtf(tot * (1.0f / QKD) + EPS) * (isq ? QSCALE : 1.0f);
                    const size_t hs = ((size_t)(b * H_ + h0 + bj) * S_ + sq);
                    if (isq) { if (wc < 3) *(u32x4*)(Q + hs * QKD + gd) = pack8(acc[ai][bj][m][0] * rstd * g0, acc[ai][bj][m][1] * rstd * g1); }
                    else {
                        if (wc < 2) *(u32x4*)(K + hs * QKD + gd) = pack8(acc[ai][bj][m][0] * rstd * g0, acc[ai][bj][m][1] * rstd * g1);
                        else { if (wc == 2) *(u32x4*)(K + hs * QKD + gd) = pack8(kp0 * rstd * g0, kp1 * rstd * g1);
                               *(u32x4*)(V + hs * VD + 32 * (wc - 2) + 8 * fq) = pack8(acc[ai][bj][m][0], acc[ai][bj][m][1]); } } } }
    } };
struct ZcatOrder {
    pg8::TileOrder T; const char* A0; const char* B0;
    __device__ __forceinline__ void init(int G, int c, const void* hlo, const void* w) { T.init(64, 4, G, c); A0 = (const char*)hlo; B0 = (const char*)w; }
    __device__ __forceinline__ bool next(int i, Unit& u) const { if (!T.tile(i >> 1, u.pm, u.pn)) return false; const int seg = i & 1;
        u.A = A0 + (size_t)u.pm * (256 * LDHLO * 2) + seg * 2048; u.B = B0 + (size_t)u.pn * (256 * 1536 * 2) + seg * 2048; u.aux = seg ? 1 : ((1 << 30)); u.nt = seg ? 8 : 16; return true; }
    __device__ __forceinline__ unsigned row_off(int, int) const { return 0u; }
};
struct EpiZcat { static constexpr bool PERM = true; Params p;
    __device__ __forceinline__ void operator()(AccT& acc, const Unit& u, int wr, int wc, int fr, int fq) const {
        const int row0 = u.pm * 256 + wr * 64 + fr, c0 = u.pn * 256 + wc * 32 + fq * 8; const unsigned char* G = PB(A_G, unsigned char); bf16_t* Z = PB(A_Z, bf16_t);
        const bool fin = (u.aux & 1) != 0;
#pragma unroll
        for (int ai = 0; ai < 2; ++ai)
#pragma unroll
            for (int m = 0; m < 4; ++m) { const size_t row = row0 + ai * 128 + m * 16;
#pragma unroll
                for (int bj = 0; bj < 2; ++bj) { const int c = c0 + bj * 128; const u32x2 gmw = *(const u32x2*)(G + row * 2048 + 1024 + c);
                    const f32x4 gm0 = (f32x4){(float)(gmw.x & 0xffu), (float)((gmw.x >> 8) & 0xffu), (float)((gmw.x >> 16) & 0xffu), (float)(gmw.x >> 24)}, gm1 = (f32x4){(float)(gmw.y & 0xffu), (float)((gmw.y >> 8) & 0xffu), (float)((gmw.y >> 16) & 0xffu), (float)(gmw.y >> 24)};
                    if (fin) { *(u32x4*)(Z + row * D_ + c) = pack8(acc[ai][bj][m][0] * gm0 * (1.0f / 255.0f), acc[ai][bj][m][1] * gm1 * (1.0f / 255.0f)); }
                    else { const u32x2 glw = *(const u32x2*)(G + row * 2048 + c);
                        const f32x4 gl0 = (f32x4){(float)(glw.x & 0xffu), (float)((glw.x >> 8) & 0xffu), (float)((glw.x >> 16) & 0xffu), (float)(glw.x >> 24)}, gl1 = (f32x4){(float)(glw.y & 0xffu), (float)((glw.y >> 8) & 0xffu), (float)((glw.y >> 16) & 0xffu), (float)(glw.y >> 24)};
                        f32x4 r0, r1;
#pragma unroll
                        for (int j = 0; j < 4; ++j) { r0[j] = gl0[j] * __builtin_amdgcn_rcpf(fmaxf(gm0[j], 1.0f)); r1[j] = gl1[j] * __builtin_amdgcn_rcpf(fmaxf(gm1[j], 1.0f)); }
                        acc[ai][bj][m][0] = acc[ai][bj][m][0] * r0; acc[ai][bj][m][1] = acc[ai][bj][m][1] * r1; } } }
    } };
struct GatesOrder {
    pg8::TileOrder T; const char* UPb; const char* B0;
    int Gp, cp, Qn, pmb;
    __device__ __forceinline__ void init(int Gp_, int cp_, int Qn_, int pmb_, const void* uc, const void* wg) { Gp = Gp_; cp = cp_; Qn = Qn_; pmb = pmb_; UPb = (const char*)uc; B0 = (const char*)wg; }
    __device__ __forceinline__ bool next(int i, Unit& u) const { const int q = (i >> 1) * Gp + cp; if (q >= Qn) return false; u.pm = pmb + (q >> 3); u.pn = (q & 7) * 2 + (i & 1);
        u.A = UPb + ((size_t)u.pm * 256 * D_ + (u.pn >> 1) * 128) * 2; u.B = B0 + (size_t)u.pn * 256 * 128 * 2; u.aux = 0; u.nt = 2; return true; }
    __device__ __forceinline__ unsigned row_off(int, int) const { return 0u; }
};

__device__ __forceinline__ void conv_to_lds(const Params& p, int l, int pm, int nb, int tid, LAS unsigned char* dst) {
    const bf16_t* __restrict__ UP = PB(A_UP, bf16_t);
    const int cl = (tid & 15) * 8, c0 = nb * 128 + cl, b = pm >> 3, s0 = (pm & 7) * 256;
    f32x4 cw[4][2], cb[2];
#pragma unroll
    for (int tap = 0; tap < 4; ++tap) { cw[tap][0] = *(const f32x4*)(p.in[15] + ((size_t)l * 4 + tap) * D_ + c0); cw[tap][1] = *(const f32x4*)(p.in[15] + ((size_t)l * 4 + tap) * D_ + c0 + 4); }
    cb[0] = *(const f32x4*)(p.in[16] + (size_t)l * D_ + c0); cb[1] = *(const f32x4*)(p.in[16] + (size_t)l * D_ + c0 + 4);
    u32x4 w[8][4];
#pragma unroll
    for (int k = 0; k < 8; ++k) {
        const bf16_t* ur = UP + ((size_t)b * SP + s0 + (tid >> 4) + 32 * k) * D_ + c0;
#pragma unroll
        for (int tap = 0; tap < 4; ++tap) w[k][tap] = *(const u32x4*)(ur + (size_t)tap * D_);
    }
#pragma unroll
    for (int k = 0; k < 8; ++k) {
        const int r = (tid >> 4) + 32 * k;
        f32x4 lo = cb[0], hi = cb[1];
#pragma unroll
        for (int tap = 0; tap < 4; ++tap) { lo = lo + bf4lo(w[k][tap]) * cw[tap][0]; hi = hi + bf4hi(w[k][tap]) * cw[tap][1]; }
        *(LAS u32x4*)(dst + ((cl >> 6) * 2 + (r >> 7)) * 16384 + pg8::lds_byte(r & 127, cl & 63)) = pack8(lo, hi);
    }
}
__device__ __forceinline__ void gates_direct(const Params& p, int l, LAS unsigned char* lds, int Gp, int cp, int Qn, int pmb, int tid_in) {
    int tid = tid_in; asm volatile("" : "+v"(tid));
    const int wid = __builtin_amdgcn_readfirstlane(tid >> 6), lane = tid & 63, fr = lane & 15, fq = lane >> 4, hc = wid >> 2, wcq = wid & 3;
    unsigned* LB = PB(A_LAB, unsigned); unsigned short* LR = PB(A_LR, unsigned short);
    const int sw = fr * 64 + fq * 16, aoff = sw ^ (((sw >> 9) & 1) << 5);
#pragma unroll 1
    for (int k0 = 0;; k0 += 2) {
        const int q0 = k0 * Gp + cp; if (q0 >= Qn) break;
        const int q1 = q0 + Gp, nq = q1 < Qn ? 2 : 1;
#pragma unroll 1
        for (int qq = 0; qq < nq; ++qq) { const int q = qq ? q1 : q0; conv_to_lds(p, l, pmb + (q >> 3), q & 7, tid, lds + qq * 65536); }
        asm volatile("s_waitcnt vmcnt(0)" ::: "memory");
        __syncthreads();
#pragma unroll 1
        for (int qq = 0; qq < nq; ++qq) {
            const int q = qq ? q1 : q0, pm = pmb + (q >> 3), nb = q & 7, pn = nb * 2 + hc;
            const bf16_t* Wt = PB(WS_WEI, bf16_t) + WE_WG + ((size_t)l * 4096 + pn * 256) * 128;
            bf16x8 bfr[4][4];
#pragma unroll
            for (int dg = 0; dg < 4; ++dg)
#pragma unroll
                for (int ks = 0; ks < 4; ++ks) bfr[dg][ks] = *(const bf16x8*)(Wt + (size_t)((dg >> 1) * 128 + wcq * 32 + (dg & 1) * 16 + fr) * 128 + ks * 32 + fq * 8);
            const float* GBp = PB(WS_GB, float) + (size_t)l * 4096 + pn * 256 + 32 * wcq + 4 * fq;
            f32x4 bias[2][2];
#pragma unroll
            for (int dir = 0; dir < 2; ++dir) { bias[dir][0] = *(const f32x4*)(GBp + 128 * dir); bias[dir][1] = *(const f32x4*)(GBp + 128 * dir + 16); }
            const int ch0 = nb * 128 + hc * 64 + wcq * 16 + 4 * fq;
            const LAS unsigned char* abuf = lds + qq * 65536 + aoff;
            u32x2 ucr[16];
#pragma unroll
            for (int rb = 0; rb < 16; ++rb) { const int cu = wcq * 16 + 4 * fq, ob = fr * 64 + (cu & 31) * 2;
                ucr[rb] = *(const LAS u32x2*)(lds + qq * 65536 + (hc * 2 + (rb >> 3)) * 16384 + ((rb & 7) * 2 + (cu >> 5)) * 1024 + (ob ^ (((ob >> 9) & 1) << 5))); }
#pragma unroll
            for (int rb = 0; rb < 16; ++rb) {
                const int h = rb >> 3, g = rb & 7;
                bf16x8 afr[4];
#pragma unroll
                for (int ks = 0; ks < 4; ++ks) afr[ks] = *(const LAS bf16x8*)(abuf + ((ks >> 1) * 2 + h) * 16384 + (g * 2 + (ks & 1)) * 1024);
                const size_t eo = (size_t)(pm * 256 + rb * 16 + fr) * D_ + ch0;
                const f32x4 uc = unpack4(ucr[rb]);
                f32x4 acc[4];
#pragma unroll
                for (int dg = 0; dg < 4; ++dg) acc[dg] = __builtin_amdgcn_mfma_f32_16x16x32_bf16(bfr[dg][0], afr[0], bias[dg >> 1][dg & 1], 0, 0, 0);
#pragma unroll
                for (int ks = 1; ks < 4; ++ks)
#pragma unroll
                    for (int dg = 0; dg < 4; ++dg) acc[dg] = __builtin_amdgcn_mfma_f32_16x16x32_bf16(bfr[dg][ks], afr[ks], acc[dg], 0, 0, 0);
                f32x4 sg[4];
#pragma unroll
                for (int dg = 0; dg < 4; ++dg) { f32x4 e;
#pragma unroll
                    for (int j = 0; j < 4; ++j) e[j] = __builtin_amdgcn_exp2f(acc[dg][j]);
                    e = e + 1.0f;
#pragma unroll
                    for (int j = 0; j < 4; ++j) sg[dg][j] = __builtin_amdgcn_rcpf(e[j]); }
                const f32x4 tf = sg[0] * 255.0f + 8388608.0f, tb = sg[2] * 255.0f + 8388608.0f, bf = sg[1] * uc, bb = sg[3] * uc;
                *(u32x4*)(LB + eo) = (u32x4){cvt_pk_bf16(bf[0], bb[0]), cvt_pk_bf16(bf[1], bb[1]), cvt_pk_bf16(bf[2], bb[2]), cvt_pk_bf16(bf[3], bb[3])};
                const unsigned p0 = __builtin_amdgcn_perm(__float_as_uint(tb[0]), __float_as_uint(tf[0]), 0x0c0c0400u), p1 = __builtin_amdgcn_perm(__float_as_uint(tb[1]), __float_as_uint(tf[1]), 0x0c0c0400u);
                const unsigned p2 = __builtin_amdgcn_perm(__float_as_uint(tb[2]), __float_as_uint(tf[2]), 0x0c0c0400u), p3 = __builtin_amdgcn_perm(__float_as_uint(tb[3]), __float_as_uint(tf[3]), 0x0c0c0400u);
                *(u32x2*)(LR + eo) = (u32x2){p0 | (p1 << 16), p2 | (p3 << 16)};
            }
        }
        __syncthreads();
    }
}

__device__ __forceinline__ int moe_meta(const Params& p, int l, int lane) {
    const unsigned* cnt = PB(WS_CTL, unsigned) + CW_CNT + (l >> 1) * 1024;
    int mv = 0; unsigned tb = 0;
#pragma unroll
    for (int e = 0; e < NE; ++e) { const unsigned c = cnt[64 * e]; mv = (lane == e) ? (int)c : mv; mv = (lane == 8 + e) ? (int)tb : mv; tb += (c + 255u) >> 8; }
    mv = (lane == 16) ? (int)tb : mv;
    return mv;
}
__device__ __forceinline__ int xcd_remap(int L, int nwg) { const int q = nwg / 8, r = nwg % 8, xcd = L % 8, off = L / 8; return (xcd < r ? xcd * (q + 1) : r * (q + 1) + (xcd - r) * q) + off; }
struct MoeOrder {
    int metav; LAS unsigned* tok; int G, c, npn, nwg, nt; const char* A0; const char* B0; unsigned atile, bexp, btile;
    int nfull, St, sb;
    __device__ __forceinline__ bool next(int i, Unit& u) const {
        const int L = i * G + c; int h = -1, su = 0, rt, pn;
        if (St > 0) {
            if (L < nfull) { const int wgid = xcd_remap(L, nfull); rt = wgid / npn; pn = wgid - rt * npn; if (rt >= sb) rt += St; }
            else { const int q = G - 1 - c; if (L >= nfull + G || q >= 16 * St) return false; su = q >> 2; h = q & 3; rt = sb + (su >> 2); pn = su & 3; }
        } else { if (L >= nwg) return false; const int wgid = xcd_remap(L, nwg); rt = wgid / npn; pn = wgid - rt * npn; }
        int e = 0;
#pragma unroll
        for (int k = 1; k < NE; ++k) e += (rt >= __builtin_amdgcn_readlane(metav, 8 + k)) ? 1 : 0;
        const int j = rt - __builtin_amdgcn_readlane(metav, 8 + e);
        u.pm = rt; u.pn = pn; u.aux = e | (j << 4); u.nt = nt; u.A = A0 + (size_t)rt * atile; u.B = B0 + (size_t)e * bexp + (size_t)pn * btile;
        if (h >= 0) { const int k0 = h < 2 ? 12 * h : 4 + 10 * h; u.nt = h < 2 ? 12 : 10; u.A += k0 * 128; u.B += k0 * 128; u.aux |= (1 << 20) | (h << 21) | (su << 23); }
        return true;
    }
    __device__ __forceinline__ unsigned row_off(int i, int r) const { return tok[i * 256 + r]; }
    __device__ __forceinline__ void fill_tok(const Params& p, int tid) const {
        const int* list = PB(WS_LIST, int);
        const int* lp[8]; bool ok[8];
#pragma unroll
        for (int k = 0; k < 8; ++k) { const int idx = tid + 512 * k, i = idx >> 8, r = idx & 255, L = i * G + c; ok[k] = false; lp[k] = list;
            if (L < nwg) { const int wgid = xcd_remap(L, nwg), rt = wgid / npn; int e = 0;
#pragma unroll
                for (int kk = 1; kk < NE; ++kk) e += (rt >= __builtin_amdgcn_readlane(metav, 8 + kk)) ? 1 : 0;
                const int pos = (rt - SHIDX(metav, 8 + e)) * 256 + r; if (pos < SHIDX(metav, e)) { ok[k] = true; lp[k] = list + (size_t)e * T_ + pos; } } }
        int ent[8];
#pragma unroll
        for (int k = 0; k < 8; ++k) ent[k] = *lp[k];
#pragma unroll
        for (int k = 0; k < 8; ++k) tok[tid + 512 * k] = ok[k] ? (unsigned)(ent[k] >> 1) * (unsigned)(D_ * 2) : 0u;
        __syncthreads();
    }
};
struct EpiMoeDown { static constexpr bool PERM = true; Params p; int l;
    __device__ __forceinline__ void operator()(AccT& acc, const Unit& u, int wr, int wc, int fr, int fq) const {
        if (u.aux & (1 << 20)) {
            const int h = (u.aux >> 21) & 3, su = (u.aux >> 23) & 63, tid = (wr * 4 + wc) * 64 + fq * 16 + fr;
            float* slab = PB(A_YP, float) + (size_t)su * (4 * 65536) + (size_t)tid * 4;
#pragma unroll
            for (int ai = 0; ai < 2; ++ai)
#pragma unroll
                for (int bj = 0; bj < 2; ++bj)
#pragma unroll
                    for (int m = 0; m < 4; ++m)
#pragma unroll
                        for (int n = 0; n < 2; ++n) *(f32x4*)(slab + h * 65536 + (((ai * 2 + bj) * 4 + m) * 2 + n) * 2048) = acc[ai][bj][m][n];
            asm volatile("s_waitcnt vmcnt(0)" ::: "memory");
            __syncthreads();
            if (tid == 0) { unsigned* tk = PB(WS_CTL, unsigned) + CW_CNT + (l >> 1) * 1024 + 512 + su;
                __builtin_amdgcn_fence(__ATOMIC_RELEASE, "agent"); asm volatile("s_waitcnt vmcnt(0)" ::: "memory");
                (void)__hip_atomic_fetch_add(tk, 1u, __ATOMIC_RELAXED, __HIP_MEMORY_SCOPE_AGENT);
                unsigned sp = 0; while (__hip_atomic_load(tk, __ATOMIC_RELAXED, __HIP_MEMORY_SCOPE_AGENT) < 4u && ++sp < (1u << 22)) __builtin_amdgcn_s_sleep(1);
                __builtin_amdgcn_fence(__ATOMIC_ACQUIRE, "agent"); asm volatile("s_waitcnt vmcnt(0)" ::: "memory"); }
            __syncthreads();
            const int e = u.aux & 15, j = (u.aux >> 4) & 0xFFFF, ai = h >> 1, bj = h & 1; const int cnt = (int)(PB(WS_CTL, unsigned) + CW_CNT + (l >> 1) * 1024)[64 * e];
            const int* list = PB(WS_LIST, int) + (size_t)e * T_; const float* tw = PB(WS_TW, float); const int c0 = u.pn * 256 + bj * 128 + wc * 32 + fq * 8;
            const float* q = slab + h * 16384;
#pragma unroll
            for (int m = 0; m < 4; ++m) { f32x4 r[2];
#pragma unroll
                for (int n = 0; n < 2; ++n) { const float* qq = q + (m * 2 + n) * 2048;
                    const f32x4 p0 = *(const f32x4*)qq, p1 = *(const f32x4*)(qq + 65536), p2 = *(const f32x4*)(qq + 2 * 65536), p3 = *(const f32x4*)(qq + 3 * 65536);
                    r[n] = ((p0 + p1) + p2) + p3; }
                const int pos = j * 256 + ai * 128 + wr * 64 + m * 16 + fr;
                if (pos < cnt) { const int ent = list[pos]; const float w = tw[ent]; bf16_t* Y = ((ent & 1) ? PB(A_Y1, bf16_t) : PB(A_Y0, bf16_t)) + (size_t)(ent >> 1) * D_ + c0;
                    *(u32x4*)Y = pack8(r[0] * w, r[1] * w); } }
            return;
        }
        const int e = u.aux & 15, j = (u.aux >> 4) & 0xFFFF; const int cnt = (int)(PB(WS_CTL, unsigned) + CW_CNT + (l >> 1) * 1024)[64 * e];
        const int* list = PB(WS_LIST, int) + (size_t)e * T_; const float* tw = PB(WS_TW, float); const int c0 = u.pn * 256 + wc * 32 + fq * 8;
#pragma unroll
        for (int ai = 0; ai < 2; ++ai)
#pragma unroll
            for (int m = 0; m < 4; ++m) { const int pos = j * 256 + ai * 128 + wr * 64 + m * 16 + fr;
                if (pos < cnt) { const int ent = list[pos]; const float w = tw[ent]; bf16_t* Y = ((ent & 1) ? PB(A_Y1, bf16_t) : PB(A_Y0, bf16_t)) + (size_t)(ent >> 1) * D_ + c0;
#pragma unroll
                    for (int bj = 0; bj < 2; ++bj) *(u32x4*)(Y + bj * 128) = pack8(acc[ai][bj][m][0] * w, acc[ai][bj][m][1] * w); } }
    } };

namespace att {
typedef short s16x4 __attribute__((ext_vector_type(4)));
typedef float f32x16 __attribute__((ext_vector_type(16)));
constexpr int KVBLK = 64, SHM_V = KVBLK * VD * 2  , SHM_K = KVBLK * 256  , LDS_ATT = 2 * SHM_V + 2 * SHM_K + 8 * 64 * 4;
#define KSWZ(row, colB) ((row) * 256 + ((colB) ^ (((row) & 7) << 4)))
#define SBAR() __builtin_amdgcn_sched_barrier(0)
__device__ __forceinline__ int crow(int r, int hi) { return (r & 3) + 8 * (r >> 2) + 4 * hi; }
__device__ __forceinline__ void partialSM(f32x16& p0, f32x16& p1) {
#pragma unroll
    for (int r = 0; r < 16; ++r) p0[r] = __builtin_amdgcn_exp2f(p0[r]);
}
__device__ __forceinline__ void finishSM(f32x16& p0, f32x16& p1, float& l_reg, bf16x8& pa0, bf16x8& pa1, bf16x8& pa2, bf16x8& pa3) {
#pragma unroll
    for (int r = 0; r < 16; ++r) p1[r] = __builtin_amdgcn_exp2f(p1[r]);
    float ps = 0;
#pragma unroll
    for (int r = 0; r < 16; ++r) ps += p0[r];
#pragma unroll
    for (int r = 0; r < 16; ++r) ps += p1[r];
    { auto rr = __builtin_amdgcn_permlane32_swap(__float_as_uint(ps), __float_as_uint(ps), false, false); ps = __uint_as_float(rr[0]) + __uint_as_float(rr[1]); }
    l_reg += ps;
#define PK4(P, BASE, OUT) do { unsigned a0 = cvt_pk_bf16(P[BASE + 0], P[BASE + 1]), a1 = cvt_pk_bf16(P[BASE + 2], P[BASE + 3]);   \
    unsigned b0 = cvt_pk_bf16(P[BASE + 4], P[BASE + 5]), b1 = cvt_pk_bf16(P[BASE + 6], P[BASE + 7]);                              \
    auto r0 = __builtin_amdgcn_permlane32_swap(a0, b0, false, false); auto r1 = __builtin_amdgcn_permlane32_swap(a1, b1, false, false); \
    u32x4 w = {r0[0], r1[0], r0[1], r1[1]}; OUT = *reinterpret_cast<bf16x8*>(&w); } while (0)
    PK4(p0, 0, pa0); PK4(p0, 8, pa1); PK4(p1, 0, pa2); PK4(p1, 8, pa3);
#undef PK4
}
__device__ __forceinline__ void qkt(f32x16& p0, f32x16& p1, const LAS char* Ks, const bf16x8* qr, int r32, int hi) {
    p0 = f32x16{}; p1 = f32x16{};
#pragma unroll
    for (int d0 = 0; d0 < 6; ++d0) { const int cb = (d0 * 16 + hi * 8) * 2;
        const bf16x8 b0 = *(const LAS bf16x8*)(Ks + KSWZ(r32, cb));
        const bf16x8 b1 = *(const LAS bf16x8*)(Ks + KSWZ(32 + r32, cb));
        p0 = __builtin_amdgcn_mfma_f32_32x32x16_bf16(b0, qr[d0], p0, 0, 0, 0);
        p1 = __builtin_amdgcn_mfma_f32_32x32x16_bf16(b1, qr[d0], p1, 0, 0, 0); }
}
__device__ __forceinline__ int v_st(int k, int c) { const int kk = (k & ~0xC) | ((k & 4) << 1) | ((k & 8) >> 1); return ((kk >> 3) * 2 + (c >> 5)) * 512 + ((kk & 7) * 32 + (c & 31)) * 2; }
__device__ __forceinline__ int v_rd_base(int lane) { return ((lane & 3) << 3) | (((lane >> 2) & 3) << 6) | (((lane >> 4) & 1) << 5) | (((lane >> 5) & 1) << 8); }
constexpr int v_rd_off(int d0, int ks, int half) { return d0 * 512 + ks * 2048 + half * 1024; }
template <int OFF> __device__ __forceinline__ s16x4 tr_read(int vb) { s16x4 r; asm volatile("ds_read_b64_tr_b16 %0, %1 offset:%2" : "=&v"(r) : "v"(vb), "i"(OFF) : "memory"); return r; }
template <int D0> __device__ __forceinline__ void pv_one(f32x16& od, int vb, bf16x8 pa0, bf16x8 pa1, bf16x8 pa2, bf16x8 pa3) {
    const s16x4 l0 = tr_read<v_rd_off(D0, 0, 0)>(vb), h0 = tr_read<v_rd_off(D0, 0, 1)>(vb), l1 = tr_read<v_rd_off(D0, 1, 0)>(vb), h1 = tr_read<v_rd_off(D0, 1, 1)>(vb);
    const s16x4 l2 = tr_read<v_rd_off(D0, 2, 0)>(vb), h2 = tr_read<v_rd_off(D0, 2, 1)>(vb), l3 = tr_read<v_rd_off(D0, 3, 0)>(vb), h3 = tr_read<v_rd_off(D0, 3, 1)>(vb);
    asm volatile("s_waitcnt lgkmcnt(0)" ::: "memory"); SBAR();
#define PKV(L, H) (bf16x8){L[0], L[1], L[2], L[3], H[0], H[1], H[2], H[3]}
    od = __builtin_amdgcn_mfma_f32_32x32x16_bf16(pa0, PKV(l0, h0), od, 0, 0, 0);
    od = __builtin_amdgcn_mfma_f32_32x32x16_bf16(pa1, PKV(l1, h1), od, 0, 0, 0);
    od = __builtin_amdgcn_mfma_f32_32x32x16_bf16(pa2, PKV(l2, h2), od, 0, 0, 0);
    od = __builtin_amdgcn_mfma_f32_32x32x16_bf16(pa3, PKV(l3, h3), od, 0, 0, 0);
#undef PKV
}
__device__ __forceinline__ void pv_d0(f32x16* o, int vb, bf16x8 pa0, bf16x8 pa1, bf16x8 pa2, bf16x8 pa3) { pv_one<0>(o[0], vb, pa0, pa1, pa2, pa3); pv_one<1>(o[1], vb, pa0, pa1, pa2, pa3); }

__device__ __forceinline__ void attn_unit(const bf16_t* __restrict__ Qb, const bf16_t* __restrict__ Kh, const bf16_t* __restrict__ Vh, bf16_t* __restrict__ Ob, int seq, LAS char* lds, int tid, const float* __restrict__ cs0, const float* __restrict__ sn0  ) {
    const int wid = tid >> 6, lane = tid & 63, r32 = lane & 31, hi = lane >> 5;
    LAS char* V_lds = lds; LAS char* K_lds = lds + 2 * SHM_V;
    LAS float* ws = (LAS float*)(lds + 2 * SHM_V + 2 * SHM_K) + wid * 64; LAS float* li_l = ws;
    float l_reg = 0; f32x16 o[2] = {}; bf16x8 qr[6];
    const bf16_t* Qw = Qb + (size_t)(wid * 32 + r32) * QKD + hi * 8;
#pragma unroll
    for (int d0 = 0; d0 < 6; ++d0) qr[d0] = *(const bf16x8*)(Qw + d0 * 16);
    {
        const float* cr = cs0 + (size_t)(wid * 32 + r32) * 16 + hi * 8; const float* sr = sn0 + (size_t)(wid * 32 + r32) * 16 + hi * 8;
        const f32x4 c0 = *(const f32x4*)cr, c1 = *(const f32x4*)(cr + 4), s0 = *(const f32x4*)sr, s1 = *(const f32x4*)(sr + 4);
        const u32x4 lw = *reinterpret_cast<const u32x4*>(&qr[4]), hw = *reinterpret_cast<const u32x4*>(&qr[5]);
        const f32x4 l0 = bf4lo(lw), l1 = bf4hi(lw), h0 = bf4lo(hw), h1 = bf4hi(hw);
        const u32x4 nl = pack8(l0 * c0 - h0 * s0, l1 * c1 - h1 * s1), nh = pack8(h0 * c0 + l0 * s0, h1 * c1 + l1 * s1);
        qr[4] = *reinterpret_cast<const bf16x8*>(&nl); qr[5] = *reinterpret_cast<const bf16x8*>(&nh); }
    const int vrow = tid >> 3, vch = tid & 7, vst = v_st(vrow, vch * 8);
    const int k0row = tid / 12, k0ch = tid % 12; const bool k1ok = tid < 256; const int id1 = k1ok ? tid + 512 : tid, k1row = id1 / 12, k1ch = id1 % 12;
    const int kst0 = KSWZ(k0row, k0ch * 16), kst1 = KSWZ(k1row, k1ch * 16);
    const int vb0 = (int)(uintptr_t)V_lds + v_rd_base(lane);
    struct { bf16x8 v, k0, k1; } sr_[2];
    const unsigned vgo = (unsigned)(vrow * VD + vch * 8) * 2u, kgo0 = (unsigned)(k0row * QKD + k0ch * 8) * 2u, kgo1 = (unsigned)(k1row * QKD + k1ch * 8) * 2u;
#define SLOAD(i, kk0) do { const char* vt_ = (const char*)Vh + (size_t)(kk0) * (VD * 2); const char* kt_ = (const char*)Kh + (size_t)(kk0) * (QKD * 2); \
    sr_[i].v = *(const bf16x8*)(vt_ + vgo); sr_[i].k0 = *(const bf16x8*)(kt_ + kgo0); sr_[i].k1 = *(const bf16x8*)(kt_ + kgo1); } while (0)
#define SWRITE(b, i) do { *(LAS bf16x8*)(V_lds + (b) * SHM_V + vst) = sr_[i].v; *(LAS bf16x8*)(K_lds + (b) * SHM_K + kst0) = sr_[i].k0; if (k1ok) *(LAS bf16x8*)(K_lds + (b) * SHM_K + kst1) = sr_[i].k1; } while (0)
#define SWAIT() asm volatile("s_waitcnt vmcnt(3)" ::: "memory")
    f32x16 pA0, pA1, pB0, pB1; bf16x8 pa0, pa1, pa2, pa3; const int NT = seq / KVBLK;
    constexpr int SE = 0, SO = 1;
    SLOAD(SE, 0); asm volatile("s_waitcnt vmcnt(0)" ::: "memory"); SWRITE(0, SE); __syncthreads();
    qkt(pA0, pA1, K_lds, qr, r32, hi); partialSM(pA0, pA1);
    SLOAD(SO, KVBLK); if (2 < NT) SLOAD(SE, 2 * KVBLK);
    SWAIT(); SWRITE(1, SO); __syncthreads();
#pragma unroll 1
    for (int j = 1; j + 1 < NT; j += 2) {
        SBAR(); qkt(pB0, pB1, K_lds + SHM_K, qr, r32, hi);
        finishSM(pA0, pA1, l_reg, pa0, pa1, pa2, pa3); SBAR();
        SLOAD(SO, (j + 2) * KVBLK); SBAR();
        pv_d0(o, vb0, pa0, pa1, pa2, pa3); partialSM(pB0, pB1);
        __syncthreads(); SWAIT(); SWRITE(0, SE);
        __syncthreads();
        SBAR(); qkt(pA0, pA1, K_lds, qr, r32, hi);
        finishSM(pB0, pB1, l_reg, pa0, pa1, pa2, pa3); SBAR();
        if (j + 3 < NT) SLOAD(SE, (j + 3) * KVBLK); SBAR();
        pv_d0(o, vb0 + SHM_V, pa0, pa1, pa2, pa3); partialSM(pA0, pA1);
        __syncthreads(); SWAIT(); SWRITE(1, SO);
        __syncthreads();
    }
    SBAR(); qkt(pB0, pB1, K_lds + SHM_K, qr, r32, hi);
    finishSM(pA0, pA1, l_reg, pa0, pa1, pa2, pa3); SBAR();
    pv_d0(o, vb0, pa0, pa1, pa2, pa3); partialSM(pB0, pB1);
    __syncthreads();
    finishSM(pB0, pB1, l_reg, pa0, pa1, pa2, pa3); SBAR();
    pv_d0(o, vb0 + SHM_V, pa0, pa1, pa2, pa3);
    if (hi == 0) li_l[r32] = l_reg; asm volatile("s_waitcnt lgkmcnt(0)" ::: "memory");
    bf16_t* Ow = Ob + (size_t)(wid * 32) * LDHLO;
#pragma unroll
    for (int r = 0; r < 16; ++r) { const int orow = crow(r, hi); const float rl = __builtin_amdgcn_rcpf(li_l[orow]);
#pragma unroll
        for (int d0 = 0; d0 < 2; ++d0) Ow[(size_t)orow * LDHLO + d0 * 32 + r32] = f2bf(o[d0][r] * rl); }
    __syncthreads();
#undef SLOAD
#undef SWRITE
#undef SWAIT
#undef RESC
}
#undef KSWZ
#undef SBAR
}
__device__ __forceinline__ void ph_attn(const Params& p, LAS unsigned char* lds, int blk, int G, int tid, int loc, int xi, int lr) {
    const bf16_t* Q = PB(A_Q, bf16_t); const bf16_t* K = PB(A_K, bf16_t); const bf16_t* V = PB(A_V, bf16_t); bf16_t* O = PB(A_HLO, bf16_t) + 1024;
#pragma unroll 1
    for (int i = 0;; ++i) {
        int bh, qb;
        if (loc) { const int uu = i * 32 + lr; if (uu >= 64) break; bh = xi * 8 + (uu >> 3); qb = uu & 7; }
        else { const int L = i * G + blk; if (L >= B_ * H_ * 8) break;
            if (G == 256) { const int x = blk & 7, y = blk >> 3; bh = i * 32 + x * 4 + (y >> 3); qb = y & 7; } else { bh = L >> 3; qb = L & 7; } }
        const int b = bh >> 3, h = bh & 7;
        att::attn_unit(Q + ((size_t)bh * S_ + qb * 256) * QKD, K + (size_t)bh * S_ * QKD, V + (size_t)bh * S_ * VD, O + ((size_t)b * S_ + qb * 256) * LDHLO + h * VD, S_, (LAS char*)lds, tid, PB(WS_COS, float) + ((size_t)b * S_ + qb * 256) * 16, PB(WS_SIN, float) + ((size_t)b * S_ + qb * 256) * 16);
    }
}

struct CvItem { const float* src; size_t ldw; const float* ksc; bf16_t* dst; int k0, Kd; float mul; };
__device__ __forceinline__ void tr_load(const CvItem& d, int lane, f32x4 (&v)[16]) {
    const int r = lane >> 4;
#pragma unroll
    for (int i = 0; i < 16; ++i) v[i] = d.src ? *(const f32x4*)(d.src + (size_t)(d.k0 + 4 * i + r) * d.ldw) : (f32x4){0.f, 0.f, 0.f, 0.f};
}
__device__ __forceinline__ void tr_emit(const f32x4 (&v)[16], const CvItem& d, LAS float* scr, int lane) {
    const int r = lane >> 4, c4 = lane & 15;
    float ks[16];
#pragma unroll
    for (int i = 0; i < 16; ++i) ks[i] = d.ksc ? d.ksc[4 * i + r] : 1.0f;
#pragma unroll
    for (int i = 0; i < 16; ++i) { const int kk = 4 * i + r; const f32x4 x = v[i] * (ks[i] * d.mul); LAS float* q = scr + kk * 65 + 4 * c4; q[0] = x.x; q[1] = x.y; q[2] = x.z; q[3] = x.w; }
    LDS_WAIT(); asm volatile("" ::: "memory");
    const int c = lane & 7;
#pragma unroll
    for (int j = 0; j < 8; ++j) { const int n = (lane >> 3) + 8 * j; const LAS float* sp = scr + (8 * c) * 65 + n;
        u32x4 o; o.x = pk2(sp[0 * 65], sp[1 * 65]); o.y = pk2(sp[2 * 65], sp[3 * 65]); o.z = pk2(sp[4 * 65], sp[5 * 65]); o.w = pk2(sp[6 * 65], sp[7 * 65]);
        *(u32x4*)(d.dst + (size_t)n * d.Kd + 8 * c) = o; }
    LDS_WAIT(); asm volatile("" ::: "memory");
}
constexpr int CV_NL = L_ * 2112, CV_ND = 2 * 2112, CV_MOE = 8 * 2112;
__device__ __forceinline__ void cv_decode(const Params& p, int it, int c4, CvItem& o) {
    bf16_t* WB = PB(WS_WEI, bf16_t);
    constexpr int PER_L = 2112, N_L = L_ * PER_L, PER_F = 2112, N_D = 2 * PER_F;
    const float* src = nullptr; size_t ldw = 0; int k0 = 0; const float* ksc = nullptr; bf16_t* dst = nullptr; int Kd = 0; float mul = 1.0f;
    if (it < N_L) {
        const int l = it / PER_L; int r = it % PER_L;
        if (r < 1216) { const int kb = r & 15, nd0 = (r >> 4) * 64, nd = nd0 + c4; const int sc = nd < 512 ? nd : (nd < 4608 ? nd + 32 : (nd < 4640 ? 512 + nd - 4608 : -1));
            if (sc >= 0) src = p.in[7] + (size_t)l * D_ * INC + sc; ldw = INC; k0 = kb * 64; Kd = 1024; dst = WB + WE_WIN + ((size_t)l * 4864 + nd0) * 1024 + k0; }
        else if ((r -= 1216) < 64) { const int kb = r & 3, nd0 = (r >> 2) * 64, nd = nd0 + c4, h = nd >> 7, d = nd & 127;
            if (d < 96) src = p.in[10] + (size_t)l * 256 * 768 + h * 96 + d; ldw = 768; k0 = kb * 64; Kd = 256; ksc = p.in[8] + l * 256 + k0; dst = WB + WE_WQKV + ((size_t)l * 2048 + nd0) * 256 + k0; }
        else if ((r -= 64) < 64) { const int kb = r & 3, nd0 = (r >> 2) * 64;
            src = p.in[11] + (size_t)l * 256 * 1024 + nd0 + c4; ldw = 1024; k0 = kb * 64; Kd = 256; ksc = p.in[9] + l * 256 + k0; dst = WB + WE_WQKV + ((size_t)l * 2048 + 1024 + nd0) * 256 + k0; }
        else if ((r -= 64) < 128) { const int kh = r & 1, b4 = (r >> 1) & 3, pn = r >> 3, nbk = pn >> 1, hc = pn & 1, c = b4 * 64 + c4, dir = c >> 7, wc = (c >> 5) & 3, gate = (c >> 4) & 1, e = hc * 64 + 16 * wc + (c & 15);
            src = p.in[17] + ((((size_t)l * 2 + dir) * 2 + gate) * NE + nbk) * 128 * 128 + e; ldw = 128; k0 = kh * 64; Kd = 128; mul = -1.4426950408889634f;
            dst = WB + WE_WG + ((size_t)l * 4096 + pn * 256 + b4 * 64) * 128 + k0; }
        else if ((r -= 128) < 256) { const int kb = r & 15, nd0 = (r >> 4) * 64;
            src = p.in[20] + (size_t)l * D_ * D_ + nd0 + c4; ldw = 1024; k0 = kb * 64; Kd = 1536; dst = WB + WE_WCAT + ((size_t)l * 1024 + nd0) * 1536 + k0; }
        else if ((r -= 256) < 128) { const int kb = r & 7, nd0 = (r >> 3) * 64;
            src = p.in[14] + (size_t)l * 512 * D_ + nd0 + c4; ldw = 1024; k0 = kb * 64; Kd = 1536; dst = WB + WE_WCAT + ((size_t)l * 1024 + nd0) * 1536 + 1024 + k0; }
        else { r -= 128; const int kb = r & 15, nd0 = (r >> 4) * 64;
            src = p.in[21] + (size_t)l * D_ * D_ + nd0 + c4; ldw = 1024; k0 = kb * 64; Kd = 1024; dst = WB + WE_WOUT + ((size_t)l * 1024 + nd0) * 1024 + k0; }
    } else {
        const bool moe = it >= N_L + N_D; int r = moe ? it - N_L - N_D : it - N_L; const int ie = r / PER_F; r %= PER_F;
        const float* Wg = (moe ? p.in[26] : p.in[22]) + (size_t)ie * D_ * FF; const float* Wu = (moe ? p.in[27] : p.in[23]) + (size_t)ie * D_ * FF; const float* Wd = (moe ? p.in[28] : p.in[24]) + (size_t)ie * FF * D_;
        bf16_t* GU = WB + (moe ? WE_MGU : WE_FGU) + (size_t)ie * 5632 * 1024; bf16_t* DN = WB + (moe ? WE_MD : WE_FD) + (size_t)ie * 1024 * 2816;
        if (r < 1408) { const int kb = r & 15, nd0 = (r >> 4) * 64, nd = nd0 + c4, pn = nd >> 8, rr = nd & 255;
            src = (rr < 128 ? Wg : Wu) + pn * 128 + (rr & 127); ldw = FF; k0 = kb * 64; Kd = 1024; dst = GU + (size_t)nd0 * 1024 + k0; }
        else { r -= 1408; const int kb = r % 44, nd0 = (r / 44) * 64;
            src = Wd + nd0 + c4; ldw = 1024; k0 = kb * 64; Kd = 2816; dst = DN + (size_t)nd0 * 2816 + k0; }
    }
    o.src = src; o.ldw = ldw; o.ksc = ksc; o.dst = dst; o.k0 = k0; o.Kd = Kd; o.mul = mul;
}
__device__ __forceinline__ void p0_weights(const Params& p, LAS float* scr, int lo, int hi, int widx, int nw, int lane) {
    const int c4 = (lane & 15) * 4;
    int it = lo + widx; if (it >= hi) return;
    CvItem cur; cv_decode(p, it, c4, cur);
    f32x4 v[16]; tr_load(cur, lane, v);
#pragma unroll 1
    for (;;) {
        const int nx = it + nw; const bool more = nx < hi; CvItem nxt = cur; f32x4 w[16];
#pragma unroll
        for (int i = 0; i < 16; ++i) w[i] = v[i];
        if (more) { cv_decode(p, nx, c4, nxt); tr_load(nxt, lane, w); }
        tr_emit(v, cur, scr, lane);
        if (!more) break;
#pragma unroll
        for (int i = 0; i < 16; ++i) v[i] = w[i];
        cur = nxt; it = nx;
    }
}
__device__ __forceinline__ void p0_gbias(const Params& p, int gt, int ngt) {
    float* GB = PB(WS_GB, float);
    for (int idx = gt; idx < L_ * 4096; idx += ngt) {
        const int l = idx >> 12, pn = (idx >> 8) & 15, c = idx & 255, dir = c >> 7, wc = (c >> 5) & 3, n = (c >> 4) & 1, fq = (c >> 2) & 3, j = c & 3;
        const int nbk = pn >> 1, e = (pn & 1) * 64 + 16 * wc + 4 * fq + j, ch = nbk * 128 + e;
        (void)e; GB[idx] = -1.4426950408889634f * p.in[18][(((size_t)l * 2 + dir) * 2 + n) * D_ + ch];
    }
    float* SPT = PB(WS_GB, float) + L_ * 4096;
    for (int idx = gt; idx < L_ * 2 * D_; idx += ngt) SPT[idx] = -8.0f * softplusf_(p.in[19][idx]);
}

#define XB_TMO      128
#define XB_XCNT(j)  (256  + 64 * (j))
#define XB_XSUB(j)  (1280 + 64 * (j))
#define XB_XGEN(j)  (2304 + 64 * (j))
#define XB_TOP      3328
#define XB_TOPGEN   3392
#define XCD_BAR_WORDS 3456
#define XB_SPIN_CAP (1u << 18)
__device__ __forceinline__ unsigned xb_ld(unsigned* p)              { return __hip_atomic_load(p, __ATOMIC_RELAXED, __HIP_MEMORY_SCOPE_AGENT); }
__device__ __forceinline__ unsigned xb_add(unsigned* p, unsigned v) { return __hip_atomic_fetch_add(p, v, __ATOMIC_RELAXED, __HIP_MEMORY_SCOPE_AGENT); }
__device__ __forceinline__ unsigned xb_xcc_id() { return (unsigned)__builtin_amdgcn_s_getreg((3 << 11) | 20) & 0xFu; }
#define XB_SPIN(cond, bar) do { unsigned _sp = 0; while (cond) { __builtin_amdgcn_s_sleep(1); \
    if ((++_sp & 255u) == 0u) { if (xb_ld(&(bar)[XB_TMO])) break; if (_sp > XB_SPIN_CAP) { atomicAdd(&(bar)[XB_TMO], 1u); break; } } } } while (0)
struct XcdBarrier { unsigned* bar; unsigned x; volatile LAS unsigned* st; };
__device__ __forceinline__ XcdBarrier xcd_barrier_post(unsigned* bar, volatile LAS unsigned* st) {
    XcdBarrier b; b.bar = bar; b.x = xb_xcc_id(); b.st = st;
    if (threadIdx.x == 0) st[2] = xb_add(&bar[XB_XCNT(b.x)], 1u);
    return b;
}
__device__ __forceinline__ void xcd_barrier_complete(unsigned* bar, unsigned x, unsigned& nloc, unsigned& nx) {
    const unsigned G = gridDim.x * gridDim.y * gridDim.z;
    unsigned sum, cnt, mine, sp = 0u;
    for (;;) {
        sum = 0u; cnt = 0u; mine = 0u;
#pragma unroll
        for (unsigned j = 0; j < 16; ++j) { const unsigned c = xb_ld(&bar[XB_XCNT(j)]); sum += c; cnt += (c > 0u) ? 1u : 0u; }
        mine = xb_ld(&bar[XB_XCNT(x)]);
        if (sum == G) break;
        __builtin_amdgcn_s_sleep(1);
        if ((++sp & 255u) == 0u) { if (xb_ld(&bar[XB_TMO])) break; if (sp > XB_SPIN_CAP) { atomicAdd(&bar[XB_TMO], 1u); break; } }
    }
    nloc = mine > 0u ? mine : 1u; nx = cnt > 0u ? cnt : 1u;
}
__device__ __forceinline__ void xcd_barrier(const XcdBarrier& b) {
    asm volatile("s_waitcnt vmcnt(0)" ::: "memory");
    __syncthreads();
    if (threadIdx.x == 0) {
        unsigned* bar = b.bar; asm volatile("" : "+s"(bar));
        __builtin_amdgcn_s_waitcnt(0);
        unsigned nloc = b.st[0], nx = b.st[1];
        if (nloc == 0u) { xcd_barrier_complete(bar, b.x, nloc, nx); b.st[0] = nloc; b.st[1] = nx; }
        const unsigned old = xb_add(&bar[XB_XSUB(b.x)], 1u);
        const unsigned gen = old / nloc;
        if (old + 1u == (gen + 1u) * nloc) {
            __builtin_amdgcn_fence(__ATOMIC_RELEASE, "agent");
            asm volatile("s_waitcnt vmcnt(0)" ::: "memory");
            const unsigned og = xb_add(&bar[XB_TOP], 1u);
            const unsigned tg = og / nx;
            if (og + 1u == (tg + 1u) * nx) xb_add(&bar[XB_TOPGEN], 1u);
            else XB_SPIN(xb_ld(&bar[XB_TOPGEN]) == tg, bar);
            __builtin_amdgcn_fence(__ATOMIC_ACQUIRE, "agent");
            xb_add(&bar[XB_XGEN(b.x)], 1u);
            asm volatile("s_waitcnt vmcnt(0)" ::: "memory");
        } else {
            XB_SPIN(xb_ld(&bar[XB_XGEN(b.x)]) == gen, bar);
            __builtin_amdgcn_fence(__ATOMIC_ACQUIRE, "agent");
            asm volatile("s_waitcnt vmcnt(0)" ::: "memory");
        }
    }
    __syncthreads();
}

__device__ __forceinline__ void xcd_local_barrier(unsigned* ctl, unsigned* gbar, unsigned xi, unsigned nloc) {
    asm volatile("s_waitcnt vmcnt(0)" ::: "memory");
    __syncthreads();
    if (threadIdx.x == 0) {
        unsigned* sub = ctl + CW_LBAR + 64 * xi; unsigned* gen = ctl + CW_LBAR + 1024 + 64 * xi; asm volatile("" : "+s"(sub), "+s"(gen));
        asm volatile("buffer_inv sc1" ::: "memory");
        const unsigned old = xb_add(sub, 1u), g = old / nloc;
        if (old + 1u == (g + 1u) * nloc) (void)xb_add(gen, 1u);
        else XB_SPIN(xb_ld(gen) == g, gbar);
        asm volatile("s_waitcnt vmcnt(0)" ::: "memory");
    }
    __syncthreads();
}

constexpr int RING_BYTES = 131072, LDS_TOK = RING_BYTES, LDS_MISC = RING_BYTES + 16384, LDS_BYTES = LDS_MISC + 1024;
constexpr int NPL = 14;
enum { SS_NORM1 = 0, SS_WIN, SS_PREP1, SS_QG, SS_KVG, SS_GATES, SS_PREP2, SS_ATTN, SS_Z1, SS_Z, SS_RES, SS_NORM2, SS_UP, SS_DOWN };
constexpr int ST_FINAL = 1 + L_ * NPL, NSTEPS = ST_FINAL + 1;
struct Args { Params p; int s_lo, s_hi, li, pad; };
typedef const Args __attribute__((address_space(4)))* KArgsP;
#if defined(__HIP_DEVICE_COMPILE__)
#define KP() ({ KArgsP _k = (KArgsP)__builtin_amdgcn_kernarg_segment_ptr(); asm volatile("" : "+s"(_k)); _k->p; })
#else
#define KP() (a.p)
#endif

__global__ void __launch_bounds__(512, 2) mk_fwd(Args a) {
    extern __shared__ __attribute__((aligned(16))) unsigned char lds_raw[];
    LAS unsigned char* lds = (LAS unsigned char*)lds_raw;
    const int tid = threadIdx.x;
    const int wave_s = __builtin_amdgcn_readfirstlane(tid >> 6);
#define PH_BEGIN const Params p = KP(); unsigned ones_ = ~0u; asm volatile("" : "+s"(ones_)); int tid_ = wave_s * 64 + (int)__builtin_amdgcn_mbcnt_hi(ones_, __builtin_amdgcn_mbcnt_lo(ones_, 0u)); asm volatile("" : "+v"(tid_)); const int loc_ = __builtin_amdgcn_readfirstlane((int)MISC[12]), xi_ = __builtin_amdgcn_readfirstlane((int)MISC[11]), lr_ = __builtin_amdgcn_readfirstlane((int)MISC[10]); int blk_ = loc_ ? lr_ * 8 + xi_ : (int)blockIdx.x, G = gridDim.x; asm volatile("" : "+s"(blk_), "+s"(G)); \
    const int lane = tid_ & 63, wave = __builtin_amdgcn_readfirstlane(tid_ >> 6), gw = (loc_ ? lr_ : blk_) * 8 + wave, ngw = loc_ ? 256 : G * 8, row0_ = loc_ ? xi_ * S_ : 0, nrows_ = loc_ ? S_ : T_, gt = blk_ * 512 + tid_, ngt = G * 512; (void)lane; (void)gw; (void)ngw; (void)gt; (void)ngt; (void)row0_; (void)nrows_;
    unsigned misc_base_ = LDS_MISC; asm volatile("" : "+s"(misc_base_));
    volatile LAS unsigned* MISC = (volatile LAS unsigned*)(lds + misc_base_);
    for (int u = tid; u < 256; u += 512) MISC[u] = 0u;
    __syncthreads();
    XcdBarrier bar; { const Params p = KP(); bar.bar = PB(WS_CTL, unsigned) + CW_BAR + a.li * XCD_BAR_WORDS; bar.x = 0; bar.st = nullptr;
    if (a.s_hi - a.s_lo > 1) bar = xcd_barrier_post(PB(WS_CTL, unsigned) + CW_BAR + a.li * XCD_BAR_WORDS, MISC + 8); }
#ifndef PROBE_REPEAT
#define PROBE_REPEAT 0
#endif
#define REP(bit) for (int rep_ = 0; rep_ < 1 + ((PROBE_REPEAT >> (bit)) & 1); ++rep_)
#ifndef PROBE_SEL
#define PROBE_SEL (-1)
#endif
#define T0C (wave_s == 0 && __builtin_amdgcn_mbcnt_hi(~0u, __builtin_amdgcn_mbcnt_lo(~0u, 0u)) == 0u)
#define PT0 if (PROBE_SEL >= 0 && T0C) { MISC[63] = (unsigned)__builtin_amdgcn_s_memrealtime(); }
#define PT1(k) do { if (PROBE_SEL >= 0 && T0C) { MISC[64 + (k)] += (unsigned)__builtin_amdgcn_s_memrealtime() - MISC[63]; } } while (0)
#define IN(s) (a.s_lo <= (s) && (s) < a.s_hi)
#define SEAM(s) do { if (IN(s) && IN((s) + 1)) { PT0 xcd_barrier(bar); PT1(16); } } while (0)
#define SEAML(s) do { if (IN(s) && IN((s) + 1)) { PT0 if (__builtin_amdgcn_readfirstlane((int)MISC[12])) { const Params p = KP(); xcd_local_barrier(PB(WS_CTL, unsigned), bar.bar, (unsigned)__builtin_amdgcn_readfirstlane((int)MISC[11]), 32u); } else xcd_barrier(bar); PT1(16); } } while (0)
#define WB PB(WS_WEI, bf16_t)
#define MOD PB(WS_MOD, float)
    if (IN(0)) REP(14) { PH_BEGIN PT0
        p0_weights(p, (LAS float*)(lds + wave * 16640), 0, (G == 256) ? (CV_NL + CV_ND) : (CV_NL + CV_ND + 2 * CV_MOE), gw, ngw, lane);
        if (G == 256) { p0_weights(p, (LAS float*)(lds + wave * 16640), CV_NL + CV_ND + 7680, CV_NL + CV_ND + CV_MOE, gw, ngw, lane);
                        p0_weights(p, (LAS float*)(lds + wave * 16640), CV_NL + CV_ND + CV_MOE + 10240, CV_NL + CV_ND + 2 * CV_MOE, gw, ngw, lane); }
        __syncthreads();
        ph_mod(p, (LAS float*)lds, blk_, G, tid_);
        ph_tables(p, gt, ngt);
        p0_gbias(p, gt, ngt); PT1(14);
    }
    SEAM(0);
    if (IN(0) && IN(1)) {
        if (tid == 0) { unsigned npop = 0, ok = (gridDim.x == 256u) ? 1u : 0u, xi = 0;
            for (unsigned j = 0; j < 16; ++j) { const unsigned c = xb_ld(&bar.bar[XB_XCNT(j)]); if (c) { ++npop; if (c != 32u) ok = 0u; if (j < bar.x) ++xi; } }
            MISC[11] = xi; MISC[12] = (ok && npop == 8u) ? 1u : 0u; }
        __syncthreads();
    }
    for (int l = 0; l < L_; ++l) {
        const int sb = 1 + l * NPL;
        if (IN(sb + SS_NORM1)) { PH_BEGIN PT0 if (loc_) ph_zero_pads(p, xi_, 1, lr_ * 512 + tid_, 32 * 512); else ph_zero_pads(p, 0, B_, gt, ngt);
            ph_norm(p, l, 1, row0_, nrows_, gw, ngw, lane); PT1(SS_NORM1); }
        SEAML(sb + SS_NORM1);
        if (IN(sb + SS_WIN)) REP(SS_WIN) { PH_BEGIN PT0
            pg8::GemmCfg g{1024, 1024, 1024, 256u}; pg8::StdOrder S; S.init(64, 19, G, blk_, PB(A_XN, bf16_t), WB + WE_WIN + (size_t)l * 4864 * 1024, 1024, 1024, 1024);
            EpiWin E{p}; pg8::gemm_phase<EpiWin, pg8::StdOrder, true, false>(lds, g, S, E, tid_);
            if (G == 256 && blk_ >= 192 && l < 3) { const int base = CV_NL + CV_ND + (l ? CV_MOE : 0) + (l == 2 ? 2560 : 0); p0_weights(p, (LAS float*)(lds + wave * 16640), base, base + 2560, (blk_ - 192) * 8 + wave, 512, lane); }
            PT1(SS_WIN);
        }
        SEAML(sb + SS_WIN);
        if (IN(sb + SS_QG)) REP(SS_QG) { PH_BEGIN PT0
            pg8::GemmCfg g{512, 256, 256, 256u}; QkvOrder S; S.init(G, blk_, PB(A_CQKV, bf16_t), WB + WE_WQKV + (size_t)l * 2048 * 256);
            EpiQkvF E{p, l, (LAS float*)(lds + LDS_TOK)}; pg8::gemm_phase<EpiQkvF, QkvOrder, true, false>(lds, g, S, E, tid_); PT1(SS_QG);
            asm volatile("s_waitcnt vmcnt(0)" ::: "memory"); __syncthreads();
            { PT0 gates_direct(p, l, lds, loc_ ? 32 : G, loc_ ? lr_ : blk_, loc_ ? 64 : 512, loc_ ? xi_ * 8 : 0, tid_); PT1(SS_GATES); }
        }
        SEAML(sb + SS_GATES);
        if (IN(sb + SS_ATTN)) { PH_BEGIN { PT0
            if (a.pad & 1) REP(SS_ATTN) ph_attn(p, lds, blk_, G, tid_, loc_, xi_, lr_);
            PT1(SS_ATTN); } PT0
            REP(16) { if (loc_) ph_scan(p, l, lds, xi_ * 32 + lr_, xi_ * 32 + lr_ + 1, 1, tid_); else ph_scan(p, l, lds, blk_, B_ * 32, G, tid_); } PT1(17); }
        SEAML(sb + SS_ATTN);
        if (IN(sb + SS_Z)) REP(SS_Z) { PH_BEGIN PT0
            pg8::GemmCfg g{LDHLO, 1536, 1536, 256u}; ZcatOrder S; S.init(G, blk_, PB(A_HLO, bf16_t), WB + WE_WCAT + (size_t)l * 1024 * 1536);
            EpiZcat E{p}; pg8::gemm_phase<EpiZcat, ZcatOrder, true, false>(lds, g, S, E, tid_); PT1(SS_Z);
        }
        SEAML(sb + SS_Z);
        if (IN(sb + SS_RES)) { PH_BEGIN PT0
            pg8::GemmCfg g{1024, 1024, 1024, 256u}; pg8::StdOrder S; S.init(64, 4, G, blk_, PB(A_Z, bf16_t), WB + WE_WOUT + (size_t)l * 1024 * 1024, 1024, 1024, 1024);
            EpiRes E{l == 0 ? p.in[0] : nullptr, PB(A_X, bf16_t), MOD + (size_t)l * 8 * 6144 + 2048}; pg8::gemm_phase<EpiRes, pg8::StdOrder, true, false>(lds, g, S, E, tid_); PT1(SS_RES);
        }
        SEAML(sb + SS_RES);
        if (IN(sb + SS_NORM2)) { PH_BEGIN PT0
            if (l & 1) { LAS float* wl = (LAS float*)lds; const float* wrp = p.in[25] + (size_t)(l >> 1) * D_ * NE;
                for (int idx = tid_; idx < D_ * NE; idx += 512) { const int k = idx >> 3, e = idx & 7; wl[(((k >> 9) * 8 + (k & 7)) * 64 + ((k & 511) >> 3)) * 8 + e] = wrp[idx]; }
                __syncthreads(); }
            ph_norm(p, l, 2, row0_, nrows_, gw, ngw, lane, (const LAS float*)lds); PT1(SS_NORM2); }
        if (l & 1) SEAM(sb + SS_NORM2); else SEAML(sb + SS_NORM2);
        if (IN(sb + SS_UP)) { PH_BEGIN PT0
            if (!(l & 1)) REP(SS_UP) {
                pg8::GemmCfg g{1024, 1024, 1024, 256u}; pg8::StdOrder S; S.init(64, 22, G, blk_, PB(A_XN, bf16_t), WB + WE_FGU + (size_t)(l >> 1) * 5632 * 1024, 1024, 1024, 1024);
                EpiUp E{PB(A_HIDD, bf16_t)}; pg8::gemm_phase<EpiUp, pg8::StdOrder, true, false>(lds, g, S, E, tid_);
                if (G == 256 && blk_ >= 128) { const int base = CV_NL + CV_ND + (l >> 1) * CV_MOE + (l ? 5120 : 2560); p0_weights(p, (LAS float*)(lds + wave * 16640), base, base + 5120, (blk_ - 128) * 8 + wave, 1024, lane); }
                PT1(SS_UP);
            } else REP(15) {
                MoeOrder S; S.metav = moe_meta(p, l, lane); S.tok = (LAS unsigned*)(lds + LDS_TOK); S.G = G; S.c = blk_; S.nt = 16; S.npn = 22; S.nwg = __builtin_amdgcn_readlane(S.metav, 16) * 22; S.A0 = (const char*)PB(A_XN, bf16_t); S.atile = 0; S.nfull = 0; S.St = 0; S.sb = 0;
                S.B0 = (const char*)(WB + WE_MGU + (size_t)(l >> 1) * 8 * 5632 * 1024); S.bexp = 5632u * 1024u * 2u; S.btile = 256u * 1024u * 2u;
                S.fill_tok(p, tid_);
                pg8::GemmCfg g{1024, 1024, 1024, 256u}; EpiUp E{PB(A_HID, bf16_t)}; pg8::gemm_phase<EpiUp, MoeOrder, true, true>(lds, g, S, E, tid_); PT1(15);
            }
        }
        if (l & 1) SEAM(sb + SS_UP); else SEAML(sb + SS_UP);
        if (IN(sb + SS_DOWN)) { PH_BEGIN PT0
            if (!(l & 1)) {
                pg8::GemmCfg g{FF, FF, FF, 256u}; pg8::StdOrder S; S.init(64, 4, G, blk_, PB(A_HIDD, bf16_t), WB + WE_FD + (size_t)(l >> 1) * 1024 * 2816, FF, FF, FF);
                EpiRes E{nullptr, PB(A_X, bf16_t), MOD + (size_t)l * 8 * 6144 + 5120}; pg8::gemm_phase<EpiRes, pg8::StdOrder, true, false>(lds, g, S, E, tid_); PT1(SS_DOWN);
            } else {
                MoeOrder S; S.metav = moe_meta(p, l, lane); S.tok = (LAS unsigned*)(lds + LDS_TOK); S.G = G; S.c = blk_; S.nt = 44; S.npn = 4; S.nwg = __builtin_amdgcn_readlane(S.metav, 16) * 4; S.A0 = (const char*)PB(A_HID, bf16_t); S.atile = 256u * FF * 2u;
                { int tbp = 0, best = 1 << 30, sbv = 0;
#pragma unroll
                  for (int e = 0; e < NE; ++e) { const int tbn = __builtin_amdgcn_readlane(S.metav, e == NE - 1 ? 16 : 9 + e), ne = tbn - tbp; if (ne < best) { best = ne; sbv = tbp; } tbp = tbn; }
                  S.St = (best > 0 && 16 * best <= G) ? best : 0; S.sb = sbv; S.nfull = S.nwg - 4 * S.St; }
                S.B0 = (const char*)(WB + WE_MD + (size_t)(l >> 1) * 8 * 1024 * 2816); S.bexp = 1024u * 2816u * 2u; S.btile = 256u * 2816u * 2u;
                pg8::GemmCfg g{FF, FF, FF, 256u}; EpiMoeDown E{p, l}; pg8::gemm_phase<EpiMoeDown, MoeOrder, true, false>(lds, g, S, E, tid_); PT1(18);
            }
        }
        if (l & 1) SEAM(sb + SS_DOWN); else SEAML(sb + SS_DOWN);
    }
    if (IN(ST_FINAL)) { PH_BEGIN PT0 ph_final(p, gt, ngt); PT1(19); }
    if (PROBE_SEL >= 0 && blockIdx.x == 0 && T0C) {
        const unsigned long long tend = __builtin_amdgcn_s_memrealtime() + 8ull * (unsigned long long)MISC[64 + PROBE_SEL];
        while (__builtin_amdgcn_s_memrealtime() < tend) __builtin_amdgcn_s_sleep(8);
    }
#undef IN
#undef SEAM
#undef WB
#undef MOD
}

#ifndef ONE_LAUNCH
#define ONE_LAUNCH 1
#endif
extern "C" void kernel_launch(void* const* d_in, const int* in_sizes, int n_in, void* d_out, int out_size, void* d_ws, size_t ws_size, hipStream_t stream) {
    if (n_in != 29 || out_size != T_ * D_ || ws_size < WS_END) { fprintf(stderr, "kernel_launch: bad shapes n_in %d out %d ws %zu (need %zu)\n", n_in, out_size, ws_size, (size_t)WS_END); return; }
    Params p{};
    for (int i = 0; i < 29; ++i) p.in[i] = (const float*)d_in[i];
    p.out = (float*)d_out; p.ws = (unsigned char*)d_ws;
    static int grid = 0;
    if (!grid) {
        (void)hipFuncSetAttribute((const void*)mk_fwd, hipFuncAttributeMaxDynamicSharedMemorySize, LDS_BYTES);
        int dev = 0, cus = 0, per_cu = 0; (void)hipGetDevice(&dev); (void)hipDeviceGetAttribute(&cus, hipDeviceAttributeMultiprocessorCount, dev);
        (void)hipOccupancyMaxActiveBlocksPerMultiprocessor(&per_cu, (const void*)mk_fwd, 512, LDS_BYTES);
        grid = cus > 0 ? cus : 256; if (per_cu < 1) fprintf(stderr, "kernel_launch: occupancy query says %d blocks per CU\n", per_cu);
        (void)hipGetLastError();
    }
    (void)hipMemsetAsync((char*)d_ws + WS_CTL, 0, CTL_BYTES, stream);
    if (ONE_LAUNCH) { Args a{}; a.p = p; a.s_lo = 0; a.s_hi = NSTEPS; a.li = 0; a.pad = 1; hipLaunchKernelGGL(mk_fwd, dim3(grid), dim3(512), LDS_BYTES, stream, a); return; }
    for (int s = 0; s < NSTEPS; ++s) { Args a{}; a.p = p; a.s_lo = s; a.s_hi = s + 1; a.li = 0; a.pad = 1; hipLaunchKernelGGL(mk_fwd, dim3(grid), dim3(512), LDS_BYTES, stream, a); }
}
```
